# Optimizing an MI355X kernel written in HIP

```python
import math
import jax, jax.numpy as jnp
from jax import lax
import numpy as np

D_MODEL = 1024
BATCH = 8
SEQ = 8192
DEPTH = 4

MIX_WIDTH = D_MODEL
GROUP_WIDTH = MIX_WIDTH // 4

S5_WIDTH = GROUP_WIDTH
S5_CH = 16
S5_GROUPS = S5_WIDTH // S5_CH
S5_STATE = 64
S5_DT_MIN = 1e-3
S5_DT_MAX = 1e-1

RWKV_HEAD = 64
RWKV_WIDTH = GROUP_WIDTH
RWKV_HEADS = RWKV_WIDTH // RWKV_HEAD
RWKV_DECAY_LORA = 64
RWKV_A_LORA = 64
RWKV_V_LORA = 32
RWKV_G_LORA = 128
RWKV_GN_EPS = 64e-5
RWKV_IN = 3 * RWKV_WIDTH + RWKV_DECAY_LORA + RWKV_A_LORA + RWKV_G_LORA

MLA_V = 64
MLA_HEADS = GROUP_WIDTH // MLA_V
MLA_NOPE = 64
MLA_ROPE = 32
MLA_Q_RANK = 256
MLA_KV_RANK = 128
MLA_WIDTH = MLA_HEADS * MLA_V
MLA_IN = MLA_Q_RANK + MLA_KV_RANK + MLA_ROPE
Q_BLOCK = 128

RET_V = 64
RET_HEADS = GROUP_WIDTH // RET_V
RET_QK = 32
RET_WIDTH = RET_HEADS * RET_V
RET_CHUNK = 128
RET_IN = 2 * RET_HEADS * RET_QK + 2 * RET_WIDTH

IN_WIDTH = S5_WIDTH + RWKV_IN + MLA_IN + RET_IN
ROPE_BASE = 10000.0
MAX_POS_OFFSET = 4096

N_EXPERTS = 32
TOP_K = 4
D_EXPERT = D_MODEL
SWIGLU_ALPHA = 1.702
SWIGLU_LIMIT = 7.0
MOE_BLOCK = 128

NORM_EPS = 1e-5
N_MOD = 6
F32 = jnp.float32

kernel_name = "hybrid_s5_rwkv7_mla_retention_moe_adaln"


def rmsnorm(x, g):
    xf = x.astype(F32)
    y = xf * lax.rsqrt(jnp.mean(xf * xf, axis=-1, keepdims=True) + NORM_EPS)
    return (y * g.astype(F32)).astype(x.dtype)


def rope(x, positions):
    d = x.shape[-1]
    inv = ROPE_BASE ** (-jnp.arange(0, d, 2, dtype=F32) / d)
    ang = positions.astype(F32)[..., None] * inv
    cos = jnp.cos(ang)[:, :, None, :]
    sin = jnp.sin(ang)[:, :, None, :]
    x1, x2 = jnp.split(x.astype(F32), 2, axis=-1)
    return jnp.concatenate([x1 * cos - x2 * sin, x1 * sin + x2 * cos], axis=-1).astype(x.dtype)


def _complex_affine_combine(e1, e2):
    a1r, a1i, b1r, b1i = e1
    a2r, a2i, b2r, b2i = e2
    return (a1r * a2r - a1i * a2i,
            a1r * a2i + a1i * a2r,
            a2r * b1r - a2i * b1i + b2r,
            a2r * b1i + a2i * b1r + b2i)


def s5_mixer(u, lam_re, lam_im, log_step, b_re, b_im, c_re, c_im, d_skip, glu_w, glu_b):
    out_dtype = u.dtype
    bsz, seq, _ = u.shape
    u = u.astype(F32)
    lam_re, lam_im, b_re, b_im, c_re, c_im = (t.astype(F32) for t in (lam_re, lam_im, b_re, b_im, c_re, c_im))
    dt = jnp.exp(log_step.astype(F32))[:, None]
    mag = jnp.exp(lam_re * dt)
    lb_re = mag * jnp.cos(lam_im * dt)
    lb_im = mag * jnp.sin(lam_im * dt)
    den = lam_re * lam_re + lam_im * lam_im
    n_re = lb_re - 1.0
    f_re = (n_re * lam_re + lb_im * lam_im) / den
    f_im = (lb_im * lam_re - n_re * lam_im) / den
    bb_re = f_re[..., None] * b_re - f_im[..., None] * b_im
    bb_im = f_re[..., None] * b_im + f_im[..., None] * b_re
    ug = u.reshape(bsz, seq, S5_GROUPS, S5_CH)
    bu_re = jnp.einsum('blgh,gph->blgp', ug, bb_re)
    bu_im = jnp.einsum('blgh,gph->blgp', ug, bb_im)
    a_re = jnp.broadcast_to(lb_re, bu_re.shape)
    a_im = jnp.broadcast_to(lb_im, bu_im.shape)
    _, _, s_re, s_im = lax.associative_scan(_complex_affine_combine, (a_re, a_im, bu_re, bu_im), axis=1)
    y = jnp.einsum('blgp,ghp->blgh', s_re, c_re) - jnp.einsum('blgp,ghp->blgh', s_im, c_im)
    y = y.reshape(bsz, seq, S5_WIDTH) + d_skip.astype(F32) * u
    y = jax.nn.gelu(y)
    y = y * jax.nn.sigmoid(y @ glu_w.astype(F32) + glu_b.astype(F32))
    return y.astype(out_dtype)


def wkv7_scan(r, w, k, v, kk, a):
    bsz, seq, nh, n = r.shape

    def step(state, inp):
        r_t, w_t, k_t, v_t, kk_t, a_t = inp
        sa = jnp.einsum('bhvk,bhk->bhv', state, -kk_t)
        state = (state * w_t[:, :, None, :]
                 + sa[..., None] * (kk_t * a_t)[:, :, None, :]
                 + v_t[..., None] * k_t[:, :, None, :])
        return state, jnp.einsum('bhvk,bhk->bhv', state, r_t)

    xs = tuple(jnp.moveaxis(t, 1, 0) for t in (r, w, k, v, kk, a))
    s0 = jnp.zeros((bsz, nh, n, n), F32)
    _, y = lax.scan(step, s0, xs)
    return jnp.moveaxis(y, 0, 1)


def rwkv7_mixer(h, v_first, mu, w0, w2, a0, a2, g2, k_k, k_a, r_k, ln_g, ln_b, vmix):
    out_dtype = h.dtype
    bsz, seq, _ = h.shape
    h = h.astype(F32)
    h_prev = jnp.pad(h, ((0, 0), (1, 0), (0, 0)))[:, :-1]
    h = h + (h_prev - h) * mu.astype(F32)
    cuts = np.cumsum([RWKV_WIDTH, RWKV_WIDTH, RWKV_WIDTH, RWKV_DECAY_LORA, RWKV_A_LORA]).tolist()
    r, k, v, wd, ad, gd = jnp.split(h, cuts, axis=-1)
    w = -jax.nn.softplus(-(w0 + jnp.tanh(wd) @ w2)) - 0.5
    decay = jnp.exp(-jnp.exp(w))
    a = jax.nn.sigmoid(a0 + ad @ a2)
    g = jax.nn.sigmoid(gd) @ g2
    if vmix is None:
        v_first = v
    else:
        v0, v1, v2 = vmix
        v = v + (v_first - v) * jax.nn.sigmoid(v0 + (v @ v1) @ v2)
    heads = lambda t: t.reshape(bsz, seq, RWKV_HEADS, RWKV_HEAD).astype(F32)
    kk = heads(k * k_k)
    kk = kk / jnp.maximum(jnp.sqrt(jnp.sum(kk * kk, axis=-1, keepdims=True)), 1e-12)
    k = k * (1.0 + (a - 1.0) * k_a)
    rh, kh, vh, ah, wh = heads(r), heads(k), heads(v), heads(a), heads(decay)
    y = wkv7_scan(rh, wh, kh, vh, kk, ah)
    mean = jnp.mean(y, axis=-1, keepdims=True)
    var = jnp.mean(jnp.square(y - mean), axis=-1, keepdims=True)
    y = ((y - mean) * lax.rsqrt(var + RWKV_GN_EPS)).reshape(bsz, seq, RWKV_WIDTH)
    y = y * ln_g.astype(F32) + ln_b.astype(F32)
    bonus = jnp.sum(rh * kh * r_k.astype(F32), axis=-1, keepdims=True) * vh
    y = (y + bonus.reshape(bsz, seq, RWKV_WIDTH)) * g
    return y.astype(out_dtype), v_first


def causal_attention(q, k, v, scale):
    bsz, seq, nh, dq = q.shape
    dv = v.shape[-1]
    nb = seq // Q_BLOCK
    qb = jnp.moveaxis(q.reshape(bsz, nb, Q_BLOCK, nh, dq), 1, 0)
    kpos = jnp.arange(seq)

    def one_block(args):
        q_blk, i = args
        s = jnp.einsum('bqhd,bkhd->bhqk', q_blk, k).astype(F32) * scale
        qpos = i * Q_BLOCK + jnp.arange(Q_BLOCK)
        s = jnp.where(kpos[None, :] <= qpos[:, None], s, -jnp.inf)
        p = jax.nn.softmax(s, axis=-1).astype(v.dtype)
        return jnp.einsum('bhqk,bkhd->bqhd', p, v)

    out = lax.map(one_block, (qb, jnp.arange(nb)))
    return jnp.moveaxis(out, 0, 1).reshape(bsz, seq, nh, dv)


def mla_mixer(h, positions, q_norm_g, kv_norm_g, w_q_up, w_kv_up):
    bsz, seq, _ = h.shape
    qc, kvc, k_pe = jnp.split(h, [MLA_Q_RANK, MLA_Q_RANK + MLA_KV_RANK], axis=-1)
    q = (rmsnorm(qc, q_norm_g) @ w_q_up).reshape(bsz, seq, MLA_HEADS, MLA_NOPE + MLA_ROPE)
    kv = (rmsnorm(kvc, kv_norm_g) @ w_kv_up).reshape(bsz, seq, MLA_HEADS, MLA_NOPE + MLA_V)
    q_nope, q_pe = jnp.split(q, [MLA_NOPE], axis=-1)
    k_nope, v = jnp.split(kv, [MLA_NOPE], axis=-1)
    q = jnp.concatenate([q_nope, rope(q_pe, positions)], axis=-1)
    k_pe = rope(k_pe[:, :, None, :], positions)
    k = jnp.concatenate([k_nope, jnp.broadcast_to(k_pe, (bsz, seq, MLA_HEADS, MLA_ROPE))], axis=-1)
    o = causal_attention(q, k, v, (MLA_NOPE + MLA_ROPE) ** -0.5)
    return o.reshape(bsz, seq, MLA_WIDTH)


def retention_mixer(h, positions):
    out_dtype = h.dtype
    bsz, seq, _ = h.shape
    nq = RET_HEADS * RET_QK
    q, k, v, g = jnp.split(h, [nq, 2 * nq, 2 * nq + RET_WIDTH], axis=-1)
    q = rope(q.reshape(bsz, seq, RET_HEADS, RET_QK), positions).astype(F32)
    k = rope(k.reshape(bsz, seq, RET_HEADS, RET_QK), positions).astype(F32) * (RET_QK ** -0.5)
    v = v.reshape(bsz, seq, RET_HEADS, RET_V).astype(F32)
    log_gamma = jnp.log1p(-jnp.exp2(-5.0 - jnp.arange(RET_HEADS, dtype=F32)))
    nc = seq // RET_CHUNK
    qc = q.reshape(bsz, nc, RET_CHUNK, RET_HEADS, RET_QK)
    kc = k.reshape(bsz, nc, RET_CHUNK, RET_HEADS, RET_QK)
    vc = v.reshape(bsz, nc, RET_CHUNK, RET_HEADS, RET_V)
    idx = jnp.arange(RET_CHUNK, dtype=F32)
    diff = idx[:, None] - idx[None, :]
    intra = jnp.where(diff >= 0, jnp.exp(jnp.maximum(diff, 0.0)[None] * log_gamma[:, None, None]), 0.0)
    scores = jnp.einsum('bnchd,bnmhd->bnhcm', qc, kc) * intra
    inner = jnp.einsum('bnhcm,bnmhe->bnche', scores, vc)
    k_w = jnp.exp((RET_CHUNK - 1.0 - idx)[:, None] * log_gamma[None, :])
    chunk_kv = jnp.einsum('bnchd,bnche,ch->nbhde', kc, vc, k_w)
    chunk_decay = jnp.exp(RET_CHUNK * log_gamma)[None, :, None, None]

    def step(state, kv):
        return state * chunk_decay + kv, state

    _, r_prev = lax.scan(step, jnp.zeros((bsz, RET_HEADS, RET_QK, RET_V), F32), chunk_kv)
    q_w = jnp.exp((idx + 1.0)[:, None] * log_gamma[None, :])
    cross = jnp.einsum('bnchd,nbhde,ch->bnche', qc, r_prev, q_w)
    o = (inner + cross).reshape(bsz, seq, RET_HEADS, RET_V)
    o = o * lax.rsqrt(jnp.mean(o * o, axis=-1, keepdims=True) + NORM_EPS)
    o = o.reshape(bsz, seq, RET_WIDTH) * jax.nn.silu(g.astype(F32))
    return o.astype(out_dtype)


def moe_ffn(h, router_w, router_b, w_gate, b_gate, w_up, b_up, w_down, b_down):
    bsz, seq, d = h.shape
    t = bsz * seq
    xt = h.reshape(t, d)
    logits = (xt @ router_w + router_b).astype(F32)
    top_val, top_idx = lax.top_k(logits, TOP_K)
    top_w = jax.nn.softmax(top_val, axis=-1)
    n_assign = t * TOP_K
    flat_e = top_idx.reshape(-1)
    flat_tok = jnp.arange(n_assign, dtype=jnp.int32) // TOP_K
    flat_w = top_w.reshape(-1)
    order = jnp.argsort(flat_e)
    sorted_e = flat_e[order]
    counts = jnp.bincount(flat_e, length=N_EXPERTS)
    padded = (counts + MOE_BLOCK - 1) // MOE_BLOCK * MOE_BLOCK
    pad_end = jnp.cumsum(padded)
    pad_start = pad_end - padded
    start = jnp.cumsum(counts) - counts
    dest = pad_start[sorted_e] + jnp.arange(n_assign) - start[sorted_e]
    p_rows = n_assign + N_EXPERTS * MOE_BLOCK
    n_blocks = p_rows // MOE_BLOCK
    buf_tok = jnp.full((p_rows,), t, jnp.int32).at[dest].set(flat_tok[order])
    buf_w = jnp.zeros((p_rows,), F32).at[dest].set(flat_w[order])
    blk_e = jnp.minimum(jnp.searchsorted(pad_end, jnp.arange(n_blocks) * MOE_BLOCK, side='right'), N_EXPERTS - 1)
    x_pad = jnp.concatenate([xt, jnp.zeros((1, d), xt.dtype)], axis=0)
    xb = x_pad[buf_tok].reshape(n_blocks, MOE_BLOCK, d)

    def expert_block(args):
        xblk, e = args
        gt = jnp.minimum(xblk @ w_gate[e] + b_gate[e], SWIGLU_LIMIT)
        up = jnp.clip(xblk @ w_up[e] + b_up[e], -SWIGLU_LIMIT, SWIGLU_LIMIT)
        act = gt * jax.nn.sigmoid(SWIGLU_ALPHA * gt) * (up + 1.0)
        return act @ w_down[e] + b_down[e]

    yb = lax.map(expert_block, (xb, blk_e)).reshape(p_rows, d)
    out = jnp.zeros((t + 1, d), F32).at[buf_tok].add(yb.astype(F32) * buf_w[:, None])
    return out[:t].reshape(bsz, seq, d).astype(h.dtype)


def setup_inputs(seed: int = 0) -> dict:
    key = jax.random.key(seed)
    ks = iter(jax.random.split(key, 64))

    def nrm(shape, scale):
        return jax.random.normal(next(ks), shape, F32) * scale

    def unif(shape, lo, hi):
        return jax.random.uniform(next(ks), shape, F32, lo, hi)

    L = DEPTH
    x = nrm((BATCH, SEQ, D_MODEL), 1.0)
    c = nrm((BATCH, D_MODEL), 1.0)
    offset = jax.random.randint(next(ks), (BATCH, 1), 0, MAX_POS_OFFSET, dtype=jnp.int32)
    positions = offset + jnp.arange(SEQ, dtype=jnp.int32)[None, :]
    inp = {
        "x": x, "c": c, "positions": positions,
        "ada_w": nrm((L, D_MODEL, N_MOD * D_MODEL), 0.5 * D_MODEL ** -0.5),
        "ada_b": nrm((L, N_MOD * D_MODEL), 0.02),
        "norm_mix_g": 1.0 + nrm((L, D_MODEL), 0.02),
        "norm_ffn_g": 1.0 + nrm((L, D_MODEL), 0.02),
        "w_in": nrm((L, D_MODEL, IN_WIDTH), D_MODEL ** -0.5),
        "w_out": nrm((L, MIX_WIDTH, D_MODEL), MIX_WIDTH ** -0.5),
        "s5_lambda_re": -0.5 + nrm((L, S5_GROUPS, S5_STATE), 0.01),
        "s5_lambda_im": math.pi * jnp.arange(S5_STATE, dtype=F32) + nrm((L, S5_GROUPS, S5_STATE), 0.01),
        "s5_log_step": unif((L, S5_GROUPS), math.log(S5_DT_MIN), math.log(S5_DT_MAX)),
        "s5_b_re": nrm((L, S5_GROUPS, S5_STATE, S5_CH), (2.0 * S5_CH) ** -0.5),
        "s5_b_im": nrm((L, S5_GROUPS, S5_STATE, S5_CH), (2.0 * S5_CH) ** -0.5),
        "s5_c_re": nrm((L, S5_GROUPS, S5_CH, S5_STATE), S5_STATE ** -0.5),
        "s5_c_im": nrm((L, S5_GROUPS, S5_CH, S5_STATE), S5_STATE ** -0.5),
        "s5_d": nrm((L, S5_WIDTH), 1.0),
        "s5_glu_w": nrm((L, S5_WIDTH, S5_WIDTH), S5_WIDTH ** -0.5),
        "s5_glu_b": nrm((L, S5_WIDTH), 0.02),
        "rw_mu": unif((L, RWKV_IN), 0.0, 1.0),
        "rw_w0": unif((L, RWKV_WIDTH), -6.0, -1.0),
        "rw_w2": nrm((L, RWKV_DECAY_LORA, RWKV_WIDTH), 0.1 * RWKV_DECAY_LORA ** -0.5),
        "rw_a0": nrm((L, RWKV_WIDTH), 0.1),
        "rw_a2": nrm((L, RWKV_A_LORA, RWKV_WIDTH), 0.1 * RWKV_A_LORA ** -0.5),
        "rw_g2": nrm((L, RWKV_G_LORA, RWKV_WIDTH), RWKV_G_LORA ** -0.5),
        "rw_k_k": 0.85 + nrm((L, RWKV_WIDTH), 0.02),
        "rw_k_a": 1.0 + nrm((L, RWKV_WIDTH), 0.02),
        "rw_r_k": nrm((L, RWKV_HEADS, RWKV_HEAD), 0.1),
        "rw_ln_g": 1.0 + nrm((L, RWKV_WIDTH), 0.02),
        "rw_ln_b": nrm((L, RWKV_WIDTH), 0.02),
        "rw_v0": 1.0 + nrm((L - 1, RWKV_WIDTH), 0.1),
        "rw_v1": nrm((L - 1, RWKV_WIDTH, RWKV_V_LORA), RWKV_WIDTH ** -0.5),
        "rw_v2": nrm((L - 1, RWKV_V_LORA, RWKV_WIDTH), 0.1 * RWKV_V_LORA ** -0.5),
        "mla_q_norm_g": 1.0 + nrm((L, MLA_Q_RANK), 0.02),
        "mla_kv_norm_g": 1.0 + nrm((L, MLA_KV_RANK), 0.02),
        "mla_w_q_up": nrm((L, MLA_Q_RANK, MLA_HEADS * (MLA_NOPE + MLA_ROPE)), MLA_Q_RANK ** -0.5),
        "mla_w_kv_up": nrm((L, MLA_KV_RANK, MLA_HEADS * (MLA_NOPE + MLA_V)), MLA_KV_RANK ** -0.5),
        "router_w": nrm((L, D_MODEL, N_EXPERTS), D_MODEL ** -0.5),
        "router_b": nrm((L, N_EXPERTS), 0.01),
        "ex_w_gate": nrm((L, N_EXPERTS, D_MODEL, D_EXPERT), D_MODEL ** -0.5),
        "ex_b_gate": nrm((L, N_EXPERTS, D_EXPERT), 0.01),
        "ex_w_up": nrm((L, N_EXPERTS, D_MODEL, D_EXPERT), D_MODEL ** -0.5),
        "ex_b_up": nrm((L, N_EXPERTS, D_EXPERT), 0.01),
        "ex_w_down": nrm((L, N_EXPERTS, D_EXPERT, D_MODEL), D_EXPERT ** -0.5),
        "ex_b_down": nrm((L, N_EXPERTS, D_MODEL), 0.01),
        "final_norm_g": 1.0 + nrm((D_MODEL,), 0.02),
    }
    return inp


def reference(x, c, positions, ada_w, ada_b, norm_mix_g, norm_ffn_g, w_in, w_out,
              s5_lambda_re, s5_lambda_im, s5_log_step, s5_b_re, s5_b_im, s5_c_re, s5_c_im,
              s5_d, s5_glu_w, s5_glu_b,
              rw_mu, rw_w0, rw_w2, rw_a0, rw_a2, rw_g2, rw_k_k, rw_k_a, rw_r_k, rw_ln_g, rw_ln_b,
              rw_v0, rw_v1, rw_v2,
              mla_q_norm_g, mla_kv_norm_g, mla_w_q_up, mla_w_kv_up,
              router_w, router_b, ex_w_gate, ex_b_gate, ex_w_up, ex_b_up, ex_w_down, ex_b_down,
              final_norm_g):
    split_pts = np.cumsum([S5_WIDTH, RWKV_IN, MLA_IN]).tolist()
    cond = jax.nn.silu(c)
    v_first = None
    for l in range(DEPTH):
        mod = (cond @ ada_w[l] + ada_b[l])[:, None, :]
        sh1, sc1, g1, sh2, sc2, g2 = jnp.split(mod, N_MOD, axis=-1)
        hn = rmsnorm(x, norm_mix_g[l]) * (1.0 + sc1) + sh1
        proj = hn @ w_in[l]
        s5_u, rw_in, mla_in, ret_in = jnp.split(proj, split_pts, axis=-1)
        y_s5 = s5_mixer(s5_u, s5_lambda_re[l], s5_lambda_im[l], s5_log_step[l], s5_b_re[l], s5_b_im[l],
                        s5_c_re[l], s5_c_im[l], s5_d[l], s5_glu_w[l], s5_glu_b[l])
        vmix = None if l == 0 else (rw_v0[l - 1], rw_v1[l - 1], rw_v2[l - 1])
        y_rw, v_first = rwkv7_mixer(rw_in, v_first, rw_mu[l], rw_w0[l], rw_w2[l], rw_a0[l], rw_a2[l],
                                    rw_g2[l], rw_k_k[l], rw_k_a[l], rw_r_k[l], rw_ln_g[l], rw_ln_b[l], vmix)
        y_mla = mla_mixer(mla_in, positions, mla_q_norm_g[l], mla_kv_norm_g[l], mla_w_q_up[l], mla_w_kv_up[l])
        y_ret = retention_mixer(ret_in, positions)
        mixed = jnp.concatenate([y_s5, y_rw.astype(x.dtype), y_mla.astype(x.dtype), y_ret], axis=-1) @ w_out[l]
        x = x + g1 * mixed
        hn = rmsnorm(x, norm_ffn_g[l]) * (1.0 + sc2) + sh2
        x = x + g2 * moe_ffn(hn, router_w[l], router_b[l], ex_w_gate[l], ex_b_gate[l], ex_w_up[l], ex_b_up[l],
                             ex_w_down[l], ex_b_down[l])
    return rmsnorm(x, final_norm_g)
```

```cpp
#include <hip/hip_runtime.h>
#include <cstdint>
#include <cstdio>

#define LAS __attribute__((address_space(3)))
#define GAS __attribute__((address_space(1)))
typedef unsigned short bf16_t;
typedef short bf16x8 __attribute__((ext_vector_type(8)));
typedef float f32x2 __attribute__((ext_vector_type(2)));
typedef float f32x4 __attribute__((ext_vector_type(4)));
typedef float f32x16 __attribute__((ext_vector_type(16)));
typedef unsigned u32x2 __attribute__((ext_vector_type(2)));
typedef unsigned u32x4 __attribute__((ext_vector_type(4)));

constexpr int NB = 8, SEQ = 8192, T = NB * SEQ, D = 1024, DEPTH = 4;
constexpr int INW = 2464, INWP = 2560;
constexpr int C_S5 = 0, C_RWR = 256, C_RWK = 512, C_RWV = 768, C_RWWD = 1024, C_QC = 1280, C_KVC = 1536, C_KPE = 1664;
constexpr int C_RQ = 1696, C_RK = 1824, C_RV = 1952, C_RG = 2208;
constexpr int NE = 32, TOPK = 4, PMAX = 270336  , MAXTILES = 1056;
constexpr float NORM_EPS = 1e-5f;

constexpr size_t MiB = 1u << 20;
constexpr size_t WS_CTL = 0, CTL_ZERO_BYTES = 1 * MiB;
constexpr size_t WS_MOD = 1 * MiB;
constexpr size_t WS_ROPE = 2 * MiB;
constexpr size_t WS_WIN = 10 * MiB;
constexpr size_t WS_WOUT = 15 * MiB;
constexpr size_t WS_WSM = 17 * MiB;
constexpr size_t WS_WGU = 21 * MiB;
constexpr size_t WS_WDN = 149 * MiB;
constexpr size_t WS_HN8 = 85 * MiB;
constexpr size_t WS_HN = 213 * MiB;
constexpr size_t WS_VF = 341 * MiB;
constexpr size_t WS_MOE = 405 * MiB;
constexpr size_t WS_REG = 413 * MiB;
constexpr size_t R_PROJ = WS_REG;
constexpr size_t R_MIX = R_PROJ + 320 * MiB;
constexpr size_t R_AP = R_MIX + 128 * MiB;
constexpr size_t R_E = R_AP;
constexpr size_t R_CKV = R_AP + 8 * MiB;
constexpr size_t R_YG = R_AP + 24 * MiB;
constexpr size_t R_LO = R_AP + 64 * MiB;
constexpr size_t R_SI = R_LO + 128 * MiB;
constexpr size_t R_QKV = R_SI + 384 * MiB;
constexpr size_t R_YRAW = R_QKV;
constexpr size_t R_BU = R_QKV + 128 * MiB;
constexpr size_t R_UP = R_BU;
constexpr size_t R_EB = R_BU + 64 * MiB;
constexpr size_t R_WE = R_BU + 96 * MiB;
constexpr size_t R_WY = R_BU + 104 * MiB;
constexpr size_t WS_KD = R_BU + 120 * MiB;
constexpr size_t WS_S5TAB = R_BU + 124 * MiB;
constexpr size_t R_QB = R_BU + 256 * MiB;
constexpr size_t R_KT = R_QB + 48 * MiB;
constexpr size_t R_VT = R_KT + 48 * MiB;
constexpr size_t R_END = R_VT + 32 * MiB;
constexpr size_t R_H = WS_REG;
constexpr size_t R_Y = WS_REG + 528 * MiB;
constexpr size_t WS_END = R_END;
static_assert(R_Y + 528 * MiB <= R_END, "MoE overlay fits the region");
constexpr size_t SM_WQ = 0;
constexpr size_t SM_WKV = 256 * 1024;
constexpr size_t SM_WLORA = 512 * 1024;
constexpr size_t SM_WVV = 896 * 1024;
constexpr size_t SM_WGLU = 1024 * 1024;
constexpr size_t SM_WBU = 1152 * 1024;
constexpr size_t SM_WC = 2176 * 1024;
constexpr size_t MO_IDX = WS_MOE, MO_W = WS_MOE + 1 * MiB, MO_POS = WS_MOE + 2 * MiB, MO_ROWTOK = WS_MOE + 3 * MiB, MO_BLKCNT = WS_MOE + 5 * MiB, MO_TILEE = WS_MOE + 5 * MiB + 64 * 1024;
constexpr int CW_NTILES = 16, CW_ATTQ = 64  , CW_BAR = 4096;

constexpr int NWAVES = 8, NTHR = 512;
constexpr int LDS_BYTES = 147456;
constexpr int MISC_OFF = 131072 + 8192;


__device__ __forceinline__ float bf2f(unsigned h) { return __builtin_bit_cast(float, h << 16); }
__device__ __forceinline__ float bflo(unsigned w) { return __builtin_bit_cast(float, w << 16); }
__device__ __forceinline__ float bfhi(unsigned w) { return __builtin_bit_cast(float, w & 0xffff0000u); }
typedef __bf16 bf16x2_t __attribute__((ext_vector_type(2)));
__device__ __forceinline__ unsigned cvt_pk_bf16(float lo, float hi) { const f32x2 v = {lo, hi}; const bf16x2_t b = __builtin_convertvector(v, bf16x2_t); return __builtin_bit_cast(unsigned, b); }
__device__ __forceinline__ u32x4 zero4() { unsigned z = 0u; asm volatile("" : "+v"(z)); u32x4 w; w.x = z; w.y = z; w.z = z; w.w = z; return w; }
__device__ __forceinline__ unsigned pk2(float lo, float hi) { return cvt_pk_bf16(lo, hi); }
__device__ __forceinline__ unsigned f2bf(float f) { return cvt_pk_bf16(f, f) & 0xffffu; }
__device__ __forceinline__ unsigned pk4_fp8(float a0, float a1, float a2, float a3) { int w = 0; w = __builtin_amdgcn_cvt_pk_fp8_f32(a0, a1, w, false); w = __builtin_amdgcn_cvt_pk_fp8_f32(a2, a3, w, true); return (unsigned)w; }
__device__ __forceinline__ bf16_t cvt1(float x) { return (bf16_t)(cvt_pk_bf16(x, x) & 0xffffu); }
__device__ __forceinline__ float sigmoidf_(float x) { return __builtin_amdgcn_rcpf(1.0f + __expf(-x)); }
template <int CTRL> __device__ __forceinline__ float dpp_f(float v) { return __builtin_bit_cast(float, __builtin_amdgcn_update_dpp(0, __builtin_bit_cast(int, v), CTRL, 0xF, 0xF, true)); }
__device__ __forceinline__ float wave_sum(float v) {
    v += dpp_f<0xB1>(v);
    v += dpp_f<0x4E>(v);
    v += dpp_f<0x141>(v);
    v += dpp_f<0x140>(v);
    const float a = __builtin_bit_cast(float, __builtin_amdgcn_readlane(__builtin_bit_cast(int, v), 0));
    const float b = __builtin_bit_cast(float, __builtin_amdgcn_readlane(__builtin_bit_cast(int, v), 16));
    const float c = __builtin_bit_cast(float, __builtin_amdgcn_readlane(__builtin_bit_cast(int, v), 32));
    const float d = __builtin_bit_cast(float, __builtin_amdgcn_readlane(__builtin_bit_cast(int, v), 48));
    return (a + b) + (c + d);
}
template <int CTRL, int RM> __device__ __forceinline__ float dpp_fm(float v) { return __builtin_bit_cast(float, __builtin_amdgcn_update_dpp(0, __builtin_bit_cast(int, v), CTRL, RM, 0xF, false)); }
__device__ __forceinline__ float wave_sum_bc(float v) {
    v += dpp_f<0xB1>(v); v += dpp_f<0x4E>(v); v += dpp_f<0x141>(v); v += dpp_f<0x140>(v);
    v += dpp_fm<0x142, 0xA>(v);
    v += dpp_fm<0x143, 0xC>(v);
    return __builtin_bit_cast(float, __builtin_amdgcn_readlane(__builtin_bit_cast(int, v), 63));
}
__device__ __forceinline__ int lds_add(LAS int* p) { return __hip_atomic_fetch_add(p, 1, __ATOMIC_RELAXED, __HIP_MEMORY_SCOPE_WORKGROUP); }
__device__ __forceinline__ float wave_sum_shfl(float v) {
#pragma unroll
    for (int o = 1; o < 64; o <<= 1) v += __shfl_xor(v, o);
    return v;
}

namespace pg8 {
constexpr int BM = 256, BK = 64, HALF = 128, HTB = HALF * BK * 2, STAGE_BYTES = 8 * HTB, NXCD = 8, WGM = 8;
__host__ __device__ __forceinline__ int lds_byte(int r, int c) { const int st = (r >> 4) * 2 + (c >> 5), rr = r & 15, cc = c & 31, ob = rr * 64 + cc * 2; return st * 1024 + (ob ^ (((ob >> 9) & 1) << 5)); }
__host__ __device__ __forceinline__ void stage_rc(int b, int& R, int& C) { const int st = b / 1024, sb = b % 1024, swz = sb ^ (((sb >> 9) & 1) << 5); R = (st >> 1) * 16 + swz / 64; C = (st & 1) * 32 + (swz % 64) / 2; }
__host__ __device__ __forceinline__ int perm32(int rho) { const int n = rho >> 4, i = rho & 15; return 8 * (i >> 2) + 4 * n + (i & 3); }

struct Unit { int pm, pn; };
struct Gemm { const bf16_t* A; const bf16_t* Bt; int lda, ldb, K; const int* rowtok; };

struct Order {
    int nM, nN, nwg, G, c; const int* tile_e; size_t bstride;
    __device__ void init(int nM_, int nN_, int G_, int c_, const int* te = nullptr, size_t bs = 0) { nM = nM_; nN = nN_; nwg = nM * nN; G = G_; c = c_; tile_e = te; bstride = bs; }
    __device__ bool next(int i, Unit& u) const {
        const long L = (long)i * G + c; if (L >= nwg) return false;
        int wgid = (int)L; { const int q = nwg / NXCD, r = nwg % NXCD, xcd = wgid % NXCD, off = wgid / NXCD; wgid = (xcd < r ? xcd * (q + 1) : r * (q + 1) + (xcd - r) * q) + off; }
        const int nig = WGM * nN, gid = wgid / nig, fm = gid * WGM, gsz = (nM - fm) < WGM ? (nM - fm) : WGM;
        u.pm = fm + ((wgid % nig) % gsz); u.pn = (wgid % nig) / gsz; return true;
    }
    __device__ __forceinline__ int expert(const Unit& u) const { return tile_e ? __builtin_amdgcn_readfirstlane(tile_e[u.pm]) : 0; }
};

typedef int v8i_t __attribute__((ext_vector_type(8)));
template <class Epi, bool GATHER, bool FP8 = false>
__device__ __forceinline__ void gemm_phase(LAS unsigned char* lds, const Gemm g, const Order& S, const Epi& E, int tid_in) {
    int tid = tid_in; asm volatile("" : "+v"(tid));
    const int wid = __builtin_amdgcn_readfirstlane(tid >> 6), lane = tid & 63, wr = wid >> 2, wc = wid & 3, fr = lane & 15, fq = lane >> 4;
    const int K = g.K, nt = K / BK;
    int Rst[2], Cst[2];
    unsigned voffB[2], vAc[2][2], vAn[2][2];
#pragma unroll
    for (int i = 0; i < 2; ++i) { int R, C; stage_rc(tid * 16 + i * 8192, R, C); Rst[i] = R; Cst[i] = C; const int Rb = Epi::PERM ? ((R & ~31) + perm32(R & 31)) : R;
        voffB[i] = (unsigned)(Rb * g.ldb + C) * 2u; }
    const size_t kstep = (size_t)(BK * 2);
    const size_t hstepB = (size_t)HALF * g.ldb * 2;
    const unsigned ldsw = (unsigned)wid * 1024u;
    const int aoff = lds_byte(wr * 64 + fr, fq * 8), boff = lds_byte(wc * 32 + fr, fq * 8);
    const int aoff1 = aoff + 1024, boff1 = boff + 1024;
#define PG8_SA(b, h) (((b) * 2 + (h)) * HTB)
#define PG8_SB(b, h) ((4 + (b) * 2 + (h)) * HTB)
#define PG8_STAGE(bufoff, gbase, voff) do { _Pragma("unroll") for (int _i = 0; _i < 2; ++_i) \
        __builtin_amdgcn_global_load_lds((const unsigned*)((const char*)(gbase) + (voff)[_i]), (LAS unsigned*)(lds + (bufoff) + ldsw + _i * 8192), 16, 0, 0); } while (0)
#define PG8_LD8(p0, p1) __builtin_bit_cast(v8i_t, __builtin_shufflevector(*(const LAS u32x4*)(p0), *(const LAS u32x4*)(p1), 0, 1, 2, 3, 4, 5, 6, 7))
#define PG8_LDA(dst, b, h) do { _Pragma("unroll") for (int m = 0; m < 4; ++m) { if (FP8) { dst##8[m] = PG8_LD8(lds + PG8_SA(b, h) + aoff + m * 2048, lds + PG8_SA(b, h) + aoff1 + m * 2048); } \
        else { _Pragma("unroll") for (int k = 0; k < 2; ++k) dst[m][k] = *(const LAS bf16x8*)(lds + PG8_SA(b, h) + aoff + m * 2048 + k * 1024); } } } while (0)
#define PG8_LDB(dst, b, h) do { _Pragma("unroll") for (int n = 0; n < 2; ++n) { if (FP8) { dst##8[n] = PG8_LD8(lds + PG8_SB(b, h) + boff + n * 2048, lds + PG8_SB(b, h) + boff1 + n * 2048); } \
        else { _Pragma("unroll") for (int k = 0; k < 2; ++k) dst[n][k] = *(const LAS bf16x8*)(lds + PG8_SB(b, h) + boff + n * 2048 + k * 1024); } } } while (0)
#define PG8_V8(x) __builtin_bit_cast(v8i_t, __builtin_shufflevector(__builtin_bit_cast(u32x4, x[0]), __builtin_bit_cast(u32x4, x[1]), 0, 1, 2, 3, 4, 5, 6, 7))
#define PG8_MMA(ai, bj, At, Bt) do { __builtin_amdgcn_s_setprio(1); _Pragma("unroll") for (int m = 0; m < 4; ++m) _Pragma("unroll") for (int n = 0; n < 2; ++n) { \
        if (FP8) asm volatile("v_mfma_scale_f32_16x16x128_f8f6f4 %0, %1, %2, %0, %3, %4 op_sel_hi:[0,0,0]" : "+v"(acc[ai][bj][m][n]) : "v"(Bt##8[n]), "v"(At##8[m]), "v"(scB), "v"(scA)); \
        else { _Pragma("unroll") for (int k = 0; k < 2; ++k) acc[ai][bj][m][n] = __builtin_amdgcn_mfma_f32_16x16x32_bf16(Bt[n][k], At[m][k], acc[ai][bj][m][n], 0, 0, 0); } } __builtin_amdgcn_s_setprio(0); } while (0)
#define PG8_WAIT_V(n) asm volatile("s_waitcnt vmcnt(" #n ")" ::: "memory")
#define PG8_WAIT_L(n) asm volatile("s_waitcnt lgkmcnt(" #n ")" ::: "memory")
#define PG8_BAR __builtin_amdgcn_s_barrier()
#define PG8_SCHED __builtin_amdgcn_sched_barrier(0)
#define PG8_AOFFS(dst, unit) do { int _t = tid; if (GATHER) asm volatile("" : "+v"(_t)); _Pragma("unroll") for (int _h = 0; _h < 2; ++_h) _Pragma("unroll") for (int _i = 0; _i < 2; ++_i) { \
        if (GATHER) { int _R, _C; stage_rc(_t * 16 + _i * 8192, _R, _C);        \
            const int _tok = g.rowtok[(unit).pm * BM + _h * HALF + _R]; dst[_h][_i] = (unsigned)(_tok * g.lda + _C) * 2u; } \
        else dst[_h][_i] = (unsigned)((_h * HALF + Rst[_i]) * g.lda + Cst[_i]) * 2u; } } while (0)
    Unit cur, nxt; int ui = 0;
    if (!S.next(0, cur)) return;
    f32x4 acc[2][2][4][2];
#pragma unroll
    for (int a = 0; a < 2; ++a)
#pragma unroll
        for (int b = 0; b < 2; ++b)
#pragma unroll
            for (int m = 0; m < 4; ++m)
#pragma unroll
                for (int n = 0; n < 2; ++n) acc[a][b][m][n] = (f32x4){0.f, 0.f, 0.f, 0.f};
    bf16x8 At[4][2], B0[2][2], B1[2][2];
    v8i_t At8[4], B08[2], B18[2];
    const int scB = 0x7a7a7a7a, scA = 0x7f7f7f7f;
    const size_t tstepA = GATHER ? 0 : (size_t)BM * g.lda * 2, tstepB = (size_t)BM * g.ldb * 2;
    const char* cA = (const char*)g.A + (size_t)cur.pm * tstepA;
    const char* cB = (const char*)g.Bt + ((size_t)S.expert(cur) * S.bstride) * 2 + (size_t)cur.pn * tstepB;
    PG8_AOFFS(vAc, cur);
    if (GATHER) { asm volatile("s_waitcnt vmcnt(0)" ::: "memory"); }
    PG8_STAGE(PG8_SB(0, 0), cB, voffB); PG8_STAGE(PG8_SB(0, 1), cB + hstepB, voffB); PG8_STAGE(PG8_SA(0, 0), cA, vAc[0]); PG8_STAGE(PG8_SA(0, 1), cA, vAc[1]);
    if (wr == 1) PG8_BAR;
    PG8_WAIT_V(2); PG8_BAR;
    PG8_STAGE(PG8_SB(1, 0), cB + kstep, voffB); PG8_STAGE(PG8_SA(1, 0), cA + kstep, vAc[0]); PG8_STAGE(PG8_SB(1, 1), cB + hstepB + kstep, voffB);
    PG8_WAIT_V(6); PG8_BAR;
    for (;;) {
        if constexpr (Epi::PRE && FP8) { if (wid == 0) E.pre_dma(lds + 131072 + (ui & 1) * 1024, cur, S.expert(cur), fq * 16 + fr); }
        const bool has_next = S.next(ui + 1, nxt);
        const char* nA = cA; const char* nB = cB;
        if (has_next) { nA = (const char*)g.A + (size_t)nxt.pm * tstepA; nB = (const char*)g.Bt + ((size_t)S.expert(nxt) * S.bstride) * 2 + (size_t)nxt.pn * tstepB; PG8_AOFFS(vAn, nxt); }
        else {
#pragma unroll
            for (int h = 0; h < 2; ++h)
#pragma unroll
                for (int i = 0; i < 2; ++i) vAn[h][i] = vAc[h][i];
        }
        if (GATHER) { asm volatile("" : "+v"(vAn[0][0]), "+v"(vAn[0][1]), "+v"(vAn[1][0]), "+v"(vAn[1][1])); }
#pragma nounroll
        for (int t = 0; t < nt; t += 2) {
            const bool last = (t == nt - 2);
            const char* a1 = cA + (size_t)(t + 1) * kstep;
            const char* a2 = last ? nA : cA + (size_t)(t + 2) * kstep; const char* b2 = last ? nB : cB + (size_t)(t + 2) * kstep;
            const char* a3 = a2 + kstep; const char* b3 = b2 + kstep;
            unsigned v2[2][2];
#pragma unroll
            for (int h = 0; h < 2; ++h)
#pragma unroll
                for (int i = 0; i < 2; ++i) v2[h][i] = (GATHER && last) ? vAn[h][i] : vAc[h][i];
            PG8_LDB(B0, 0, 0); PG8_LDB(B1, 0, 1); PG8_SCHED; PG8_LDA(At, 0, 0); PG8_STAGE(PG8_SA(1, 1), a1, vAc[1]);
            PG8_WAIT_V(8); PG8_WAIT_L(0); PG8_BAR; PG8_MMA(0, 0, At, B0); PG8_MMA(0, 1, At, B1); PG8_BAR; PG8_SCHED;
            PG8_LDA(At, 0, 1); PG8_STAGE(PG8_SB(0, 0), b2, voffB); PG8_STAGE(PG8_SB(0, 1), b2 + hstepB, voffB); PG8_STAGE(PG8_SA(0, 0), a2, v2[0]);
            PG8_WAIT_V(8); PG8_WAIT_L(0); PG8_BAR; PG8_MMA(1, 0, At, B0); PG8_MMA(1, 1, At, B1); PG8_BAR; PG8_SCHED;
            PG8_LDB(B0, 1, 0); PG8_LDB(B1, 1, 1); PG8_SCHED; PG8_LDA(At, 1, 0); PG8_STAGE(PG8_SA(0, 1), a2, v2[1]);
            PG8_WAIT_V(8); PG8_WAIT_L(0); PG8_BAR; PG8_MMA(0, 0, At, B0); PG8_MMA(0, 1, At, B1); PG8_BAR; PG8_SCHED;
            PG8_LDA(At, 1, 1); PG8_STAGE(PG8_SB(1, 0), b3, voffB); PG8_STAGE(PG8_SB(1, 1), b3 + hstepB, voffB); PG8_STAGE(PG8_SA(1, 0), a3, v2[0]);
            PG8_WAIT_V(8); PG8_WAIT_L(0); PG8_BAR; PG8_MMA(1, 0, At, B0); PG8_MMA(1, 1, At, B1); PG8_BAR; PG8_SCHED;
        }
        if (wr == 0) PG8_BAR;
        if (FP8) asm volatile("s_nop 15\n\ts_nop 15" ::: "memory");
        if constexpr (Epi::PRE && FP8) E(acc, cur, S.expert(cur), wr, wc, fr, fq, (const LAS float*)(lds + 131072 + (ui & 1) * 1024)); else E(acc, cur, S.expert(cur), wr, wc, fr, fq);
        if (!has_next) break;
#pragma unroll
        for (int a = 0; a < 2; ++a)
#pragma unroll
            for (int b = 0; b < 2; ++b)
#pragma unroll
                for (int m = 0; m < 4; ++m)
#pragma unroll
                    for (int n = 0; n < 2; ++n) acc[a][b][m][n] = (f32x4){0.f, 0.f, 0.f, 0.f};
        cur = nxt; cA = nA; cB = nB; ++ui;
#pragma unroll
        for (int h = 0; h < 2; ++h)
#pragma unroll
            for (int i = 0; i < 2; ++i) vAc[h][i] = vAn[h][i];
        if (wr == 1) PG8_BAR;
    }
    PG8_WAIT_V(0);
    PG8_BAR;
#undef PG8_SA
#undef PG8_SB
#undef PG8_STAGE
#undef PG8_LDA
#undef PG8_LDB
#undef PG8_MMA
#undef PG8_V8
#undef PG8_LD8
#undef PG8_WAIT_V
#undef PG8_WAIT_L
#undef PG8_BAR
#undef PG8_SCHED
#undef PG8_AOFFS
}

struct EpiBf16 {
    static constexpr bool PERM = true; static constexpr bool PRE = true;
    bf16_t* O; int ldc; const float* bias; int bias_estride; int nt;
    __device__ __forceinline__ void pre_dma(LAS unsigned char* dst, const Unit& u, int e, int lane) const {
        __builtin_amdgcn_global_load_lds((const unsigned*)(bias + (size_t)e * bias_estride + u.pn * BM + 4 * lane), (LAS unsigned*)dst, 16, 0, 0); }
    __device__ __forceinline__ void operator()(const f32x4 (&acc)[2][2][4][2], const Unit& u, int e, int wr, int wc, int fr, int fq, const LAS float* pb = nullptr) const {
        asm volatile("" : "+v"(fq), "+v"(fr));
        const int row0 = u.pm * BM + wr * 64 + fr, col0 = u.pn * BM + wc * 32 + 8 * fq;
        f32x4 bv[2][2];
#pragma unroll
        for (int bj = 0; bj < 2; ++bj)
#pragma unroll
            for (int n = 0; n < 2; ++n) bv[bj][n] = pb ? *(const LAS f32x4*)(pb + wc * 32 + 8 * fq + bj * HALF + 4 * n) : (bias ? *(const f32x4*)(bias + (size_t)e * bias_estride + col0 + bj * HALF + 4 * n) : (f32x4){0.f, 0.f, 0.f, 0.f});
#pragma unroll
        for (int ai = 0; ai < 2; ++ai)
#pragma unroll
            for (int m = 0; m < 4; ++m) { bf16_t* rowp = O + (size_t)(row0 + ai * HALF + m * 16) * ldc + col0;
#pragma unroll
                for (int bj = 0; bj < 2; ++bj) { const f32x4 v0 = acc[ai][bj][m][0] + bv[bj][0], v1 = acc[ai][bj][m][1] + bv[bj][1];
                    u32x4 w; w.x = cvt_pk_bf16(v0[0], v0[1]); w.y = cvt_pk_bf16(v0[2], v0[3]); w.z = cvt_pk_bf16(v1[0], v1[1]); w.w = cvt_pk_bf16(v1[2], v1[3]);
                    if (nt) __builtin_nontemporal_store(w, (u32x4*)(rowp + bj * HALF)); else *(u32x4*)(rowp + bj * HALF) = w; } }
    }
};
struct EpiResid {
    static constexpr bool PERM = false; static constexpr bool PRE = false;
    const float* R; float* X; const float* gate;
    __device__ __forceinline__ void operator()(const f32x4 (&acc)[2][2][4][2], const Unit& u, int, int wr, int wc, int fr, int fq) const {
        asm volatile("" : "+v"(fq), "+v"(fr));
        const int col0 = u.pn * BM + wc * 32 + 4 * fq; const int b = (u.pm * BM) / SEQ;
        f32x4 gv[2][2];
#pragma unroll
        for (int bj = 0; bj < 2; ++bj)
#pragma unroll
            for (int n = 0; n < 2; ++n) gv[bj][n] = *(const f32x4*)(gate + (size_t)b * 6144 + col0 + bj * HALF + n * 16);
#pragma unroll
        for (int ai = 0; ai < 2; ++ai)
#pragma unroll
            for (int m = 0; m < 4; ++m) { const size_t off = (size_t)(u.pm * BM + ai * HALF + wr * 64 + m * 16 + fr) * D + col0;
#pragma unroll
                for (int bj = 0; bj < 2; ++bj)
#pragma unroll
                    for (int n = 0; n < 2; ++n) { const f32x4 r = *(const f32x4*)(R + off + bj * HALF + n * 16); *(f32x4*)(X + off + bj * HALF + n * 16) = r + gv[bj][n] * acc[ai][bj][m][n]; } }
    }
};
struct EpiSwiglu {
    static constexpr bool PERM = true; static constexpr bool PRE = true;
    unsigned char* H; const float* bg; const float* bu;
    __device__ __forceinline__ void pre_dma(LAS unsigned char* dst, const Unit& u, int e, int lane) const {
        const float* src = (lane < 32 ? bg : bu) + (size_t)e * 1024 + u.pn * HALF + 4 * (lane & 31);
        __builtin_amdgcn_global_load_lds((const unsigned*)src, (LAS unsigned*)dst, 16, 0, 0); }
    __device__ __forceinline__ void operator()(const f32x4 (&acc)[2][2][4][2], const Unit& u, int e, int wr, int wc, int fr, int fq, const LAS float* pb) const {
        asm volatile("" : "+v"(fq), "+v"(fr));
        const int row0 = u.pm * BM + wr * 64 + fr, col0 = u.pn * HALF + wc * 32 + 8 * fq;
        const int cl = wc * 32 + 8 * fq;
        f32x4 g0 = *(const LAS f32x4*)(pb + cl), g1 = *(const LAS f32x4*)(pb + cl + 4);
        f32x4 u0 = *(const LAS f32x4*)(pb + 128 + cl), u1 = *(const LAS f32x4*)(pb + 128 + cl + 4);
#pragma unroll
        for (int ai = 0; ai < 2; ++ai)
#pragma unroll
            for (int m = 0; m < 4; ++m) {
                float o[8];
#pragma unroll
                for (int n = 0; n < 2; ++n)
#pragma unroll
                    for (int j = 0; j < 4; ++j) {
                        float gt = acc[ai][0][m][n][j] + (n ? g1[j] : g0[j]); gt = fminf(gt, 7.0f);
                        float up = acc[ai][1][m][n][j] + (n ? u1[j] : u0[j]); up = fminf(fmaxf(up, -7.0f), 7.0f);
                        o[n * 4 + j] = gt * sigmoidf_(1.702f * gt) * (up + 1.0f);
                    }
                u32x2 w; w.x = pk4_fp8(o[0], o[1], o[2], o[3]); w.y = pk4_fp8(o[4], o[5], o[6], o[7]);
                *(u32x2*)(H + (size_t)(row0 + ai * HALF + m * 16) * 1024 + col0) = w;
            }
    }
};
struct EpiS5C {
    static constexpr bool PERM = true; static constexpr bool PRE = false;
    bf16_t* YG; const bf16_t* PROJ; const float* dskip;
    __device__ __forceinline__ void operator()(const f32x4 (&acc)[2][2][4][2], const Unit& u, int, int wr, int wc, int fr, int fq) const {
        asm volatile("" : "+v"(fq), "+v"(fr));
        const int row0 = u.pm * BM + wr * 64 + fr, col0 = wc * 32 + 8 * fq;
#pragma unroll
        for (int ai = 0; ai < 2; ++ai)
#pragma unroll
            for (int m = 0; m < 4; ++m) { const size_t row = (size_t)(row0 + ai * HALF + m * 16);
#pragma unroll
                for (int bj = 0; bj < 2; ++bj) { const int c = col0 + bj * HALF;
                    const u32x4 uu = *(const u32x4*)(PROJ + row * INWP + C_S5 + c);
                    const f32x4 d0 = *(const f32x4*)(dskip + c), d1 = *(const f32x4*)(dskip + c + 4);
                    float y[8]; const unsigned uw[4] = {uu.x, uu.y, uu.z, uu.w};
#pragma unroll
                    for (int j = 0; j < 8; ++j) { const float uj = (j & 1) ? bfhi(uw[j >> 1]) : bflo(uw[j >> 1]); const float dj = j < 4 ? d0[j & 3] : d1[j & 3];
                        const float v = acc[ai][bj][m][j >> 2][j & 3] + dj * uj;
                        const float tt = 0.7978845608028654f * (v + 0.044715f * v * v * v);
                        const float th = 1.0f - 2.0f * __builtin_amdgcn_rcpf(1.0f + __expf(2.0f * tt));
                        y[j] = 0.5f * v * (1.0f + th); }
                    u32x4 w; w.x = cvt_pk_bf16(y[0], y[1]); w.y = cvt_pk_bf16(y[2], y[3]); w.z = cvt_pk_bf16(y[4], y[5]); w.w = cvt_pk_bf16(y[6], y[7]);
                    *(u32x4*)(YG + row * 256 + c) = w; asm volatile("" ::: "memory"); } }
    }
};
struct EpiS5E {
    static constexpr bool PERM = false; static constexpr bool PRE = false;
    float* EB;
    __device__ __forceinline__ void operator()(const f32x4 (&acc)[2][2][4][2], const Unit& u, int, int wr, int wc, int fr, int fq) const {
        asm volatile("" : "+v"(fq), "+v"(fr));
#pragma unroll
        for (int ai = 0; ai < 2; ++ai)
#pragma unroll
            for (int m = 0; m < 4; ++m) { float* rp = EB + (size_t)(u.pm * BM + ai * HALF + wr * 64 + m * 16 + fr) * 128 + wc * 32 + 4 * fq;
#pragma unroll
                for (int n = 0; n < 2; ++n) *(f32x4*)(rp + n * 16) = acc[ai][0][m][n]; }
    }
};
struct EpiS5Y {
    static constexpr bool PERM = true; static constexpr bool PRE = false;
    bf16_t* YG; const bf16_t* PROJ; const float* dskip;
    __device__ __forceinline__ void operator()(const f32x4 (&acc)[2][2][4][2], const Unit& u, int, int wr, int wc, int fr, int fq) const {
        asm volatile("" : "+v"(fq), "+v"(fr));
        const int g = u.pm >> 3;
#pragma unroll
        for (int ai = 0; ai < 2; ++ai)
#pragma unroll
            for (int m = 0; m < 4; ++m) { const int chunk = (u.pm & 7) * BM + ai * HALF + wr * 64 + m * 16 + fr;
#pragma unroll
                for (int bj = 0; bj < 2; ++bj) { const int col = u.pn * BM + bj * HALF + wc * 32 + 8 * fq, tau = col >> 4, c = g * 16 + (col & 15); const size_t tok = (size_t)chunk * 32 + tau;
                    const u32x4 uu = *(const u32x4*)(PROJ + tok * INWP + C_S5 + c);
                    const f32x4 d0 = *(const f32x4*)(dskip + c), d1 = *(const f32x4*)(dskip + c + 4);
                    float y[8]; const unsigned uw[4] = {uu.x, uu.y, uu.z, uu.w};
#pragma unroll
                    for (int j = 0; j < 8; ++j) { const float uj = (j & 1) ? bfhi(uw[j >> 1]) : bflo(uw[j >> 1]); const float dj = j < 4 ? d0[j & 3] : d1[j & 3];
                        const float v = acc[ai][bj][m][j >> 2][j & 3] + dj * uj;
                        const float tt = 0.7978845608028654f * (v + 0.044715f * v * v * v);
                        const float th = 1.0f - 2.0f * __builtin_amdgcn_rcpf(1.0f + __expf(2.0f * tt));
                        y[j] = 0.5f * v * (1.0f + th); }
                    u32x4 w; w.x = cvt_pk_bf16(y[0], y[1]); w.y = cvt_pk_bf16(y[2], y[3]); w.z = cvt_pk_bf16(y[4], y[5]); w.w = cvt_pk_bf16(y[6], y[7]);
                    *(u32x4*)(YG + tok * 256 + c) = w; asm volatile("" ::: "memory"); } }
    }
};
struct EpiGlu {
    static constexpr bool PERM = true; static constexpr bool PRE = false;
    bf16_t* MIX; const bf16_t* YG; const float* gb;
    __device__ __forceinline__ void operator()(const f32x4 (&acc)[2][2][4][2], const Unit& u, int, int wr, int wc, int fr, int fq) const {
        asm volatile("" : "+v"(fq), "+v"(fr));
        const int row0 = u.pm * BM + wr * 64 + fr, col0 = wc * 32 + 8 * fq;
#pragma unroll
        for (int ai = 0; ai < 2; ++ai)
#pragma unroll
            for (int m = 0; m < 4; ++m) { const size_t row = (size_t)(row0 + ai * HALF + m * 16);
#pragma unroll
                for (int bj = 0; bj < 2; ++bj) { const int c = col0 + bj * HALF;
                    const u32x4 yy = *(const u32x4*)(YG + row * 256 + c);
                    const f32x4 b0 = *(const f32x4*)(gb + c), b1 = *(const f32x4*)(gb + c + 4);
                    float o[8]; const unsigned yw[4] = {yy.x, yy.y, yy.z, yy.w};
#pragma unroll
                    for (int j = 0; j < 8; ++j) { const float yj = (j & 1) ? bfhi(yw[j >> 1]) : bflo(yw[j >> 1]); const float bj_ = j < 4 ? b0[j & 3] : b1[j & 3];
                        o[j] = yj * sigmoidf_(acc[ai][bj][m][j >> 2][j & 3] + bj_); }
                    u32x4 w; w.x = cvt_pk_bf16(o[0], o[1]); w.y = cvt_pk_bf16(o[2], o[3]); w.z = cvt_pk_bf16(o[4], o[5]); w.w = cvt_pk_bf16(o[6], o[7]);
                    *(u32x4*)(MIX + row * 1024 + c) = w; asm volatile("" ::: "memory"); } }
    }
};
}

#define XB_TMO      128
#define XB_XCNT(j)  (256  + 64 * (j))
#define XB_XSUB(j)  (1280 + 64 * (j))
#define XB_XGEN(j)  (2304 + 64 * (j))
#define XB_TOP      3328
#define XB_TOPGEN   3392
#define XCD_BAR_WORDS 3456
#define XB_SPIN_CAP (1u << 23)
__device__ __forceinline__ unsigned xb_ld(unsigned* p)              { return __hip_atomic_load(p, __ATOMIC_RELAXED, __HIP_MEMORY_SCOPE_AGENT); }
__device__ __forceinline__ unsigned xb_add(unsigned* p, unsigned v) { return __hip_atomic_fetch_add(p, v, __ATOMIC_RELAXED, __HIP_MEMORY_SCOPE_AGENT); }
__device__ __forceinline__ unsigned xb_xcc_id() { return (unsigned)__builtin_amdgcn_s_getreg((3 << 11) | 20) & 0xFu; }
#define XB_SPIN(cond, bar) do { unsigned _sp = 0; while (cond) { __builtin_amdgcn_s_sleep(1); \
    if ((++_sp & 255u) == 0u) { if (xb_ld(&(bar)[XB_TMO])) break; if (_sp > XB_SPIN_CAP) { atomicAdd(&(bar)[XB_TMO], 1u); break; } } } } while (0)
struct XcdBarrier { unsigned* bar; unsigned x; volatile LAS unsigned* st; };
__device__ __forceinline__ XcdBarrier xcd_barrier_post(unsigned* bar, volatile LAS unsigned* st) {
    XcdBarrier b; b.bar = bar; b.x = xb_xcc_id(); b.st = st;
    if (threadIdx.x == 0) (void)xb_add(&bar[XB_XCNT(b.x)], 1u);
    return b;
}
__device__ __forceinline__ void xcd_barrier_complete(unsigned* bar, unsigned x, unsigned& nloc, unsigned& nx) {
    const unsigned G = gridDim.x * gridDim.y * gridDim.z;
    unsigned sum, cnt, mine, sp = 0u;
    for (;;) {
        sum = 0u; cnt = 0u; mine = 0u;
#pragma unroll
        for (unsigned j = 0; j < 16; ++j) { const unsigned c = xb_ld(&bar[XB_XCNT(j)]); sum += c; cnt += (c > 0u) ? 1u : 0u; mine = (j == x) ? c : mine; }
        if (sum == G) break;
        __builtin_amdgcn_s_sleep(1);
        if ((++sp & 255u) == 0u) { if (xb_ld(&bar[XB_TMO])) break; if (sp > XB_SPIN_CAP) { atomicAdd(&bar[XB_TMO], 1u); break; } }
    }
    nloc = mine > 0u ? mine : 1u; nx = cnt > 0u ? cnt : 1u;
}
__device__ __forceinline__ void xcd_barrier(const XcdBarrier& b) {
    asm volatile("s_waitcnt vmcnt(0)" ::: "memory");
    __syncthreads();
    if (threadIdx.x == 0) {
        unsigned* bar = b.bar;
        __builtin_amdgcn_s_waitcnt(0);
        unsigned nloc = b.st[0], nx = b.st[1];
        if (nloc == 0u) { xcd_barrier_complete(bar, b.x, nloc, nx); b.st[0] = nloc; b.st[1] = nx; }
        const unsigned old = xb_add(&bar[XB_XSUB(b.x)], 1u);
        const unsigned gen = old / nloc;
        if (old + 1u == (gen + 1u) * nloc) {
            __builtin_amdgcn_fence(__ATOMIC_RELEASE, "agent");
            asm volatile("s_waitcnt vmcnt(0)" ::: "memory");
            const unsigned og = xb_add(&bar[XB_TOP], 1u);
            const unsigned tg = og / nx;
            if (og + 1u == (tg + 1u) * nx) xb_add(&bar[XB_TOPGEN], 1u);
            else XB_SPIN(xb_ld(&bar[XB_TOPGEN]) == tg, bar);
            __builtin_amdgcn_fence(__ATOMIC_ACQUIRE, "agent");
            xb_add(&bar[XB_XGEN(b.x)], 1u);
            asm volatile("s_waitcnt vmcnt(0)" ::: "memory");
        } else {
            XB_SPIN(xb_ld(&bar[XB_XGEN(b.x)]) == gen, bar);
            __builtin_amdgcn_fence(__ATOMIC_ACQUIRE, "agent");
            asm volatile("s_waitcnt vmcnt(0)" ::: "memory");
        }
    }
    __syncthreads();
}

struct Args { const void* in[46]; float* out; unsigned char* ws; int ph_lo, ph_hi; };
enum { I_X = 0, I_C, I_POS, I_ADAW, I_ADAB, I_NMG, I_NFG, I_WIN, I_WOUT, I_S5LR, I_S5LI, I_S5LS, I_S5BR, I_S5BI, I_S5CR, I_S5CI, I_S5D, I_S5GW, I_S5GB,
       I_RWMU, I_RWW0, I_RWW2, I_RWA0, I_RWA2, I_RWG2, I_RWKK, I_RWKA, I_RWRK, I_RWLG, I_RWLB, I_RWV0, I_RWV1, I_RWV2,
       I_MQG, I_MKVG, I_MWQ, I_MWKV, I_RTW, I_RTB, I_EWG, I_EBG, I_EWU, I_EBU, I_EWD, I_EBD, I_FNG };
#define FIN(k) ((const float*)a.in[k])
__constant__ float ROPE_INV[16] = {1.000000000e+00f, 5.623413324e-01f, 3.162277639e-01f, 1.778279394e-01f, 1.000000015e-01f, 5.623413250e-02f, 3.162277490e-02f, 1.778279431e-02f,
                                   9.999999776e-03f, 5.623413250e-03f, 3.162277630e-03f, 1.778279431e-03f, 1.000000047e-03f, 5.623413017e-04f, 3.162277571e-04f, 1.778279402e-04f};
#define LDS_BARRIER() asm volatile("s_waitcnt lgkmcnt(0)\n\ts_barrier" ::: "memory")
#define LDS_WAIT() asm volatile("s_waitcnt lgkmcnt(0)" ::: "memory")

__device__ __forceinline__ void transpose_item_fp8(const float* W, int N, unsigned char* WT, int ldo, int k0, int n0, int drow0, LAS float* scr, int lane) {
#pragma unroll 8
    for (int i = 0; i < 32; ++i) { const int kk = 2 * i + (lane >> 5); scr[kk * 33 + (lane & 31)] = W[(size_t)(k0 + kk) * N + n0 + (lane & 31)]; }
    LDS_WAIT();
    const int c = lane & 7;
#pragma unroll
    for (int j = 0; j < 4; ++j) { const int n = (lane >> 3) + 8 * j; const LAS float* sp = scr + (8 * c) * 33 + n;
        u32x2 o; o.x = pk4_fp8(sp[0 * 33] * 32.f, sp[1 * 33] * 32.f, sp[2 * 33] * 32.f, sp[3 * 33] * 32.f); o.y = pk4_fp8(sp[4 * 33] * 32.f, sp[5 * 33] * 32.f, sp[6 * 33] * 32.f, sp[7 * 33] * 32.f);
        *(u32x2*)(WT + (size_t)(drow0 + n) * ldo + k0 + 8 * c) = o; }
    LDS_WAIT();
}
__device__ __forceinline__ void s5_lambda_bar(const Args& a, int l, int g, int p, float& lbr, float& lbi, float& fre, float& fim) {
    const float dt = __expf(FIN(I_S5LS)[l * 16 + g]);
    const float lr = FIN(I_S5LR)[(l * 16 + g) * 64 + p], li = FIN(I_S5LI)[(l * 16 + g) * 64 + p];
    const float mag = __expf(lr * dt);
    const float ang = li * dt;
    double x = (double)ang * 0.15915494309189535; x -= __builtin_rint(x);
    const float fr = (float)x;
    lbr = mag * __builtin_amdgcn_cosf(fr); lbi = mag * __builtin_amdgcn_sinf(fr);
    const float den = lr * lr + li * li, nre = lbr - 1.0f;
    fre = (nre * lr + lbi * li) / den; fim = (lbi * lr - nre * li) / den;
}
__device__ __forceinline__ void phase_init(const Args& a, LAS unsigned char* lds, int tid, int G) {
    LAS float* sc = (LAS float*)lds;
    const float* c = FIN(I_C);
    for (int i = tid; i < 8192; i += NTHR) { const float v = c[i]; sc[i] = v / (1.0f + __expf(-v)); }
    __syncthreads();
    float* MOD = (float*)(a.ws + WS_MOD);
    {
        LAS float* red = (LAS float*)(lds + 65536);
        const bool wide = (G >= 256);
        int item0 = (int)blockIdx.x; if (wide) item0 = (int)blockIdx.x < 64 ? (int)blockIdx.x : ((int)blockIdx.x >= 128 ? (int)blockIdx.x - 64 : 1 << 20);
        for (int item = item0; item < 192; item += (wide ? (1 << 20) : G)) {
            const int l = item / 48, cl = tid & 127, kq = tid >> 7, col = (item % 48) * 128 + cl;
            float acc[8];
#pragma unroll
            for (int b = 0; b < 8; ++b) acc[b] = 0.f;
            const float* w = FIN(I_ADAW) + (size_t)l * 1024 * 6144 + col;
#pragma unroll 8
            for (int k = kq * 256; k < kq * 256 + 256; ++k) { const float wv = w[(size_t)k * 6144];
#pragma unroll
                for (int b = 0; b < 8; ++b) acc[b] += sc[b * 1024 + k] * wv; }
#pragma unroll
            for (int b = 0; b < 8; ++b) red[(kq * 8 + b) * 128 + cl] = acc[b];
            __syncthreads();
            if (kq == 0) {
                const float bias = FIN(I_ADAB)[l * 6144 + col];
#pragma unroll
                for (int b = 0; b < 8; ++b) MOD[(size_t)(l * 8 + b) * 6144 + col] = bias + ((red[b * 128 + cl] + red[(8 + b) * 128 + cl]) + (red[(16 + b) * 128 + cl] + red[(24 + b) * 128 + cl])); }
            __syncthreads();
        }
    }
    {
        float* KD = (float*)(a.ws + WS_KD); int* tab = (int*)(a.ws + WS_S5TAB);
        if (blockIdx.x == 0 && tid < 128) tab[tid] = tid >> 3;
        LAS float* PW = (LAS float*)(lds + 32768);
        LAS float* BBl = PW + 32 * 64 * 2;
        LAS float* CCl = BBl + 64 * 16 * 2;
        for (int lg = (G >= 128 ? (int)blockIdx.x - 64 : (int)blockIdx.x); lg >= 0 && lg < DEPTH * 16; lg += G) {
            const int l = lg >> 4, g = lg & 15;
            __syncthreads();
            for (int i = tid; i < 32 * 64; i += NTHR) { const int p = i & 63, d = i >> 6;
                const float dt = __expf(FIN(I_S5LS)[l * 16 + g]), lr = FIN(I_S5LR)[(l * 16 + g) * 64 + p], li = FIN(I_S5LI)[(l * 16 + g) * 64 + p];
                const float mag = __expf((float)d * lr * dt); double x = (double)((float)d * (li * dt)) * 0.15915494309189535; x -= __builtin_rint(x);
                PW[i * 2] = mag * __builtin_amdgcn_cosf((float)x); PW[i * 2 + 1] = mag * __builtin_amdgcn_sinf((float)x); }
            for (int i = tid; i < 64 * 16; i += NTHR) { const int hq = i & 15, p = i >> 4; float lbr, lbi, fre, fim; s5_lambda_bar(a, l, g, p, lbr, lbi, fre, fim);
                const float bre = FIN(I_S5BR)[(((size_t)l * 16 + g) * 64 + p) * 16 + hq], bim = FIN(I_S5BI)[(((size_t)l * 16 + g) * 64 + p) * 16 + hq];
                BBl[i * 2] = fre * bre - fim * bim; BBl[i * 2 + 1] = fre * bim + fim * bre;
                const int hp = i >> 6, pp = i & 63;
                CCl[i * 2] = FIN(I_S5CR)[(((size_t)l * 16 + g) * 16 + hp) * 64 + pp]; CCl[i * 2 + 1] = FIN(I_S5CI)[(((size_t)l * 16 + g) * 16 + hp) * 64 + pp]; }
            __syncthreads();
            for (int i = tid; i < 32 * 256; i += NTHR) { const int hk = i & 255, d = i >> 8, hp = hk >> 4, hq = hk & 15; float acc = 0.f;
                for (int p = 0; p < 64; ++p) { const float pr = PW[(d * 64 + p) * 2], pi_ = PW[(d * 64 + p) * 2 + 1], bbr = BBl[(p * 16 + hq) * 2], bbi = BBl[(p * 16 + hq) * 2 + 1];
                    const float cr = CCl[(hp * 64 + p) * 2], ci = CCl[(hp * 64 + p) * 2 + 1];
                    const float tr = pr * bbr - pi_ * bbi, ti = pr * bbi + pi_ * bbr; acc += cr * tr - ci * ti; }
                KD[((size_t)lg * 32 + d) * 256 + hk] = acc; }
        }
        __syncthreads();
    }
    float* rope = (float*)(a.ws + WS_ROPE);
    const int* pos = (const int*)a.in[I_POS];
    for (int idx = blockIdx.x * NTHR + tid; idx < T * 16; idx += G * NTHR) {
        const int t = idx >> 4, i = idx & 15;
        const float ang = (float)pos[t] * ROPE_INV[i];
        double x = (double)ang * 0.15915494309189535; x -= __builtin_rint(x);
        const float fr = (float)x;
        rope[(size_t)idx * 2] = __builtin_amdgcn_cosf(fr); rope[(size_t)idx * 2 + 1] = __builtin_amdgcn_sinf(fr);
    }
    __syncthreads();
}

__device__ __forceinline__ void transpose_item(const float* W, int N, bf16_t* WT, int ldo, int k0, int n0, int drow0, LAS float* scr, int lane) {
#pragma unroll 8
    for (int i = 0; i < 32; ++i) { const int kk = 2 * i + (lane >> 5); scr[kk * 33 + (lane & 31)] = W[(size_t)(k0 + kk) * N + n0 + (lane & 31)]; }
    LDS_WAIT();
    const int c = lane & 7;
#pragma unroll
    for (int j = 0; j < 4; ++j) { const int n = (lane >> 3) + 8 * j; const LAS float* s = scr + (8 * c) * 33 + n;
        u32x4 o; o.x = pk2(s[0 * 33], s[1 * 33]); o.y = pk2(s[2 * 33], s[3 * 33]); o.z = pk2(s[4 * 33], s[5 * 33]); o.w = pk2(s[6 * 33], s[7 * 33]);
        *(u32x4*)(WT + (size_t)(drow0 + n) * ldo + k0 + 8 * c) = o; }
    LDS_WAIT();
}
__device__ __forceinline__ void conv_expert_item(const Args& a, int l, int bi, LAS float* scr, int wave, int lane) {
    unsigned char* WGU = a.ws + WS_WGU; unsigned char* WDN = a.ws + WS_WDN;
    for (int k = 0; k < 12; ++k) {
        const int r = bi * 96 + k * 8 + wave;
        const int e = r / 1536, mm = (r % 1536) / 512, q = r % 512, kb = q / 32, nb = q % 32, n0 = 32 * nb;
        const size_t eoff = ((size_t)l * 32 + e) * 1024 * 1024;
        if (mm == 0) transpose_item_fp8(FIN(I_EWG) + eoff, 1024, WGU + (size_t)e * 2048 * 1024, 1024, 64 * kb, n0, (n0 >> 7) * 256 + (n0 & 127), scr, lane);
        else if (mm == 1) transpose_item_fp8(FIN(I_EWU) + eoff, 1024, WGU + (size_t)e * 2048 * 1024, 1024, 64 * kb, n0, (n0 >> 7) * 256 + 128 + (n0 & 127), scr, lane);
        else transpose_item_fp8(FIN(I_EWD) + eoff, 1024, WDN + (size_t)e * 1024 * 1024, 1024, 64 * kb, n0, n0, scr, lane);
    }
}
template <int PART> __device__ __forceinline__ void phase_conv(const Args& a, int l, LAS unsigned char* lds, int tid, int wave, int lane, int G) {
    LAS float* scr = (LAS float*)(lds + wave * 8704);
    const int gw = blockIdx.x * NWAVES + wave, NGW = G * NWAVES;
    bf16_t* WIN = (bf16_t*)(a.ws + WS_WIN); bf16_t* WOUT = (bf16_t*)(a.ws + WS_WOUT); bf16_t* WGU = (bf16_t*)(a.ws + WS_WGU); bf16_t* WDN = (bf16_t*)(a.ws + WS_WDN);
    constexpr int I_A = 16 * 77, I_Z = 96, I_O = 512, I_E = 32 * 1536;
    for (int it = (PART == 0 ? gw : gw + I_A + I_Z + I_O); it < (PART == 0 ? I_A + I_Z + I_O : I_A + I_Z + I_O + I_E); it += NGW) {
        int r = it;
        if (r < I_A) { const int kb = r / 77, nb = r % 77; transpose_item(FIN(I_WIN) + (size_t)l * 1024 * INW, INW, WIN, 1024, 64 * kb, 32 * nb, 32 * nb, scr, lane); continue; } r -= I_A;
        if (r < I_Z) { u32x4 z = zero4(); u32x4* d = (u32x4*)(WIN + (size_t)(INW + r) * 1024);
#pragma unroll
            for (int j = 0; j < 2; ++j) d[j * 64 + lane] = z; continue; } r -= I_Z;
        if (r < I_O) { const int kb = r / 32, nb = r % 32; transpose_item(FIN(I_WOUT) + (size_t)l * 1024 * 1024, 1024, WOUT, 1024, 64 * kb, 32 * nb, 32 * nb, scr, lane); continue; } r -= I_O;
        const int e = r / 1536, mm = (r % 1536) / 512, q = r % 512, kb = q / 32, nb = q % 32, n0 = 32 * nb;
        const size_t eoff = ((size_t)l * 32 + e) * 1024 * 1024;
        if (mm == 0) transpose_item(FIN(I_EWG) + eoff, 1024, WGU + (size_t)e * 2048 * 1024, 1024, 64 * kb, n0, (n0 >> 7) * 256 + (n0 & 127), scr, lane);
        else if (mm == 1) transpose_item(FIN(I_EWU) + eoff, 1024, WGU + (size_t)e * 2048 * 1024, 1024, 64 * kb, n0, (n0 >> 7) * 256 + 128 + (n0 & 127), scr, lane);
        else transpose_item(FIN(I_EWD) + eoff, 1024, WDN + (size_t)e * 1024 * 1024, 1024, 64 * kb, n0, n0, scr, lane);
    }
    if (PART == 1) return;
    bf16_t* SM = (bf16_t*)(a.ws + WS_WSM);
    const int gt = blockIdx.x * NTHR + tid, NGT = G * NTHR;
    for (int i = gt; i < 512 * 256; i += NGT) { const int n = i >> 8, k = i & 255;
        const float vq = n < 384 ? FIN(I_MQG)[l * 256 + k] * FIN(I_MWQ)[((size_t)l * 256 + k) * 384 + n] : 0.f;
        const float vk = k < 128 ? FIN(I_MKVG)[l * 128 + k] * FIN(I_MWKV)[((size_t)l * 128 + k) * 512 + n] : 0.f;
        SM[SM_WQ / 2 + i] = (bf16_t)f2bf(vq); SM[SM_WKV / 2 + i] = (bf16_t)f2bf(vk); }
    for (int i = gt; i < 768 * 256; i += NGT) { const int n = i >> 8, k = i & 255; float v = 0.f;
        if (n < 256) { if (k < 64) v = FIN(I_RWW2)[((size_t)l * 64 + k) * 256 + n]; }
        else if (n < 512) { if (k >= 64 && k < 128) v = FIN(I_RWA2)[((size_t)l * 64 + (k - 64)) * 256 + (n - 256)]; }
        else { if (k >= 128) v = FIN(I_RWG2)[((size_t)l * 128 + (k - 128)) * 256 + (n - 512)]; }
        SM[SM_WLORA / 2 + i] = (bf16_t)f2bf(v); }
    for (int i = gt; i < 256 * 256; i += NGT) { const int n = i >> 8, k = i & 255; float v = 0.f;
        if (l > 0) { const float* v1 = FIN(I_RWV1) + (size_t)(l - 1) * 256 * 32 + k * 32; const float* v2 = FIN(I_RWV2) + (size_t)(l - 1) * 32 * 256 + n;
#pragma unroll 8
            for (int m = 0; m < 32; ++m) v += v1[m] * v2[m * 256]; }
        SM[SM_WVV / 2 + i] = (bf16_t)f2bf(v);
        SM[SM_WGLU / 2 + i] = (bf16_t)f2bf(FIN(I_S5GW)[((size_t)l * 256 + k) * 256 + n]); }
    {
        bf16_t* WE = (bf16_t*)(a.ws + R_WE); bf16_t* WY = (bf16_t*)(a.ws + R_WY); const float* KD = (const float*)(a.ws + WS_KD) + (size_t)l * 16 * 32 * 256;
        for (int i0 = gt; i0 < 16 * 256 * 512; i0 += 4 * NGT) { float v4[4];
#pragma unroll
          for (int u = 0; u < 4; ++u) { const int i = i0 + u * NGT; const int k = i & 511, q = (i >> 9) & 255, g = i >> 17; float v = 0.f;
            if (q < 128 && i < 16 * 256 * 512) { const int p = q & 63, tau = k >> 4, h = k & 15; float lbr, lbi, fre, fim; s5_lambda_bar(a, l, g, p, lbr, lbi, fre, fim);
                const float bre = FIN(I_S5BR)[(((size_t)l * 16 + g) * 64 + p) * 16 + h], bim = FIN(I_S5BI)[(((size_t)l * 16 + g) * 64 + p) * 16 + h];
                const float bbr = fre * bre - fim * bim, bbi = fre * bim + fim * bre;
                const float dt = __expf(FIN(I_S5LS)[l * 16 + g]), lr = FIN(I_S5LR)[(l * 16 + g) * 64 + p], li = FIN(I_S5LI)[(l * 16 + g) * 64 + p]; const float d = (float)(31 - tau);
                const float mag = __expf(d * lr * dt); double x = (double)(d * (li * dt)) * 0.15915494309189535; x -= __builtin_rint(x);
                const float pr = mag * __builtin_amdgcn_cosf((float)x), pi_ = mag * __builtin_amdgcn_sinf((float)x);
                v = (q < 64) ? (pr * bbr - pi_ * bbi) : (pr * bbi + pi_ * bbr); }
            v4[u] = v; }
#pragma unroll
          for (int u = 0; u < 4; ++u) if (i0 + u * NGT < 16 * 256 * 512) WE[i0 + u * NGT] = (bf16_t)f2bf(v4[u]); }
        for (int i0 = gt; i0 < 16 * 512 * 768; i0 += 4 * NGT) { float v4[4];
#pragma unroll
          for (int u = 0; u < 4; ++u) { const int i = i0 + u * NGT; const int k = i % 768, n = (i / 768) & 511, g = i / (768 * 512), tau = n >> 4, hp = n & 15; float v = 0.f;
            if (i >= 16 * 512 * 768) { } else if (k < 512) { const int j = k >> 4, h = k & 15; if (j <= tau) v = KD[((g * 32 + (tau - j)) * 16 + hp) * 16 + h]; }
            else if (k < 640) { const int q = k - 512, p = q & 63;
                const float dt = __expf(FIN(I_S5LS)[l * 16 + g]), lr = FIN(I_S5LR)[(l * 16 + g) * 64 + p], li = FIN(I_S5LI)[(l * 16 + g) * 64 + p]; const float d = (float)(tau + 1);
                const float mag = __expf(d * lr * dt); double x = (double)(d * (li * dt)) * 0.15915494309189535; x -= __builtin_rint(x);
                const float pr = mag * __builtin_amdgcn_cosf((float)x), pi_ = mag * __builtin_amdgcn_sinf((float)x);
                const float cr = FIN(I_S5CR)[(((size_t)l * 16 + g) * 16 + hp) * 64 + p], ci = FIN(I_S5CI)[(((size_t)l * 16 + g) * 16 + hp) * 64 + p];
                v = (q < 64) ? (cr * pr - ci * pi_) : -(cr * pi_ + ci * pr); }
            v4[u] = v; }
#pragma unroll
          for (int u = 0; u < 4; ++u) if (i0 + u * NGT < 16 * 512 * 768) WY[i0 + u * NGT] = (bf16_t)f2bf(v4[u]); }
    }
}

template <int MODE>
__device__ __forceinline__ void phase_norm1(const Args& a, int l, int wave, int lane, int G) {
    const int gw = blockIdx.x * NWAVES + wave, NGW = G * NWAVES;
    const float* MOD = (const float*)(a.ws + WS_MOD);
    const int* pos = (const int*)(a.ws + MO_POS); const float* tw = (const float*)(a.ws + MO_W);
    const bf16_t* Y = (const bf16_t*)(a.ws + R_Y);
    bf16_t* HN = (bf16_t*)(a.ws + WS_HN);
#pragma unroll 2
    for (int m = gw; m < T; m += NGW) {
        const int b = m >> 13;
        const float* xr = (l == 0 ? FIN(I_X) : a.out) + (size_t)m * D;
        f32x4 v[4];
#pragma unroll
        for (int j = 0; j < 4; ++j) v[j] = ((const f32x4*)xr)[64 * j + lane];
        if (l > 0) {
            f32x4 acc[4];
#pragma unroll
            for (int j = 0; j < 4; ++j) acc[j] = (f32x4){0.f, 0.f, 0.f, 0.f};
#pragma unroll
            for (int k = 0; k < 4; ++k) { const int p = pos[m * 4 + k]; const float w = tw[m * 4 + k]; const u32x2* yr = (const u32x2*)(Y + (size_t)p * 1024);
#pragma unroll
                for (int j = 0; j < 4; ++j) { const u32x2 yy = __builtin_nontemporal_load(yr + 64 * j + lane); acc[j] += w * (f32x4){bflo(yy.x), bfhi(yy.x), bflo(yy.y), bfhi(yy.y)}; } }
            const float* g2 = MOD + (size_t)((l - 1) * 8 + b) * 6144 + 5120;
#pragma unroll
            for (int j = 0; j < 4; ++j) { v[j] += ((const f32x4*)g2)[64 * j + lane] * acc[j]; ((f32x4*)(a.out + (size_t)m * D))[64 * j + lane] = v[j]; }
        }
        float ss = 0.f;
#pragma unroll
        for (int j = 0; j < 4; ++j) ss += (v[j].x * v[j].x + v[j].y * v[j].y) + (v[j].z * v[j].z + v[j].w * v[j].w);
        ss = wave_sum(ss);
        const float rstd = __builtin_amdgcn_rsqf(ss * (1.0f / D) + NORM_EPS);
        if (MODE == 0) {
            const float* gn = FIN(I_NMG) + l * D; const float* sh = MOD + (size_t)(l * 8 + b) * 6144; const float* sc = sh + 1024;
            u32x2* o = (u32x2*)(HN + (size_t)m * D);
#pragma unroll
            for (int j = 0; j < 4; ++j) { const f32x4 g = ((const f32x4*)gn)[64 * j + lane], s1 = ((const f32x4*)sc)[64 * j + lane], s0 = ((const f32x4*)sh)[64 * j + lane];
                const f32x4 h = v[j] * rstd * g * (1.0f + s1) + s0; u32x2 w; w.x = pk2(h.x, h.y); w.y = pk2(h.z, h.w); o[64 * j + lane] = w; }
        } else {
            const float* gn = FIN(I_FNG);
#pragma unroll
            for (int j = 0; j < 4; ++j) { const f32x4 g = ((const f32x4*)gn)[64 * j + lane]; ((f32x4*)(a.out + (size_t)m * D))[64 * j + lane] = v[j] * rstd * g; }
        }
    }
}

__device__ __forceinline__ void phase_pre(const Args& a, int l, int tid, int G) {
    const bf16_t* PROJ = (const bf16_t*)(a.ws + R_PROJ); bf16_t* AP = (bf16_t*)(a.ws + R_AP);
    const float* mu = FIN(I_RWMU) + l * 1024;
    const int stride = G * NTHR;
    float muv[8];
    { const int ch0 = tid & 63, mi0 = ch0 < 32 ? (768 + ch0 * 8) : (512 + (ch0 - 32) * 8);
#pragma unroll
      for (int j = 0; j < 8; ++j) muv[j] = mu[mi0 + j]; }
    for (int idx0 = blockIdx.x * NTHR + tid; idx0 < T * 64; idx0 += 4 * stride) {
        u32x4 cu[4], pv[4];
#pragma unroll
        for (int u = 0; u < 4; ++u) { const int idx = idx0 + u * stride; cu[u] = zero4(); pv[u] = zero4();
            if (idx < T * 64) { const int t = idx >> 6, ch = idx & 63; const int pc = ch < 32 ? (C_RWWD + ch * 8) : (C_RWV + (ch - 32) * 8);
                cu[u] = *(const u32x4*)(PROJ + (size_t)t * INWP + pc); if ((t & (SEQ - 1)) != 0) pv[u] = *(const u32x4*)(PROJ + (size_t)(t - 1) * INWP + pc); } }
#pragma unroll
        for (int u = 0; u < 4; ++u) { const int idx = idx0 + u * stride; if (idx >= T * 64) break;
            const int t = idx >> 6, ch = idx & 63;
            const unsigned cw[4] = {cu[u].x, cu[u].y, cu[u].z, cu[u].w}, pw[4] = {pv[u].x, pv[u].y, pv[u].z, pv[u].w};
            float o[8];
#pragma unroll
            for (int j = 0; j < 8; ++j) { const float c = (j & 1) ? bfhi(cw[j >> 1]) : bflo(cw[j >> 1]), p = (j & 1) ? bfhi(pw[j >> 1]) : bflo(pw[j >> 1]);
                float x = c + (p - c) * muv[j];
                if (ch < 8) x = 1.0f - 2.0f * __builtin_amdgcn_rcpf(1.0f + __expf(2.0f * x)); else if (ch >= 16 && ch < 32) x = sigmoidf_(x);
                o[j] = x; }
            u32x4 w; w.x = pk2(o[0], o[1]); w.y = pk2(o[2], o[3]); w.z = pk2(o[4], o[5]); w.w = pk2(o[6], o[7]);
            *(u32x4*)(AP + (size_t)t * 512 + ch * 8) = w;
        }
    }
}

constexpr float QSCALE = 0.14724444602590306f;
__device__ __forceinline__ void mla_finish(const Args& a, LAS unsigned char* lds, int tid, int G) {
    const bf16_t* PROJ = (const bf16_t*)(a.ws + R_PROJ); const bf16_t* RAW = (const bf16_t*)(a.ws + R_QKV);
    bf16_t* QB = (bf16_t*)(a.ws + R_QB); unsigned char* KT = a.ws + R_KT; unsigned char* VT = a.ws + R_VT;
    const float* rope = (const float*)(a.ws + WS_ROPE);
    LAS float* rs = (LAS float*)lds;
    for (int tile = blockIdx.x; tile < T / 64; tile += G) {
        const int t0 = tile * 64, b = t0 >> 13, tidx = (t0 & (SEQ - 1)) >> 6;
        {
            const int tk = tid >> 3, part = tid & 7; const bf16_t* pr = PROJ + (size_t)(t0 + tk) * INWP;
            float sq = 0.f, sk = 0.f;
#pragma unroll
            for (int i = 0; i < 4; ++i) { const u32x4 w = *(const u32x4*)(pr + C_QC + part * 32 + i * 8); const unsigned ww[4] = {w.x, w.y, w.z, w.w};
#pragma unroll
                for (int j = 0; j < 4; ++j) { const float x0 = bflo(ww[j]), x1 = bfhi(ww[j]); sq += x0 * x0 + x1 * x1; } }
#pragma unroll
            for (int i = 0; i < 2; ++i) { const u32x4 w = *(const u32x4*)(pr + C_KVC + part * 16 + i * 8); const unsigned ww[4] = {w.x, w.y, w.z, w.w};
#pragma unroll
                for (int j = 0; j < 4; ++j) { const float x0 = bflo(ww[j]), x1 = bfhi(ww[j]); sk += x0 * x0 + x1 * x1; } }
            sq += __shfl_xor(sq, 1); sq += __shfl_xor(sq, 2); sq += __shfl_xor(sq, 4);
            sk += __shfl_xor(sk, 1); sk += __shfl_xor(sk, 2); sk += __shfl_xor(sk, 4);
            if (part == 0) { rs[tk * 2] = __builtin_amdgcn_rsqf(sq * (1.0f / 256.0f) + NORM_EPS); rs[tk * 2 + 1] = __builtin_amdgcn_rsqf(sk * (1.0f / 128.0f) + NORM_EPS); }
        }
        __syncthreads();
#pragma nounroll
        for (int c0 = 0; c0 < 6; c0 += 3) {
            asm volatile("" ::: "memory");
            u32x4 w_[3], wp_[3]; f32x4 rp_[3][4];
#pragma unroll
            for (int u = 0; u < 3; ++u) { const int ci = tid + (c0 + u) * NTHR; const int tk = ci / 48, rem = ci % 48, h = rem / 12, c = rem % 12; const size_t t = (size_t)t0 + tk;
                w_[u] = *(const u32x4*)(RAW + t * 1024 + h * 96 + c * 8); wp_[u] = zero4();
#pragma unroll
                for (int q = 0; q < 4; ++q) rp_[u][q] = (f32x4){0.f, 0.f, 0.f, 0.f};
                if (c >= 8) { const int cp = (c < 10) ? c + 2 : c - 2; wp_[u] = *(const u32x4*)(RAW + t * 1024 + h * 96 + cp * 8); const f32x4* rr = (const f32x4*)(rope + (t * 16 + ((c - 8) & 1) * 8) * 2);
#pragma unroll
                    for (int q = 0; q < 4; ++q) rp_[u][q] = rr[q]; } }
#pragma unroll
            for (int u = 0; u < 3; ++u) { const int ci = tid + (c0 + u) * NTHR; const int tk = ci / 48, rem = ci % 48, h = rem / 12, c = rem % 12; const size_t t = (size_t)t0 + tk;
                const float sc = rs[tk * 2] * QSCALE;
                const unsigned ww[4] = {w_[u].x, w_[u].y, w_[u].z, w_[u].w}, pp[4] = {wp_[u].x, wp_[u].y, wp_[u].z, wp_[u].w};
                float o[8];
#pragma unroll
                for (int j = 0; j < 8; ++j) { const float xo = (j & 1) ? bfhi(ww[j >> 1]) : bflo(ww[j >> 1]), xp = (j & 1) ? bfhi(pp[j >> 1]) : bflo(pp[j >> 1]);
                    const float cs = rp_[u][j >> 1][(j & 1) * 2], sn = rp_[u][j >> 1][(j & 1) * 2 + 1];
                    o[j] = (c < 8) ? xo * sc : ((c < 10) ? (xo * cs - xp * sn) : (xp * sn + xo * cs)) * sc; }
                u32x4 ow; ow.x = pk2(o[0], o[1]); ow.y = pk2(o[2], o[3]); ow.z = pk2(o[4], o[5]); ow.w = pk2(o[6], o[7]);
                *(u32x4*)(QB + t * 384 + h * 96 + c * 8) = ow; }
        }
#pragma nounroll
        for (int c0 = 0; c0 < 6; c0 += 3) {
            asm volatile("" ::: "memory");
            u32x4 w_[3], wp_[3]; f32x4 rp_[3][4];
#pragma unroll
            for (int u = 0; u < 3; ++u) { const int ci = tid + (c0 + u) * NTHR; const int h = ci / 768, rem = ci % 768, c = rem >> 6, key = rem & 63; const size_t t = (size_t)t0 + key;
                wp_[u] = zero4();
#pragma unroll
                for (int q = 0; q < 4; ++q) rp_[u][q] = (f32x4){0.f, 0.f, 0.f, 0.f};
                if (c < 8) w_[u] = *(const u32x4*)(RAW + t * 1024 + 512 + h * 128 + c * 8);
                else { const int cp = (c < 10) ? c + 2 : c - 2; w_[u] = *(const u32x4*)(PROJ + t * INWP + C_KPE + (c - 8) * 8); wp_[u] = *(const u32x4*)(PROJ + t * INWP + C_KPE + (cp - 8) * 8);
                    const f32x4* rr = (const f32x4*)(rope + (t * 16 + ((c - 8) & 1) * 8) * 2);
#pragma unroll
                    for (int q = 0; q < 4; ++q) rp_[u][q] = rr[q]; } }
#pragma unroll
            for (int u = 0; u < 3; ++u) { const int ci = tid + (c0 + u) * NTHR; const int h = ci / 768, rem = ci % 768, c = rem >> 6, key = rem & 63;
                const float sc = rs[key * 2 + 1];
                const unsigned ww[4] = {w_[u].x, w_[u].y, w_[u].z, w_[u].w}, pp[4] = {wp_[u].x, wp_[u].y, wp_[u].z, wp_[u].w};
                float o[8];
#pragma unroll
                for (int j = 0; j < 8; ++j) { const float xo = (j & 1) ? bfhi(ww[j >> 1]) : bflo(ww[j >> 1]), xp = (j & 1) ? bfhi(pp[j >> 1]) : bflo(pp[j >> 1]);
                    const float cs = rp_[u][j >> 1][(j & 1) * 2], sn = rp_[u][j >> 1][(j & 1) * 2 + 1];
                    o[j] = (c < 8) ? xo * sc : ((c < 10) ? (xo * cs - xp * sn) : (xp * sn + xo * cs)); }
                u32x4 ow; ow.x = pk2(o[0], o[1]); ow.y = pk2(o[2], o[3]); ow.z = pk2(o[4], o[5]); ow.w = pk2(o[6], o[7]);
                *(u32x4*)(KT + ((size_t)((b * 4 + h) * 128 + tidx)) * 12288 + (size_t)(c * 64 + key) * 16) = ow; }
        }
        {
            asm volatile("" ::: "memory");
            unsigned rv[4][8];
#pragma unroll
            for (int u = 0; u < 4; ++u) { const int ci = tid + u * NTHR; const int h = ci >> 9, rem = ci & 511, kh = rem >> 6, dv = rem & 63, ks = kh >> 1, hh = kh & 1;
#pragma unroll
                for (int j = 0; j < 8; ++j) { const int key = 16 * ks + 8 * (j >> 2) + 4 * hh + (j & 3); rv[u][j] = RAW[((size_t)t0 + key) * 1024 + 512 + h * 128 + 64 + dv]; } }
#pragma unroll
            for (int u = 0; u < 4; ++u) { const int ci = tid + u * NTHR; const int h = ci >> 9, rem = ci & 511, kh = rem >> 6, dv = rem & 63, ks = kh >> 1, hh = kh & 1;
                float o[8];
#pragma unroll
                for (int j = 0; j < 8; ++j) { const int key = 16 * ks + 8 * (j >> 2) + 4 * hh + (j & 3); o[j] = bf2f(rv[u][j]) * rs[key * 2 + 1]; }
                u32x4 ow; ow.x = pk2(o[0], o[1]); ow.y = pk2(o[2], o[3]); ow.z = pk2(o[4], o[5]); ow.w = pk2(o[6], o[7]);
                *(u32x4*)(VT + ((size_t)((b * 4 + h) * 128 + tidx)) * 8192 + (size_t)(kh * 64 + dv) * 16) = ow; }
        }
        __syncthreads();
    }
}
__device__ __forceinline__ void rwkv_finish(const Args& a, int l, int wave, int lane, int G) {
    const bf16_t* PROJ = (const bf16_t*)(a.ws + R_PROJ); const bf16_t* LO = (const bf16_t*)(a.ws + R_LO);
    float* SI = (float*)(a.ws + R_SI); float* VF = (float*)(a.ws + WS_VF);
    const float* mu = FIN(I_RWMU) + l * 1024;
    const int h = wave & 3, j = h * 64 + lane;
    const float mur = mu[j], muk = mu[256 + j], muv = mu[512 + j];
    const float w0 = FIN(I_RWW0)[l * 256 + j], a0 = FIN(I_RWA0)[l * 256 + j], kkp = FIN(I_RWKK)[l * 256 + j], kap = FIN(I_RWKA)[l * 256 + j];
    const float v0 = l > 0 ? FIN(I_RWV0)[(l - 1) * 256 + j] : 0.f;
#pragma unroll 4
    for (int tp = blockIdx.x; tp < T / 2; tp += G) {
        const size_t t = (size_t)tp * 2 + (wave >> 2); const bool first = (t & (SEQ - 1)) == 0;
        const bf16_t* pc = PROJ + t * INWP; const bf16_t* pp = pc - INWP;
        float r = bf2f(pc[C_RWR + j]), k = bf2f(pc[C_RWK + j]), v = bf2f(pc[C_RWV + j]);
        const float rp = first ? 0.f : bf2f(pp[C_RWR + j]), kp = first ? 0.f : bf2f(pp[C_RWK + j]), vp = first ? 0.f : bf2f(pp[C_RWV + j]);
        r += (rp - r) * mur; k += (kp - k) * muk; v += (vp - v) * muv;
        const float wl = w0 + bf2f(LO[t * 1024 + j]);
        const float sp = log1pf(__expf(-wl));
        const float wraw = -sp - 0.5f;
        const float decay = __expf(-__expf(wraw));
        const float aa = sigmoidf_(a0 + bf2f(LO[t * 1024 + 256 + j]));
        if (l > 0) { const float vf = VF[t * 256 + j]; v += (vf - v) * sigmoidf_(v0 + bf2f(LO[t * 1024 + 768 + j])); }
        else VF[t * 256 + j] = v;
        const float kk0 = k * kkp;
        const float nrm = sqrtf(wave_sum(kk0 * kk0));
        const float kk = kk0 / fmaxf(nrm, 1e-12f);
        const float k2 = k * (1.0f + (aa - 1.0f) * kap);
        float* o = SI + (t * 4 + h) * 384;
        o[lane] = r; o[64 + lane] = decay; o[128 + lane] = k2; o[192 + lane] = kk; o[256 + lane] = kk * aa; o[320 + lane] = v;
    }
}
struct S5State { float lbr, lbi; int cre, cim; };
__device__ __forceinline__ S5State s5_state(const Args& a, int l, int s) { S5State st; const int g = s >> 6, p = s & 63; float fre, fim; s5_lambda_bar(a, l, g, p, st.lbr, st.lbi, fre, fim); st.cre = g * 128 + p; st.cim = st.cre + 64; return st; }
__device__ __forceinline__ void s5_repack(const Args& a, int tid, int G) {
    const bf16_t* PROJ = (const bf16_t*)(a.ws + R_PROJ); bf16_t* UP = (bf16_t*)(a.ws + R_UP);
    for (int i = blockIdx.x * NTHR + tid; i < T * 32; i += G * NTHR) { const int p8 = i & 31, t = i >> 5, g = p8 >> 1, h0 = (p8 & 1) * 8;
        *(u32x4*)(UP + ((size_t)g * 2048 + (t >> 5)) * 768 + (t & 31) * 16 + h0) = *(const u32x4*)(PROJ + (size_t)t * INWP + C_S5 + p8 * 8); }
    for (int i = blockIdx.x * NTHR + tid; i < 16 * 2048 * 16; i += G * NTHR) { const int r = i >> 4, c8 = i & 15; *(u32x4*)(UP + (size_t)r * 768 + 640 + c8 * 8) = zero4(); }
}
__device__ __forceinline__ void s5_chunk_scan(const Args& a, int l, int tid, int G) {
    bf16_t* UP = (bf16_t*)(a.ws + R_UP); const float* EB = (const float*)(a.ws + R_EB);
    if (tid < 64)
    for (int i = blockIdx.x * 64 + tid; i < NB * 16 * 64; i += G * 64) { const int p = i & 63, g = (i >> 6) & 15, b = i >> 10;
        float lbr, lbi, fre, fim; s5_lambda_bar(a, l, g, p, lbr, lbi, fre, fim);
        float pr = lbr, pi_ = lbi;
#pragma unroll
        for (int k = 0; k < 5; ++k) { const float tr = pr * pr - pi_ * pi_, ti = 2.f * pr * pi_; pr = tr; pi_ = ti; }
        float sr = 0.f, si = 0.f;
        for (int c0 = 0; c0 < 256; c0 += 32) { float er[32], ei[32];
#pragma unroll
            for (int c = 0; c < 32; ++c) { const size_t row = (size_t)g * 2048 + b * 256 + c0 + c; er[c] = EB[row * 128 + p]; ei[c] = EB[row * 128 + 64 + p]; }
#pragma unroll
            for (int c = 0; c < 32; ++c) { const size_t row = (size_t)g * 2048 + b * 256 + c0 + c;
                UP[row * 768 + 512 + p] = (bf16_t)f2bf(sr); UP[row * 768 + 576 + p] = (bf16_t)f2bf(si);
                const float nr = pr * sr - pi_ * si + er[c], ni = pr * si + pi_ * sr + ei[c]; sr = nr; si = ni; }
        }
    }
}
__device__ __forceinline__ void s5_pass_a(const Args& a, int l, int tid, int G) {
    const bf16_t* BU = (const bf16_t*)(a.ws + R_BU); float* E = (float*)(a.ws + R_E);
    const S5State s0 = s5_state(a, l, tid), s1 = s5_state(a, l, tid + 512);
    for (int u = blockIdx.x; u < NB * 64; u += G) {
        const size_t t0 = (size_t)(u >> 6) * SEQ + (size_t)(u & 63) * 128;
        float ar = 0.f, ai = 0.f, br = 0.f, bi = 0.f;
#pragma unroll 4
        for (int tk = 0; tk < 128; ++tk) { const bf16_t* row = BU + (t0 + tk) * 2048;
            const float x0 = bf2f(row[s0.cre]), y0 = bf2f(row[s0.cim]), x1 = bf2f(row[s1.cre]), y1 = bf2f(row[s1.cim]);
            const float nar = s0.lbr * ar - s0.lbi * ai + x0, nai = s0.lbr * ai + s0.lbi * ar + y0; ar = nar; ai = nai;
            const float nbr = s1.lbr * br - s1.lbi * bi + x1, nbi = s1.lbr * bi + s1.lbi * br + y1; br = nbr; bi = nbi; }
        float* e = E + (size_t)u * 2048;
        e[tid * 2] = ar; e[tid * 2 + 1] = ai; e[(tid + 512) * 2] = br; e[(tid + 512) * 2 + 1] = bi;
    }
}
__device__ __forceinline__ void s5_pass_c(const Args& a, int l, int tid, int G) {
    bf16_t* BU = (bf16_t*)(a.ws + R_BU); const float* E = (const float*)(a.ws + R_E);
    const S5State s0 = s5_state(a, l, tid), s1 = s5_state(a, l, tid + 512);
    float p0r = s0.lbr, p0i = s0.lbi, p1r = s1.lbr, p1i = s1.lbi;
#pragma unroll
    for (int i = 0; i < 7; ++i) { const float t0r = p0r * p0r - p0i * p0i, t0i = 2.f * p0r * p0i; p0r = t0r; p0i = t0i; const float t1r = p1r * p1r - p1i * p1i, t1i = 2.f * p1r * p1i; p1r = t1r; p1i = t1i; }
    for (int u = blockIdx.x; u < NB * 64; u += G) {
        const int b = u >> 6, c = u & 63; const size_t t0 = (size_t)b * SEQ + (size_t)c * 128;
        float ar = 0.f, ai = 0.f, br = 0.f, bi = 0.f;
        for (int cc = 0; cc < c; ++cc) { const float* e = E + (size_t)(b * 64 + cc) * 2048;
            const float e0r = e[tid * 2], e0i = e[tid * 2 + 1], e1r = e[(tid + 512) * 2], e1i = e[(tid + 512) * 2 + 1];
            const float nar = p0r * ar - p0i * ai + e0r, nai = p0r * ai + p0i * ar + e0i; ar = nar; ai = nai;
            const float nbr = p1r * br - p1i * bi + e1r, nbi = p1r * bi + p1i * br + e1i; br = nbr; bi = nbi; }
#pragma unroll 4
        for (int tk = 0; tk < 128; ++tk) { bf16_t* row = BU + (t0 + tk) * 2048;
            const float x0 = bf2f(row[s0.cre]), y0 = bf2f(row[s0.cim]), x1 = bf2f(row[s1.cre]), y1 = bf2f(row[s1.cim]);
            const float nar = s0.lbr * ar - s0.lbi * ai + x0, nai = s0.lbr * ai + s0.lbi * ar + y0; ar = nar; ai = nai;
            const float nbr = s1.lbr * br - s1.lbi * bi + x1, nbi = s1.lbr * bi + s1.lbi * br + y1; br = nbr; bi = nbi;
            row[s0.cre] = (bf16_t)f2bf(ar); row[s0.cim] = (bf16_t)f2bf(ai); row[s1.cre] = (bf16_t)f2bf(br); row[s1.cim] = (bf16_t)f2bf(bi); }
    }
}
__device__ __forceinline__ float ret_rope(const bf16_t* PROJ, const float* rope, size_t t, int colbase, int h, int d) {
    const bf16_t* p = PROJ + t * INWP + colbase + h * 32; const int i = d & 15;
    const float x1 = bf2f(p[i]), x2 = bf2f(p[i + 16]); const float cs = rope[(t * 16 + i) * 2], sn = rope[(t * 16 + i) * 2 + 1];
    return d < 16 ? (x1 * cs - x2 * sn) : (x1 * sn + x2 * cs);
}
__device__ __forceinline__ void ret_rope8(const bf16_t* PROJ, const float* rope, size_t t, int colbase, int h, int ch, float (&o)[8]) {
    const bf16_t* p = PROJ + t * INWP + colbase + h * 32;
    const u32x4 wo = *(const u32x4*)(p + 8 * ch), wp = *(const u32x4*)(p + 8 * (ch ^ 2));
    const unsigned ow[4] = {wo.x, wo.y, wo.z, wo.w}, pw[4] = {wp.x, wp.y, wp.z, wp.w};
    const f32x4* cs = (const f32x4*)(rope + (t * 16 + (ch & 1) * 8) * 2);
    const f32x4 c0 = cs[0], c1 = cs[1], c2 = cs[2], c3 = cs[3];
    const float cc[8] = {c0.x, c0.z, c1.x, c1.z, c2.x, c2.z, c3.x, c3.z}, sn[8] = {c0.y, c0.w, c1.y, c1.w, c2.y, c2.w, c3.y, c3.w};
#pragma unroll
    for (int j = 0; j < 8; ++j) { const float xo = (j & 1) ? bfhi(ow[j >> 1]) : bflo(ow[j >> 1]), xp = (j & 1) ? bfhi(pw[j >> 1]) : bflo(pw[j >> 1]);
        o[j] = (ch < 2) ? (xo * cc[j] - xp * sn[j]) : (xp * sn[j] + xo * cc[j]); }
}
__device__ __forceinline__ void ret_stage_vt(const bf16_t* PROJ, LAS bf16_t* VT, size_t t0, int h, int tid) {
    const int m = tid >> 2, eg = tid & 3, ks = m >> 4, w = m & 15, hh = (w >> 2) & 1, j = 4 * (w >> 3) + (w & 3);
    const u32x4 v0 = *(const u32x4*)(PROJ + (t0 + m) * INWP + C_RV + h * 64 + eg * 16), v1 = *(const u32x4*)(PROJ + (t0 + m) * INWP + C_RV + h * 64 + eg * 16 + 8);
    const unsigned vw[8] = {v0.x, v0.y, v0.z, v0.w, v1.x, v1.y, v1.z, v1.w};
    LAS bf16_t* d = VT + ((ks * 2 + hh) * 64 + eg * 16) * 8 + j;
#pragma unroll
    for (int i = 0; i < 16; ++i) d[i * 8] = (bf16_t)((i & 1) ? (vw[i >> 1] >> 16) : (vw[i >> 1] & 0xffffu));
}
__device__ __forceinline__ void ret_pass_a(const Args& a, LAS unsigned char* lds, int tid, int wave, int lane, int G) {
    const bf16_t* PROJ = (const bf16_t*)(a.ws + R_PROJ); const float* rope = (const float*)(a.ws + WS_ROPE); float* CKV = (float*)(a.ws + R_CKV);
    LAS bf16_t* VT = (LAS bf16_t*)lds; LAS bf16_t* KW = (LAS bf16_t*)(lds + 16384);
    const int hh = lane >> 5, l31 = lane & 31;
    for (int u = blockIdx.x; u < NB * 64 * 4; u += G) {
        const int h = u & 3, n = (u >> 2) & 63, b = u >> 8; const size_t t0 = (size_t)b * SEQ + (size_t)n * 128;
        const float lg2 = log2f(1.0f - exp2f(-5.0f - (float)h));
        ret_stage_vt(PROJ, VT, t0, h, tid);
        {
            const int d = tid & 31, kh = tid >> 5, ks = kh >> 1, khh = kh & 1, i = d & 15; float o[8];
#pragma unroll
            for (int j = 0; j < 8; ++j) { const int m = 16 * ks + 8 * (j >> 2) + 4 * khh + (j & 3); const size_t t = t0 + m;
                const bf16_t* p = PROJ + t * INWP + C_RK + h * 32; const float x1 = bf2f(p[i]), x2 = bf2f(p[i + 16]);
                const float cs = rope[(t * 16 + i) * 2], sn = rope[(t * 16 + i) * 2 + 1];
                o[j] = (d < 16 ? (x1 * cs - x2 * sn) : (x1 * sn + x2 * cs)) * 0.17677669529663687f * exp2f((float)(127 - m) * lg2); }
            u32x4 w; w.x = pk2(o[0], o[1]); w.y = pk2(o[2], o[3]); w.z = pk2(o[4], o[5]); w.w = pk2(o[6], o[7]);
            *(LAS u32x4*)(KW + (kh * 32 + d) * 8) = w;
        }
        __syncthreads();
        if (wave < 2) {
            f32x16 acc;
#pragma unroll
            for (int r = 0; r < 16; ++r) acc[r] = 0.f;
#pragma unroll
            for (int ks = 0; ks < 8; ++ks) {
                const bf16x8 va = *(const LAS bf16x8*)(VT + ((ks * 2 + hh) * 64 + 32 * wave + l31) * 8);
                const bf16x8 kb = *(const LAS bf16x8*)(KW + ((ks * 2 + hh) * 32 + l31) * 8);
                acc = __builtin_amdgcn_mfma_f32_32x32x16_bf16(va, kb, acc, 0, 0, 0);
            }
            float* o = CKV + (size_t)u * 2048;
#pragma unroll
            for (int r = 0; r < 16; ++r) { const int e = 32 * wave + (r & 3) + 8 * (r >> 2) + 4 * hh; o[e * 32 + l31] = acc[r]; }
        }
        __syncthreads();
    }
}
__device__ __forceinline__ void ret_pass_c(const Args& a, LAS unsigned char* lds, int tid, int wave, int lane, int G) {
    const bf16_t* PROJ = (const bf16_t*)(a.ws + R_PROJ); const float* rope = (const float*)(a.ws + WS_ROPE); const float* CKV = (const float*)(a.ws + R_CKV);
    bf16_t* MIX = (bf16_t*)(a.ws + R_MIX);
    LAS bf16_t* VT = (LAS bf16_t*)lds; LAS bf16_t* QS = (LAS bf16_t*)(lds + 16384); LAS bf16_t* KS = (LAS bf16_t*)(lds + 24576); LAS bf16_t* RT = (LAS bf16_t*)(lds + 32768);
    LAS float* SSQ = (LAS float*)(lds + 36864);
    const int hh = lane >> 5, l31 = lane & 31, cb = wave & 3, eb = wave >> 2;
    const int vm = tid >> 2, veg = tid & 3;
    const int row = tid & 127, ch = tid >> 7;
    const int re = tid >> 3, rd0 = (tid & 7) * 4;
    for (int su = blockIdx.x; su < NB * 4 * 8; su += G) {
        const int bh = su >> 3, h = bh & 3, b = bh >> 2, n0 = (su & 7) * 8;
        const float gam = 1.0f - exp2f(-5.0f - (float)h), lg2 = log2f(gam), cd = exp2f(128.0f * lg2);
        const float* ck = CKV + ((size_t)((b * 64) * 4 + h)) * 2048 + re * 32 + rd0;
        f32x4 Rc = (f32x4){0.f, 0.f, 0.f, 0.f};
        for (int nn = 0; nn + 1 < n0; nn += 8) { f32x4 c8[8];
#pragma unroll
            for (int i = 0; i < 8; ++i) c8[i] = (nn + i < n0 - 1) ? *(const f32x4*)(ck + (size_t)(nn + i) * 4 * 2048) : (f32x4){0.f, 0.f, 0.f, 0.f};
#pragma unroll
            for (int i = 0; i < 8; ++i) if (nn + i < n0 - 1) Rc = Rc * cd + c8[i]; }
        u32x4 sv0, sv1, sqo, sqp, sko, skp; f32x4 sc0, sc1, sc2, sc3, sck;
#define RC_LOAD(n_) do { const size_t t0_ = (size_t)b * SEQ + (size_t)(n_) * 128; \
            const bf16_t* pv_ = PROJ + (t0_ + vm) * INWP + C_RV + h * 64 + veg * 16; sv0 = *(const u32x4*)pv_; sv1 = *(const u32x4*)(pv_ + 8); \
            const bf16_t* pq_ = PROJ + (t0_ + row) * INWP + C_RQ + h * 32; sqo = *(const u32x4*)(pq_ + 8 * ch); sqp = *(const u32x4*)(pq_ + 8 * (ch ^ 2)); \
            const bf16_t* pk_ = PROJ + (t0_ + row) * INWP + C_RK + h * 32; sko = *(const u32x4*)(pk_ + 8 * ch); skp = *(const u32x4*)(pk_ + 8 * (ch ^ 2)); \
            const f32x4* cs_ = (const f32x4*)(rope + ((t0_ + row) * 16 + (ch & 1) * 8) * 2); sc0 = cs_[0]; sc1 = cs_[1]; sc2 = cs_[2]; sc3 = cs_[3]; \
            sck = (n_) > 0 ? *(const f32x4*)(ck + (size_t)((n_) - 1) * 4 * 2048) : (f32x4){0.f, 0.f, 0.f, 0.f}; } while (0)
        RC_LOAD(n0);
        for (int kq = 0; kq < 8; ++kq) {
            const int n = n0 + kq; const size_t t0 = (size_t)b * SEQ + (size_t)n * 128;
            {
                const int ks = vm >> 4, w = vm & 15, vh = (w >> 2) & 1, j = 4 * (w >> 3) + (w & 3);
                const unsigned vw[8] = {sv0.x, sv0.y, sv0.z, sv0.w, sv1.x, sv1.y, sv1.z, sv1.w};
                LAS bf16_t* d = VT + ((ks * 2 + vh) * 64 + veg * 16) * 8 + j;
#pragma unroll
                for (int i = 0; i < 16; ++i) d[i * 8] = (bf16_t)((i & 1) ? (vw[i >> 1] >> 16) : (vw[i >> 1] & 0xffffu));
            }
            {
                const float cc[8] = {sc0.x, sc0.z, sc1.x, sc1.z, sc2.x, sc2.z, sc3.x, sc3.z}, sn[8] = {sc0.y, sc0.w, sc1.y, sc1.w, sc2.y, sc2.w, sc3.y, sc3.w};
                const unsigned qo[4] = {sqo.x, sqo.y, sqo.z, sqo.w}, qp[4] = {sqp.x, sqp.y, sqp.z, sqp.w}, ko[4] = {sko.x, sko.y, sko.z, sko.w}, kp[4] = {skp.x, skp.y, skp.z, skp.w};
                float oq[8], ok[8];
#pragma unroll
                for (int j = 0; j < 8; ++j) { const float xo = (j & 1) ? bfhi(qo[j >> 1]) : bflo(qo[j >> 1]), xp = (j & 1) ? bfhi(qp[j >> 1]) : bflo(qp[j >> 1]);
                    oq[j] = (ch < 2) ? (xo * cc[j] - xp * sn[j]) : (xp * sn[j] + xo * cc[j]);
                    const float yo = (j & 1) ? bfhi(ko[j >> 1]) : bflo(ko[j >> 1]), yp = (j & 1) ? bfhi(kp[j >> 1]) : bflo(kp[j >> 1]);
                    ok[j] = (ch < 2) ? (yo * cc[j] - yp * sn[j]) : (yp * sn[j] + yo * cc[j]); }
                const float qs = exp2f((float)row * lg2);
                u32x4 w; w.x = pk2(oq[0] * qs, oq[1] * qs); w.y = pk2(oq[2] * qs, oq[3] * qs); w.z = pk2(oq[4] * qs, oq[5] * qs); w.w = pk2(oq[6] * qs, oq[7] * qs);
                *(LAS u32x4*)(QS + (ch * 128 + row) * 8) = w;
                const float ks_ = 0.17677669529663687f * exp2f(-(float)row * lg2);
                w.x = pk2(ok[0] * ks_, ok[1] * ks_); w.y = pk2(ok[2] * ks_, ok[3] * ks_); w.z = pk2(ok[4] * ks_, ok[5] * ks_); w.w = pk2(ok[6] * ks_, ok[7] * ks_);
                *(LAS u32x4*)(KS + (ch * 128 + row) * 8) = w;
            }
            {
                if (n > 0) Rc = Rc * cd + sck;
                const f32x4 R = Rc;
                u32x2 w; w.x = pk2(R.x * gam, R.y * gam); w.y = pk2(R.z * gam, R.w * gam);
                *(LAS u32x2*)(RT + ((rd0 >> 3) * 64 + re) * 8 + (rd0 & 7)) = w;
            }
            LDS_BARRIER();
            if (kq < 7) RC_LOAD(n + 1);
            const size_t t = t0 + 32 * cb + l31;
            u32x2 gwv[4];
#pragma unroll
            for (int g = 0; g < 4; ++g) gwv[g] = *(const u32x2*)(PROJ + t * INWP + C_RG + h * 64 + 32 * eb + 8 * g + 4 * hh);
            f32x16 o;
#pragma unroll
            for (int r = 0; r < 16; ++r) o[r] = 0.f;
            bf16x8 qf[2];
#pragma unroll
            for (int s2 = 0; s2 < 2; ++s2) qf[s2] = *(const LAS bf16x8*)(QS + ((2 * s2 + hh) * 128 + 32 * cb + l31) * 8);
#pragma unroll
            for (int s2 = 0; s2 < 2; ++s2) { const bf16x8 ra = *(const LAS bf16x8*)(RT + ((2 * s2 + hh) * 64 + 32 * eb + l31) * 8); o = __builtin_amdgcn_mfma_f32_32x32x16_bf16(ra, qf[s2], o, 0, 0, 0); }
            for (int mb = 0; mb <= cb; ++mb) {
                f32x16 sc;
#pragma unroll
                for (int r = 0; r < 16; ++r) sc[r] = 0.f;
#pragma unroll
                for (int s2 = 0; s2 < 2; ++s2) { const bf16x8 ka = *(const LAS bf16x8*)(KS + ((2 * s2 + hh) * 128 + 32 * mb + l31) * 8); sc = __builtin_amdgcn_mfma_f32_32x32x16_bf16(ka, qf[s2], sc, 0, 0, 0); }
                if (mb == cb) {
#pragma unroll
                    for (int r = 0; r < 16; ++r) if ((r & 3) + 8 * (r >> 2) + 4 * hh > l31) sc[r] = 0.f;
                }
#pragma unroll
                for (int sb = 0; sb < 2; ++sb) { u32x4 w; w.x = cvt_pk_bf16(sc[8 * sb], sc[8 * sb + 1]); w.y = cvt_pk_bf16(sc[8 * sb + 2], sc[8 * sb + 3]); w.z = cvt_pk_bf16(sc[8 * sb + 4], sc[8 * sb + 5]); w.w = cvt_pk_bf16(sc[8 * sb + 6], sc[8 * sb + 7]);
                    const bf16x8 pb = __builtin_bit_cast(bf16x8, w);
                    const bf16x8 va = *(const LAS bf16x8*)(VT + (((2 * mb + sb) * 2 + hh) * 64 + 32 * eb + l31) * 8);
                    o = __builtin_amdgcn_mfma_f32_32x32x16_bf16(va, pb, o, 0, 0, 0); }
            }
            float ss = 0.f;
#pragma unroll
            for (int r = 0; r < 16; ++r) ss += o[r] * o[r];
            ss += __shfl_xor(ss, 32);
            if (hh == 0) SSQ[(cb * 2 + eb) * 32 + l31] = ss;
            LDS_BARRIER();
            const float tot = SSQ[(cb * 2) * 32 + l31] + SSQ[(cb * 2 + 1) * 32 + l31];
            const float rstd = __builtin_amdgcn_rsqf(tot * (1.0f / 64.0f) + NORM_EPS);
#pragma unroll
            for (int g = 0; g < 4; ++g) { const int e0 = 32 * eb + 8 * g + 4 * hh;
                const float g0 = bflo(gwv[g].x), g1 = bfhi(gwv[g].x), g2 = bflo(gwv[g].y), g3 = bfhi(gwv[g].y);
                u32x2 w; w.x = cvt_pk_bf16(o[4 * g] * rstd * g0 * sigmoidf_(g0), o[4 * g + 1] * rstd * g1 * sigmoidf_(g1)); w.y = cvt_pk_bf16(o[4 * g + 2] * rstd * g2 * sigmoidf_(g2), o[4 * g + 3] * rstd * g3 * sigmoidf_(g3));
                *(u32x2*)(MIX + t * 1024 + 768 + h * 64 + e0) = w; }
        }
#undef RC_LOAD
        __syncthreads();
    }
}
__device__ __forceinline__ float exp2_(float x) { return __builtin_amdgcn_exp2f(x); }
__device__ __forceinline__ void attn_unit(LAS unsigned char* lds, const bf16_t* QB, const unsigned char* KT, const unsigned char* VT, bf16_t* MIX, int bh, int qb, int tid, int wave, int lane) {
    const int b = bh >> 2, h = bh & 3, hh = lane >> 5, l31 = lane & 31, grp = wave >> 2;
    const int qrel = wave * 32 + l31;
    const size_t trow = (size_t)b * SEQ + (size_t)qb * 256 + qrel;
    bf16x8 qf[6];
#pragma unroll
    for (int s = 0; s < 6; ++s) qf[s] = *(const bf16x8*)(QB + trow * 384 + h * 96 + 16 * s + 8 * hh);
    f32x16 o0, o1;
#pragma unroll
    for (int r = 0; r < 16; ++r) { o0[r] = 0.f; o1[r] = 0.f; }
    float mrun = -1e30f, lsum = 0.f;
    const int ntile = 4 * (qb + 1);
    const unsigned char* kbase = KT + (size_t)bh * 128 * 12288 + lane * 16; const unsigned char* vbase = VT + (size_t)bh * 128 * 8192 + wave * 1024 + lane * 16;
    const int kp0 = wave * 1024, kp1 = (wave < 4 ? wave + 8 : wave) * 1024;
    LAS unsigned char* vring = lds + 36864;
#define AT_DMA_K(T, SLOT) do { const unsigned char* kp_ = kbase + (size_t)(T) * 12288; LAS unsigned char* kd_ = lds + (SLOT) * 12288; \
        __builtin_amdgcn_global_load_lds((const unsigned*)(kp_ + kp0), (LAS unsigned*)(kd_ + kp0), 16, 0, 0); \
        __builtin_amdgcn_global_load_lds((const unsigned*)(kp_ + kp1), (LAS unsigned*)(kd_ + kp1), 16, 0, 0); } while (0)
#define AT_DMA_V(T, SLOT) __builtin_amdgcn_global_load_lds((const unsigned*)(vbase + (size_t)(T) * 8192), (LAS unsigned*)(vring + (SLOT) * 8192 + wave * 1024), 16, 0, 0)
#define AT_BAR() asm volatile("s_barrier" ::: "memory")
#define AT_PV(SLOT) do { LAS unsigned char* vl = vring + (SLOT) * 8192; _Pragma("unroll") for (int ks = 0; ks < 4; ++ks) { \
        const bf16x8 va0 = *(const LAS bf16x8*)(vl + ((ks * 2 + hh) * 64 + l31) * 16); const bf16x8 va1 = *(const LAS bf16x8*)(vl + ((ks * 2 + hh) * 64 + 32 + l31) * 16); \
        o0 = __builtin_amdgcn_mfma_f32_32x32x16_bf16(va0, pb[ks], o0, 0, 0, 0); o1 = __builtin_amdgcn_mfma_f32_32x32x16_bf16(va1, pb[ks], o1, 0, 0, 0); } } while (0)
    AT_DMA_K(0, 0);
    AT_DMA_K(1, 1); AT_DMA_V(0, 0);
    *(LAS u32x4*)(vring + 2 * 8192 + tid * 16) = zero4();
    asm volatile("s_waitcnt vmcnt(3) lgkmcnt(0)" ::: "memory"); AT_BAR();
    if (grp) AT_BAR();
    int i0 = 0, i1 = 1, i2 = 2;
    bf16x8 pb[4];
#pragma unroll
    for (int ks = 0; ks < 4; ++ks) pb[ks] = __builtin_bit_cast(bf16x8, zero4());
    const int lrow = (hh * 64 + l31) * 16;
    for (int t = 0; t < ntile; ++t) {
        { const int tk = (t + 2 < ntile) ? t + 2 : ntile - 1, tv = (t + 1 < ntile) ? t + 1 : ntile - 1; AT_DMA_K(tk, i2); AT_DMA_V(tv, i1); }
        const int jr = t - 4 * qb;
        f32x16 s0, s1;
#pragma unroll
        for (int r = 0; r < 16; ++r) { s0[r] = 0.f; s1[r] = 0.f; }
        {
            LAS unsigned char* kl = lds + i0 * 12288 + lrow; LAS unsigned char* vl = vring + i2 * 8192 + lrow;
            bf16x8 kf[12], vf[8];
#pragma unroll
            for (int s = 0; s < 2; ++s) { kf[2 * s] = *(const LAS bf16x8*)(kl + s * 2048); kf[2 * s + 1] = *(const LAS bf16x8*)(kl + s * 2048 + 512); }
            __builtin_amdgcn_sched_barrier(0);
            __builtin_amdgcn_s_setprio(1);
#pragma unroll
            for (int s = 0; s < 6; ++s) {
                s0 = __builtin_amdgcn_mfma_f32_32x32x16_bf16(kf[2 * s], qf[s], s0, 0, 0, 0);
                s1 = __builtin_amdgcn_mfma_f32_32x32x16_bf16(kf[2 * s + 1], qf[s], s1, 0, 0, 0);
                if (s < 4) { kf[2 * s + 4] = *(const LAS bf16x8*)(kl + (s + 2) * 2048); kf[2 * s + 5] = *(const LAS bf16x8*)(kl + (s + 2) * 2048 + 512); }
                else {
#pragma unroll
                    for (int q = 0; q < 2; ++q) { const int ks = (s - 4) * 2 + q; vf[2 * ks] = *(const LAS bf16x8*)(vl + ks * 2048); vf[2 * ks + 1] = *(const LAS bf16x8*)(vl + ks * 2048 + 512); } }
                __builtin_amdgcn_sched_barrier(0);
            }
#pragma unroll
            for (int ks = 0; ks < 4; ++ks) { o0 = __builtin_amdgcn_mfma_f32_32x32x16_bf16(vf[2 * ks], pb[ks], o0, 0, 0, 0); o1 = __builtin_amdgcn_mfma_f32_32x32x16_bf16(vf[2 * ks + 1], pb[ks], o1, 0, 0, 0); }
            __builtin_amdgcn_s_setprio(0);
        }
        asm volatile("s_waitcnt vmcnt(3)" ::: "memory"); AT_BAR();
        {
            if (jr >= 0 && (64 * jr + 63 > wave * 32)) {
                const float ninf = -__builtin_inff();
#pragma unroll
                for (int r = 0; r < 16; ++r) { const int key = 64 * jr + (r & 3) + 8 * (r >> 2) + 4 * hh;
                    if (key > qrel) s0[r] = ninf; if (key + 32 > qrel) s1[r] = ninf; }
            }
            float mx = s0[0];
#pragma unroll
            for (int r = 1; r < 16; ++r) mx = fmaxf(mx, s0[r]);
#pragma unroll
            for (int r = 0; r < 16; ++r) mx = fmaxf(mx, s1[r]);
            mx = fmaxf(mx, __shfl_xor(mx, 32));
            const float mnew = fmaxf(mrun, mx);
            const float alpha = exp2_(mrun - mnew);
            float rs = 0.f;
#pragma unroll
            for (int r = 0; r < 16; ++r) { s0[r] = exp2_(s0[r] - mnew); s1[r] = exp2_(s1[r] - mnew); rs += s0[r] + s1[r]; }
            lsum = lsum * alpha + rs;
            if (__builtin_amdgcn_ballot_w64(mnew > mrun) != 0ull) {
#pragma unroll
                for (int r = 0; r < 16; ++r) { o0[r] *= alpha; o1[r] *= alpha; } }
            mrun = mnew;
#pragma unroll
            for (int ks = 0; ks < 4; ++ks) { u32x4 w;
                if (ks < 2) { w.x = cvt_pk_bf16(s0[8 * ks + 0], s0[8 * ks + 1]); w.y = cvt_pk_bf16(s0[8 * ks + 2], s0[8 * ks + 3]); w.z = cvt_pk_bf16(s0[8 * ks + 4], s0[8 * ks + 5]); w.w = cvt_pk_bf16(s0[8 * ks + 6], s0[8 * ks + 7]); }
                else { const int k2 = ks - 2; w.x = cvt_pk_bf16(s1[8 * k2 + 0], s1[8 * k2 + 1]); w.y = cvt_pk_bf16(s1[8 * k2 + 2], s1[8 * k2 + 3]); w.z = cvt_pk_bf16(s1[8 * k2 + 4], s1[8 * k2 + 5]); w.w = cvt_pk_bf16(s1[8 * k2 + 6], s1[8 * k2 + 7]); }
                pb[ks] = __builtin_bit_cast(bf16x8, w); }
        }
        AT_BAR();
        { const int tmp = i0; i0 = i1; i1 = i2; i2 = tmp; }
    }
    AT_PV(i2);
    asm volatile("s_waitcnt vmcnt(0)" ::: "memory"); AT_BAR();
    if (!grp) AT_BAR();
#undef AT_DMA_K
#undef AT_DMA_V
#undef AT_BAR
#undef AT_PV
    const float ltot = lsum + __shfl_xor(lsum, 32);
    const float inv = 1.0f / ltot;
    bf16_t* orow = MIX + trow * 1024 + 512 + h * 64;
#pragma unroll
    for (int g = 0; g < 4; ++g) {
        u32x2 w0, w1;
        w0.x = cvt_pk_bf16(o0[4 * g] * inv, o0[4 * g + 1] * inv); w0.y = cvt_pk_bf16(o0[4 * g + 2] * inv, o0[4 * g + 3] * inv);
        w1.x = cvt_pk_bf16(o1[4 * g] * inv, o1[4 * g + 1] * inv); w1.y = cvt_pk_bf16(o1[4 * g + 2] * inv, o1[4 * g + 3] * inv);
        *(u32x2*)(orow + 8 * g + 4 * hh) = w0; *(u32x2*)(orow + 32 + 8 * g + 4 * hh) = w1;
    }
}
__device__ __forceinline__ void attn_queue(const Args& a, int l, LAS unsigned char* lds, volatile LAS unsigned* qw, unsigned* qctr, int tid, int wave, int lane) {
    const bf16_t* QB = (const bf16_t*)(a.ws + R_QB); const unsigned char* KT = a.ws + R_KT; const unsigned char* VT = a.ws + R_VT; bf16_t* MIX = (bf16_t*)(a.ws + R_MIX);
    for (;;) {
        if (tid == 0) *qw = __hip_atomic_fetch_add(qctr, 1u, __ATOMIC_RELAXED, __HIP_MEMORY_SCOPE_AGENT);
        __syncthreads();
        const int u = (int)__builtin_amdgcn_readfirstlane(*qw);
        __syncthreads();
        if (u >= 1536) break;
        if (u < 1024 && (u & 1)) { conv_expert_item(a, l, u >> 1, (LAS float*)(lds + 65536 + wave * 8704), wave, lane); continue; }
        const int au = u < 1024 ? (u >> 1) : u - 512;
        attn_unit(lds, QB, KT, VT, MIX, au & 31, 31 - (au >> 5), tid, wave, lane);
    }
}
__device__ __forceinline__ void attn_phase(const Args& a, LAS unsigned char* lds, int tid, int wave, int lane, int G) {
    const bf16_t* QB = (const bf16_t*)(a.ws + R_QB); const unsigned char* KT = a.ws + R_KT; const unsigned char* VT = a.ws + R_VT; bf16_t* MIX = (bf16_t*)(a.ws + R_MIX);
    for (int u = blockIdx.x; u < 512; u += G) {
        int bh, pq;
        if ((G & 7) == 0 && (512 % G) == 0) { const int x = blockIdx.x & 7, jj = (u / G) * (G / 8) + (blockIdx.x >> 3); bh = x + 8 * (jj >> 4); pq = jj & 15; }
        else { bh = u >> 4; pq = u & 15; }
        attn_unit(lds, QB, KT, VT, MIX, bh, 31 - pq, tid, wave, lane);
        attn_unit(lds, QB, KT, VT, MIX, bh, pq, tid, wave, lane);
    }
}

__device__ __forceinline__ void rwkv_scan(const Args& a, LAS unsigned char* lds, int tid, int wave, int lane, int G) {
    const float* SI = (const float*)(a.ws + R_SI); float* YR = (float*)(a.ws + R_YRAW);
    constexpr int CH = 16, NCH = SEQ / CH;
    LAS float* buf = (LAS float*)lds;
    const int lt = tid >> 5, lp = tid & 31;
    for (int blk = blockIdx.x; blk < 256; blk += G) {
        int bh, rg;
        if (G == 256) { const int x = blk & 7, j = blk >> 3; bh = x * 4 + (j >> 3); rg = j & 7; }
        else { bh = blk >> 3; rg = blk & 7; }
        const int row = rg * 8 + wave, b = bh >> 2, h = bh & 3;
        const f32x4* src = (const f32x4*)(SI + ((size_t)b * SEQ * 4 + h) * 384 + (size_t)lt * 1536) + lp;
        float* yo = YR + (size_t)b * SEQ * 256 + h * 64 + row;
        f32x4 g0 = src[0], g1 = src[32], g2 = src[64];
        { LAS f32x4* d = (LAS f32x4*)(buf + lt * 384) + lp; d[0] = g0; d[32] = g1; d[64] = g2; }
        __syncthreads();
        float s = 0.f;
        for (int c = 0; c < NCH; ++c) {
            const bool more = (c + 1 < NCH);
            if (more) { const f32x4* sn = src + (size_t)(c + 1) * CH * 384; g0 = sn[0]; g1 = sn[32]; g2 = sn[64]; }
            const LAS float* cb = buf + (c & 1) * CH * 384;
            float ykeep = 0.f;
#pragma unroll
            for (int i = 0; i < CH; ++i) {
                const LAS float* p = cb + i * 384;
                const float r = p[lane], w = p[64 + lane], k = p[128 + lane], kk = p[192 + lane], bb = p[256 + lane], v = p[320 + row];
                const float sa = -wave_sum_bc(s * kk);
                s = fmaf(sa, bb, fmaf(s, w, v * k));
                const float y = wave_sum_bc(s * r);
                ykeep = (lane == i) ? y : ykeep;
            }
            if (lane < CH) yo[(size_t)(c * CH + lane) * 256] = ykeep;
            if (more) { LAS f32x4* d = (LAS f32x4*)(buf + ((c + 1) & 1) * CH * 384 + lt * 384) + lp; d[0] = g0; d[32] = g1; d[64] = g2; }
            __syncthreads();
        }
    }
}
constexpr size_t RWP_CHUNK = 22 * 1024;
__device__ __forceinline__ u32x4 pack8(const float* x) { u32x4 w; w.x = cvt_pk_bf16(x[0], x[1]); w.y = cvt_pk_bf16(x[2], x[3]); w.z = cvt_pk_bf16(x[4], x[5]); w.w = cvt_pk_bf16(x[6], x[7]); return w; }
__device__ __forceinline__ bf16x8 frag2(const LAS bf16_t* p0, const LAS bf16_t* p1) { const u32x2 lo = *(const LAS u32x2*)p0, hi = *(const LAS u32x2*)p1; u32x4 w; w.x = lo.x; w.y = lo.y; w.z = hi.x; w.w = hi.y; return __builtin_bit_cast(bf16x8, w); }
__device__ __forceinline__ void rwkv_pre(const Args& a, int l, LAS unsigned char* lds, int wave, int lane, int G) {
    const bf16_t* PROJ = (const bf16_t*)(a.ws + R_PROJ); const bf16_t* LO = (const bf16_t*)(a.ws + R_LO); float* VF = (float*)(a.ws + WS_VF); bf16_t* BON = (bf16_t*)(a.ws + R_SI);
    unsigned char* RWP = a.ws + R_SI + 64 * MiB;
    LAS unsigned char* L = lds + wave * 16384;
    LAS bf16_t* AT = (LAS bf16_t*)L; LAS bf16_t* BH = (LAS bf16_t*)(L + 4096); LAS bf16_t* KH = (LAS bf16_t*)(L + 8192); LAS bf16_t* RT = (LAS bf16_t*)(L + 12288);
    LAS float* LT = (LAS float*)L; LAS float* TAL = (LAS float*)(L + 4096); LAS bf16_t* BB = (LAS bf16_t*)(L + 8192);
    LAS bf16_t* WL = (LAS bf16_t*)L; LAS bf16_t* GL = (LAS bf16_t*)(L + 4096);
    const int hh = lane >> 5, l31 = lane & 31;
    for (int ci = blockIdx.x * 8 + wave; ci < NB * 4 * 256; ci += G * 8) {
        const int bh = ci >> 8, c = ci & 255, b = bh >> 2, h = bh & 3;
        const size_t tok0 = (size_t)b * SEQ + (size_t)c * 32; const int jj = h * 64 + lane;
        unsigned char* out = RWP + (size_t)ci * RWP_CHUNK;
        float at[32], vv[32], bhv[32], khv[32];
        float pC;
        {
            const float* mu = FIN(I_RWMU) + l * 1024;
            const float mur = mu[jj], muk = mu[256 + jj], muv = mu[512 + jj];
            const float w0 = FIN(I_RWW0)[l * 256 + jj], a0 = FIN(I_RWA0)[l * 256 + jj], kkp = FIN(I_RWKK)[l * 256 + jj], kap = FIN(I_RWKA)[l * 256 + jj], rkp = FIN(I_RWRK)[l * 256 + jj];
            const float v0 = l > 0 ? FIN(I_RWV0)[(l - 1) * 256 + jj] : 0.f;
            float rp = 0.f, kp = 0.f, vp = 0.f;
            if (c != 0) { const bf16_t* pp = PROJ + (tok0 - 1) * INWP; rp = bf2f(pp[C_RWR + jj]); kp = bf2f(pp[C_RWK + jj]); vp = bf2f(pp[C_RWV + jj]); }
            float p = 1.f;
            unsigned raw[2][4][6]; float rvf[2][4];
#define RW_LOADG(buf_, g_) do { _Pragma("unroll") for (int q_ = 0; q_ < 4; ++q_) { const size_t tk_ = tok0 + 4 * (g_) + q_; const bf16_t* pc_ = PROJ + tk_ * INWP; const bf16_t* lo_ = LO + tk_ * 1024; \
                raw[buf_][q_][0] = pc_[C_RWR + jj]; raw[buf_][q_][1] = pc_[C_RWK + jj]; raw[buf_][q_][2] = pc_[C_RWV + jj]; raw[buf_][q_][3] = lo_[jj]; raw[buf_][q_][4] = lo_[256 + jj]; \
                raw[buf_][q_][5] = lo_[768 + jj]; rvf[buf_][q_] = VF[tk_ * 256 + jj]; } } while (0)
            RW_LOADG(0, 0);
#pragma unroll
            for (int t = 0; t < 32; ++t) { const size_t tok = tok0 + t; const int g_ = t >> 2, q = t & 3, bu = g_ & 1;
                if (q == 0 && g_ < 7) { RW_LOADG(bu ^ 1, g_ + 1); asm volatile("" ::: "memory"); }
                const float rc = bf2f(raw[bu][q][0]), kc = bf2f(raw[bu][q][1]), vc = bf2f(raw[bu][q][2]);
                const float r = rc + (rp - rc) * mur, k = kc + (kp - kc) * muk; float v = vc + (vp - vc) * muv; rp = rc; kp = kc; vp = vc;
                const float wl = w0 + bf2f(raw[bu][q][3]); const float w = __expf(-__expf(-__logf(1.0f + __expf(-wl)) - 0.5f));
                const float aa = sigmoidf_(a0 + bf2f(raw[bu][q][4]));
                if (l > 0) { const float vf = rvf[bu][q]; v += (vf - v) * sigmoidf_(v0 + bf2f(raw[bu][q][5])); } else VF[tok * 256 + jj] = v;
                const float kk0 = k * kkp; const float kk = kk0 * __builtin_amdgcn_rcpf(fmaxf(sqrtf(wave_sum_bc(kk0 * kk0)), 1e-12f));
                const float kx = k * (1.0f + (aa - 1.0f) * kap), bb = kk * aa;
                BON[tok * 256 + jj] = cvt1(wave_sum_bc(r * kx * rkp) * v);
                vv[t] = v;
                const float pprev = p; p *= w; at[t] = -kk * pprev; const float ip = __builtin_amdgcn_rcpf(p); bhv[t] = bb * ip; khv[t] = kx * ip;
                const int idx = ((lane >> 3) * 32 + t) * 8 + (lane & 7);
                AT[idx] = cvt1(at[t]); BH[idx] = cvt1(bhv[t]); KH[idx] = cvt1(khv[t]); RT[idx] = cvt1(r * p);
                if ((t & 3) == 3) asm volatile("" ::: "memory"); }
#undef RW_LOADG
            pC = p;
        }
        {
#pragma unroll
            for (int sh = 0; sh < 4; ++sh) { const int s2 = sh >> 1, h2 = sh & 1; float x[8];
#pragma unroll
                for (int j = 0; j < 8; ++j) x[j] = vv[16 * s2 + 8 * (j >> 2) + 4 * h2 + (j & 3)];
                *(u32x4*)(out + (size_t)(18 + sh) * 1024 + lane * 16) = pack8(x); }
        }
        LDS_WAIT();
        f32x16 lt, ta, abr, akr;
#pragma unroll
        for (int r = 0; r < 16; ++r) { lt[r] = 0.f; ta[r] = 0.f; abr[r] = 0.f; akr[r] = 0.f; }
#pragma unroll
        for (int s4 = 0; s4 < 4; ++s4) { const int fo = ((2 * s4 + hh) * 32 + l31) * 8;
            const bf16x8 fa = *(const LAS bf16x8*)(AT + fo), fb = *(const LAS bf16x8*)(BH + fo), fk = *(const LAS bf16x8*)(KH + fo), fr = *(const LAS bf16x8*)(RT + fo);
            lt = __builtin_amdgcn_mfma_f32_32x32x16_bf16(fa, fb, lt, 0, 0, 0); ta = __builtin_amdgcn_mfma_f32_32x32x16_bf16(fa, fk, ta, 0, 0, 0);
            abr = __builtin_amdgcn_mfma_f32_32x32x16_bf16(fb, fr, abr, 0, 0, 0); akr = __builtin_amdgcn_mfma_f32_32x32x16_bf16(fk, fr, akr, 0, 0, 0); }
#pragma unroll
        for (int r = 0; r < 16; ++r) { const int row = (r & 3) + 8 * (r >> 2) + 4 * hh;
            if (!(l31 < row)) { lt[r] = 0.f; ta[r] = 0.f; } if (!(row <= l31)) { abr[r] = 0.f; akr[r] = 0.f; } }
        LDS_WAIT();
#pragma unroll
        for (int r = 0; r < 16; ++r) { const int row = (r & 3) + 8 * (r >> 2) + 4 * hh; LT[row * 32 + l31] = lt[r]; TAL[row * 32 + l31] = ta[r]; }
#pragma unroll
        for (int ic = 0; ic < 4; ++ic) { float x[8];
#pragma unroll
            for (int j = 0; j < 8; ++j) { x[j] = bhv[8 * ic + j] * pC; khv[8 * ic + j] *= pC; }
            *(LAS u32x4*)(BB + (ic * 64 + lane) * 8) = pack8(x); }
        LDS_WAIT();
        {
            float g[32];
#pragma unroll
            for (int j = 0; j < 32; ++j) g[j] = TAL[j * 32 + l31];
#pragma unroll
            for (int j = 1; j < 32; ++j) {
#pragma unroll
                for (int i4 = 0; i4 * 4 < j; ++i4) { const f32x4 c4 = *(const LAS f32x4*)(LT + j * 32 + 4 * i4);
#pragma unroll
                    for (int ii = 0; ii < 4; ++ii) { const int i = 4 * i4 + ii; if (i < j) { at[j] = fmaf(at[i], c4[ii], at[j]); g[j] = fmaf(g[i], c4[ii], g[j]); } } }
                if ((j & 1) == 1) asm volatile("" ::: "memory"); }
            LDS_WAIT();
#pragma unroll
            for (int ic = 0; ic < 4; ++ic) { *(LAS u32x4*)(WL + (ic * 64 + lane) * 8) = pack8(at + 8 * ic); if (lane < 32) *(LAS u32x4*)(GL + (ic * 32 + lane) * 8) = pack8(g + 8 * ic); }
        }
        LDS_WAIT();
        bf16x8 ab[2];
#pragma unroll
        for (int s2 = 0; s2 < 2; ++s2) { float x[8];
#pragma unroll
            for (int j = 0; j < 8; ++j) x[j] = abr[8 * s2 + j];
            ab[s2] = __builtin_bit_cast(bf16x8, pack8(x)); }
        bf16x8 gf[2];
#pragma unroll
        for (int s2 = 0; s2 < 2; ++s2) gf[s2] = frag2(GL + ((2 * s2) * 32 + l31) * 8 + 4 * hh, GL + ((2 * s2 + 1) * 32 + l31) * 8 + 4 * hh);
#define RW_STORE_TILE(acc_, unit_) do { _Pragma("unroll") for (int s2_ = 0; s2_ < 2; ++s2_) { float x_[8]; _Pragma("unroll") for (int j_ = 0; j_ < 8; ++j_) x_[j_] = acc_[8 * s2_ + j_]; \
            *(u32x4*)(out + (size_t)((unit_) + s2_) * 1024 + lane * 16) = pack8(x_); } } while (0)
        {
            f32x16 acc = akr;
#pragma unroll
            for (int s2 = 0; s2 < 2; ++s2) acc = __builtin_amdgcn_mfma_f32_32x32x16_bf16(gf[s2], ab[s2], acc, 0, 0, 0);
            RW_STORE_TILE(acc, 16);
        }
        const float pcv0 = __shfl(pC, l31), pcv1 = __shfl(pC, 32 + l31);
#pragma unroll
        for (int kb = 0; kb < 2; ++kb) {
            bf16x8 wf[2];
#pragma unroll
            for (int s2 = 0; s2 < 2; ++s2) wf[s2] = frag2(WL + ((2 * s2) * 64 + 32 * kb + l31) * 8 + 4 * hh, WL + ((2 * s2 + 1) * 64 + 32 * kb + l31) * 8 + 4 * hh);
            {
                f32x16 acc;
#pragma unroll
                for (int g4 = 0; g4 < 4; ++g4) { const u32x2 w = *(const LAS u32x2*)(RT + ((4 * kb + g4) * 32 + l31) * 8 + 4 * hh);
                    acc[4 * g4] = bflo(w.x); acc[4 * g4 + 1] = bfhi(w.x); acc[4 * g4 + 2] = bflo(w.y); acc[4 * g4 + 3] = bfhi(w.y); }
#pragma unroll
                for (int s2 = 0; s2 < 2; ++s2) acc = __builtin_amdgcn_mfma_f32_32x32x16_bf16(wf[s2], ab[s2], acc, 0, 0, 0);
                RW_STORE_TILE(acc, 8 + kb * 2);
            }
#pragma unroll
            for (int q = 0; q < 2; ++q) {
                f32x16 acc;
#pragma unroll
                for (int r = 0; r < 16; ++r) acc[r] = 0.f;
#pragma unroll
                for (int s2 = 0; s2 < 2; ++s2) { const bf16x8 bf_ = frag2(BB + ((2 * s2) * 64 + 32 * q + l31) * 8 + 4 * hh, BB + ((2 * s2 + 1) * 64 + 32 * q + l31) * 8 + 4 * hh);
                    acc = __builtin_amdgcn_mfma_f32_32x32x16_bf16(wf[s2], bf_, acc, 0, 0, 0); }
                if (kb == q) { const float pcv = q ? pcv1 : pcv0;
#pragma unroll
                    for (int r = 0; r < 16; ++r) if ((r & 3) + 8 * (r >> 2) + 4 * hh == l31) acc[r] += pcv; }
                RW_STORE_TILE(acc, (kb * 2 + q) * 2);
            }
        }
#pragma unroll
        for (int q = 0; q < 2; ++q) {
            f32x16 acc;
#pragma unroll
            for (int g4 = 0; g4 < 4; ++g4)
#pragma unroll
                for (int jx = 0; jx < 4; ++jx) { const float va = __shfl(khv[8 * g4 + jx], 32 * q + l31), vb = __shfl(khv[8 * g4 + 4 + jx], 32 * q + l31); acc[4 * g4 + jx] = hh ? vb : va; }
#pragma unroll
            for (int s2 = 0; s2 < 2; ++s2) { const bf16x8 bf_ = frag2(BB + ((2 * s2) * 64 + 32 * q + l31) * 8 + 4 * hh, BB + ((2 * s2 + 1) * 64 + 32 * q + l31) * 8 + 4 * hh);
                acc = __builtin_amdgcn_mfma_f32_32x32x16_bf16(gf[s2], bf_, acc, 0, 0, 0); }
            RW_STORE_TILE(acc, 12 + q * 2);
        }
#undef RW_STORE_TILE
        LDS_WAIT();
    }
}
__device__ __forceinline__ void rwkv_main(const Args& a, int l, LAS unsigned char* lds, int bh, int tid, int wave, int lane) {
    const unsigned char* RWP = a.ws + R_SI + 64 * MiB + (size_t)bh * 256 * RWP_CHUNK;
    const bf16_t* BON = (const bf16_t*)(a.ws + R_SI); const bf16_t* LO = (const bf16_t*)(a.ws + R_LO); bf16_t* MIX = (bf16_t*)(a.ws + R_MIX);
    LAS float* YB = (LAS float*)(lds + 45056);
    const int hh = lane >> 5, l31 = lane & 31, vb = wave;
    f32x16 st[2];
#pragma unroll
    for (int r = 0; r < 16; ++r) { st[0][r] = 0.f; st[1][r] = 0.f; }
    u32x4 g0, g1, g2 = zero4();
    g0 = *(const u32x4*)(RWP + tid * 16); g1 = *(const u32x4*)(RWP + (512 + tid) * 16); if (tid < 384) g2 = *(const u32x4*)(RWP + (1024 + tid) * 16);
    *(LAS u32x4*)(lds + tid * 16) = g0; *(LAS u32x4*)(lds + (512 + tid) * 16) = g1; if (tid < 384) *(LAS u32x4*)(lds + (1024 + tid) * 16) = g2;
    __syncthreads();
    const int jj = (bh & 3) * 64 + lane;
    const float lng = FIN(I_RWLG)[l * 256 + jj], lnb = FIN(I_RWLB)[l * 256 + jj];
    float pb_[4], pg_[4];
#define RW_POST_LOAD(cc_) do { _Pragma("unroll") for (int q_ = 0; q_ < 4; ++q_) { const size_t tok_ = (size_t)(bh >> 2) * SEQ + (size_t)(cc_) * 32 + wave * 4 + q_; pb_[q_] = bf2f(BON[tok_ * 256 + jj]); pg_[q_] = bf2f(LO[tok_ * 1024 + 512 + jj]); } } while (0)
#define RW_POST(cc_) do { const LAS float* yb_ = YB + ((cc_) & 1) * 2048; _Pragma("unroll") for (int q_ = 0; q_ < 4; ++q_) { const int t_ = wave * 4 + q_; const size_t tok_ = (size_t)(bh >> 2) * SEQ + (size_t)(cc_) * 32 + t_; \
        const float y_ = yb_[t_ * 64 + lane]; const float mean_ = wave_sum(y_) * (1.0f / 64.0f); const float d_ = y_ - mean_; const float var_ = wave_sum(d_ * d_) * (1.0f / 64.0f); \
        const float yn_ = d_ * __builtin_amdgcn_rsqf(var_ + 64e-5f) * lng + lnb; \
        MIX[tok_ * 1024 + 256 + jj] = (bf16_t)f2bf((yn_ + pb_[q_]) * pg_[q_]); } } while (0)
    for (int c = 0; c < 256; ++c) {
        const bool more = (c + 1 < 256);
        if (c > 0) RW_POST_LOAD(c - 1);
        if (more) { const unsigned char* nx = RWP + (size_t)(c + 1) * RWP_CHUNK; g0 = *(const u32x4*)(nx + tid * 16); g1 = *(const u32x4*)(nx + (512 + tid) * 16); if (tid < 384) g2 = *(const u32x4*)(nx + (1024 + tid) * 16); }
        if (wave < 2) {
            const LAS unsigned char* in = lds + (c & 1) * 22528;
#define RW_F(unit_) (*(const LAS bf16x8*)(in + (unit_) * 1024 + lane * 16))
            const bf16x8 vf0 = *(const LAS bf16x8*)(in + (18 + hh) * 1024 + (32 * vb + l31) * 16), vf1 = *(const LAS bf16x8*)(in + (20 + hh) * 1024 + (32 * vb + l31) * 16);
            bf16x8 hi[2][2], lo[2][2];
#pragma unroll
            for (int kb = 0; kb < 2; ++kb)
#pragma unroll
                for (int s2 = 0; s2 < 2; ++s2) { float xh[8], xl[8];
#pragma unroll
                    for (int j = 0; j < 8; ++j) { const float x = st[kb][8 * s2 + j]; const float hf = bf2f(f2bf(x)); xh[j] = hf; xl[j] = x - hf; }
                    hi[kb][s2] = __builtin_bit_cast(bf16x8, pack8(xh)); lo[kb][s2] = __builtin_bit_cast(bf16x8, pack8(xl)); }
            f32x16 y, n0, n1;
#pragma unroll
            for (int r = 0; r < 16; ++r) { y[r] = 0.f; n0[r] = 0.f; n1[r] = 0.f; }
#pragma unroll
            for (int kb = 0; kb < 2; ++kb)
#pragma unroll
                for (int s2 = 0; s2 < 2; ++s2) {
                    y = __builtin_amdgcn_mfma_f32_32x32x16_bf16(RW_F(8 + kb * 2 + s2), hi[kb][s2], y, 0, 0, 0);
                    const bf16x8 m0 = RW_F((kb * 2 + 0) * 2 + s2), m1 = RW_F((kb * 2 + 1) * 2 + s2);
                    n0 = __builtin_amdgcn_mfma_f32_32x32x16_bf16(m0, hi[kb][s2], n0, 0, 0, 0); n0 = __builtin_amdgcn_mfma_f32_32x32x16_bf16(m0, lo[kb][s2], n0, 0, 0, 0);
                    n1 = __builtin_amdgcn_mfma_f32_32x32x16_bf16(m1, hi[kb][s2], n1, 0, 0, 0); n1 = __builtin_amdgcn_mfma_f32_32x32x16_bf16(m1, lo[kb][s2], n1, 0, 0, 0);
                }
            y = __builtin_amdgcn_mfma_f32_32x32x16_bf16(RW_F(16), vf0, y, 0, 0, 0); y = __builtin_amdgcn_mfma_f32_32x32x16_bf16(RW_F(17), vf1, y, 0, 0, 0);
            n0 = __builtin_amdgcn_mfma_f32_32x32x16_bf16(RW_F(12), vf0, n0, 0, 0, 0); n0 = __builtin_amdgcn_mfma_f32_32x32x16_bf16(RW_F(13), vf1, n0, 0, 0, 0);
            n1 = __builtin_amdgcn_mfma_f32_32x32x16_bf16(RW_F(14), vf0, n1, 0, 0, 0); n1 = __builtin_amdgcn_mfma_f32_32x32x16_bf16(RW_F(15), vf1, n1, 0, 0, 0);
#undef RW_F
            LAS float* yo = YB + (c & 1) * 2048 + 32 * vb + l31;
#pragma unroll
            for (int r = 0; r < 16; ++r) yo[((r & 3) + 8 * (r >> 2) + 4 * hh) * 64] = y[r];
            st[0] = n0; st[1] = n1;
        }
        if (c > 0) RW_POST(c - 1);
        if (more) { LAS unsigned char* d = lds + ((c + 1) & 1) * 22528; *(LAS u32x4*)(d + tid * 16) = g0; *(LAS u32x4*)(d + (512 + tid) * 16) = g1; if (tid < 384) *(LAS u32x4*)(d + (1024 + tid) * 16) = g2; }
        __syncthreads();
    }
    RW_POST_LOAD(255); RW_POST(255);
#undef RW_POST
#undef RW_POST_LOAD
    __syncthreads();
}

__device__ __forceinline__ void rwkv_post(const Args& a, int l, int wave, int lane, int G) {
    const float* SI = (const float*)(a.ws + R_SI); const float* YR = (const float*)(a.ws + R_YRAW); const bf16_t* LO = (const bf16_t*)(a.ws + R_LO); bf16_t* MIX = (bf16_t*)(a.ws + R_MIX);
#pragma unroll 4
    for (int idx = blockIdx.x * NWAVES + wave; idx < T * 4; idx += G * NWAVES) {
        const size_t t = idx >> 2; const int h = idx & 3, j = h * 64 + lane;
        const float y = YR[t * 256 + j];
        const float mean = wave_sum(y) * (1.0f / 64.0f); const float d = y - mean; const float var = wave_sum(d * d) * (1.0f / 64.0f);
        const float yn = d * __builtin_amdgcn_rsqf(var + 64e-5f) * FIN(I_RWLG)[l * 256 + j] + FIN(I_RWLB)[l * 256 + j];
        const float bonus = bf2f(((const bf16_t*)SI)[t * 256 + j]);
        const float g = bf2f(LO[t * 1024 + 512 + j]);
        MIX[t * 1024 + 256 + j] = (bf16_t)f2bf((yn + bonus) * g);
    }
}

__device__ __forceinline__ void phase_norm2(const Args& a, int l, LAS unsigned char* lds, int tid, int wave, int lane, int G) {
    LAS unsigned char* img_hi = lds; LAS unsigned char* img_lo = lds + 65536;
    LAS float* pbuf = (LAS float*)lds;
    LAS int* hist = (LAS int*)(lds + 135168);
    const float* rw = FIN(I_RTW) + (size_t)l * 1024 * 32;
    const float* MOD = (const float*)(a.ws + WS_MOD);
    int* tki = (int*)(a.ws + MO_IDX); float* tkw = (float*)(a.ws + MO_W); int* blkcnt = (int*)(a.ws + MO_BLKCNT);
    const float* gn = FIN(I_NFG) + l * D;
    const int hh = lane >> 5, l31 = lane & 31;
    bf16x8 whi[8], wlo[8];
#pragma unroll
    for (int s = 0; s < 8; ++s) { float xh[8], xl[8];
#pragma unroll
        for (int i = 0; i < 8; ++i) { const float w = rw[(size_t)(128 * wave + 16 * s + 8 * hh + i) * 32 + l31]; const float hf = bf2f(f2bf(w)); xh[i] = hf; xl[i] = w - hf; }
        whi[s] = __builtin_bit_cast(bf16x8, pack8(xh)); wlo[s] = __builtin_bit_cast(bf16x8, pack8(xl)); }
    const float rbias = FIN(I_RTB)[l * 32 + l31];
    for (int rb = blockIdx.x; rb < 256; rb += G) {
        if (tid < 32) hist[tid] = 0;
        f32x4 gsc[4], shv[4];
        { const int b0 = (rb * 256) >> 13; const float* sh = MOD + (size_t)(l * 8 + b0) * 6144 + 3072; const float* sc = sh + 1024;
#pragma unroll
          for (int j = 0; j < 4; ++j) { gsc[j] = ((const f32x4*)gn)[64 * j + lane] * (1.0f + ((const f32x4*)sc)[64 * j + lane]); shv[j] = ((const f32x4*)sh)[64 * j + lane]; } }
        f32x4 v[4][4];
#pragma unroll
        for (int q = 0; q < 4; ++q)
#pragma unroll
            for (int j = 0; j < 4; ++j) v[q][j] = ((const f32x4*)(a.out + (size_t)(rb * 256 + 4 * wave + q) * D))[64 * j + lane];
        for (int sbt = 0; sbt < 8; ++sbt) {
            const int mb = rb * 256 + sbt * 32;
#pragma unroll
            for (int q = 0; q < 4; ++q) { const int row = 4 * wave + q, m = mb + row; float ss = 0.f;
#pragma unroll
                for (int j = 0; j < 4; ++j) ss += (v[q][j].x * v[q][j].x + v[q][j].y * v[q][j].y) + (v[q][j].z * v[q][j].z + v[q][j].w * v[q][j].w);
                ss = wave_sum(ss);
                const float rstd = __builtin_amdgcn_rsqf(ss * (1.0f / D) + NORM_EPS);
#pragma unroll
                for (int j = 0; j < 4; ++j) { const f32x4 hq = v[q][j] * rstd * gsc[j] + shv[j]; ((unsigned*)(a.ws + WS_HN8 + (size_t)m * D))[64 * j + lane] = pk4_fp8(hq.x, hq.y, hq.z, hq.w);
                    u32x2 wh, wl; wh.x = cvt_pk_bf16(hq.x, hq.y); wh.y = cvt_pk_bf16(hq.z, hq.w);
                    wl.x = cvt_pk_bf16(hq.x - bflo(wh.x), hq.y - bfhi(wh.x)); wl.y = cvt_pk_bf16(hq.z - bflo(wh.y), hq.w - bfhi(wh.y));
                    const int off = row * 2048 + (((32 * j + (lane >> 1)) ^ (row & 15)) << 4) + ((lane & 1) << 3);
                    *(LAS u32x2*)(img_hi + off) = wh; *(LAS u32x2*)(img_lo + off) = wl; } }
            if (sbt < 7) {
#pragma unroll
                for (int q = 0; q < 4; ++q)
#pragma unroll
                    for (int j = 0; j < 4; ++j) v[q][j] = ((const f32x4*)(a.out + (size_t)(mb + 32 + 4 * wave + q) * D))[64 * j + lane];
            }
            LDS_BARRIER();
            f32x16 acc;
#pragma unroll
            for (int r = 0; r < 16; ++r) acc[r] = 0.f;
#pragma unroll
            for (int s = 0; s < 8; ++s) { const int off = l31 * 2048 + (((16 * wave + 2 * s + hh) ^ (l31 & 15)) << 4);
                const bf16x8 bh = *(const LAS bf16x8*)(img_hi + off), bl = *(const LAS bf16x8*)(img_lo + off);
                acc = __builtin_amdgcn_mfma_f32_32x32x16_bf16(whi[s], bh, acc, 0, 0, 0);
                acc = __builtin_amdgcn_mfma_f32_32x32x16_bf16(wlo[s], bh, acc, 0, 0, 0);
                acc = __builtin_amdgcn_mfma_f32_32x32x16_bf16(whi[s], bl, acc, 0, 0, 0); }
            LDS_BARRIER();
#pragma unroll
            for (int r = 0; r < 16; ++r) pbuf[wave * 1056 + ((r & 3) + 8 * (r >> 2) + 4 * hh) * 33 + l31] = acc[r];
            LDS_BARRIER();
            {
                float val[4]; float tv[4][4]; int ti[4][4];
#pragma unroll
                for (int q = 0; q < 4; ++q) { float sacc = 0.f;
#pragma unroll
                    for (int w2 = 0; w2 < 8; ++w2) sacc += pbuf[w2 * 1056 + l31 * 33 + 4 * wave + q];
                    val[q] = sacc + rbias; }
#pragma unroll
                for (int k = 0; k < 4; ++k) {
#pragma unroll
                    for (int q = 0; q < 4; ++q) { float mxv = val[q];
                        mxv = fmaxf(mxv, dpp_f<0xB1>(mxv)); mxv = fmaxf(mxv, dpp_f<0x4E>(mxv)); mxv = fmaxf(mxv, dpp_f<0x141>(mxv)); mxv = fmaxf(mxv, dpp_f<0x140>(mxv));
                        mxv = fmaxf(mxv, __builtin_bit_cast(float, __builtin_amdgcn_ds_swizzle(__builtin_bit_cast(int, mxv), 0x401F)));
                        const unsigned bal = (unsigned)__builtin_amdgcn_ballot_w64(val[q] == mxv);
                        const int idx = __builtin_ctz(bal);
                        tv[q][k] = mxv; ti[q][k] = idx; if ((lane & 31) == idx) val[q] = -__builtin_inff(); } }
#pragma unroll
                for (int q = 0; q < 4; ++q) { const int m = mb + 4 * wave + q;
                    const float e1 = __expf(tv[q][1] - tv[q][0]), e2 = __expf(tv[q][2] - tv[q][0]), e3 = __expf(tv[q][3] - tv[q][0]); const float inv = __builtin_amdgcn_rcpf(1.0f + e1 + e2 + e3);
                    if (lane == 0) {
                        tki[m * 4] = ti[q][0]; tki[m * 4 + 1] = ti[q][1]; tki[m * 4 + 2] = ti[q][2]; tki[m * 4 + 3] = ti[q][3];
                        tkw[m * 4] = inv; tkw[m * 4 + 1] = e1 * inv; tkw[m * 4 + 2] = e2 * inv; tkw[m * 4 + 3] = e3 * inv;
                        lds_add(&hist[ti[q][0]]); lds_add(&hist[ti[q][1]]); lds_add(&hist[ti[q][2]]); lds_add(&hist[ti[q][3]]); } }
            }
            LDS_BARRIER();
        }
        if (tid < 32) blkcnt[rb * 32 + tid] = hist[tid];
        __syncthreads();
    }
}
__device__ __forceinline__ void phase_plan(const Args& a, LAS unsigned char* lds, int tid, int G) {
    LAS int* tot = (LAS int*)lds; LAS int* base = tot + 32; LAS int* pstart = tot + 64; LAS int* cur = tot + 96;
    const int* blkcnt = (const int*)(a.ws + MO_BLKCNT); const int* tki = (const int*)(a.ws + MO_IDX);
    int* pos = (int*)(a.ws + MO_POS); int* rowtok = (int*)(a.ws + MO_ROWTOK); int* tile_e = (int*)(a.ws + MO_TILEE);
    unsigned* ctl = (unsigned*)(a.ws + WS_CTL);
    for (int rb = blockIdx.x; rb < 256; rb += G) {
        {
            LAS int* ptot = tot + 256; LAS int* pbase = tot + 768; const int e = tid & 31, part = tid >> 5; int c[16]; int t = 0, bs = 0;
#pragma unroll
            for (int j = 0; j < 16; ++j) c[j] = blkcnt[(part * 16 + j) * 32 + e];
#pragma unroll
            for (int j = 0; j < 16; ++j) { if (part * 16 + j < rb) bs += c[j]; t += c[j]; }
            ptot[part * 32 + e] = t; pbase[part * 32 + e] = bs;
            __syncthreads();
            if (tid < 32) { int tt = 0, bb = 0;
#pragma unroll
                for (int p = 0; p < 16; ++p) { tt += ptot[p * 32 + tid]; bb += pbase[p * 32 + tid]; }
                tot[tid] = tt; base[tid] = bb; cur[tid] = 0; }
        }
        __syncthreads();
        if (tid == 0) { int ps = 0; for (int e = 0; e < 32; ++e) { pstart[e] = ps; ps += (tot[e] + 255) & ~255; } if (rb == 0) ctl[CW_NTILES] = (unsigned)(ps >> 8); }
        __syncthreads();
        for (int q = tid; q < 1024; q += NTHR) { const int row = rb * 256 + (q >> 2), k = q & 3; const int e = tki[row * 4 + k];
            const int r = lds_add(&cur[e]); const int p = pstart[e] + base[e] + r; pos[row * 4 + k] = p; rowtok[p] = row; }
        if (rb < 32) { const int e = rb, pe = pstart[e] + ((tot[e] + 255) & ~255); for (int p = pstart[e] + tot[e] + tid; p < pe; p += NTHR) rowtok[p] = 0;
            for (int tl = (pstart[e] >> 8) + tid; tl < (pe >> 8); tl += NTHR) tile_e[tl] = e; }
        __syncthreads();
    }
}

constexpr int PH_PER_LAYER = 13, NPH = 2 + DEPTH * PH_PER_LAYER;
#ifndef MK_SPLIT
#define MK_SPLIT 0
#endif
struct KArgs { Args a; int li, pad; };

__global__ void __launch_bounds__(NTHR, 2) fwd(KArgs ka) {
    extern __shared__ __attribute__((aligned(16))) unsigned char lds_raw[];
    LAS unsigned char* lds = (LAS unsigned char*)lds_raw;
    const int tid0 = threadIdx.x, G = gridDim.x, wave0 = __builtin_amdgcn_readfirstlane(tid0 >> 6);
    volatile LAS unsigned* MISC = (volatile LAS unsigned*)(lds + MISC_OFF);
    if (tid0 < 32) MISC[tid0] = 0u;
    __syncthreads();
    unsigned* ctl0 = (unsigned*)(ka.a.ws + WS_CTL);
    const int lo = ka.a.ph_lo, hi = ka.a.ph_hi;
    XcdBarrier bar; bar.bar = ctl0 + CW_BAR + ka.li * XCD_BAR_WORDS; bar.x = 0; bar.st = MISC + 8;
    if (hi - lo > 1) bar = xcd_barrier_post(ctl0 + CW_BAR + ka.li * XCD_BAR_WORDS, MISC + 8);
#ifndef MK_PHMASK
#define MK_PHMASK 0xFFFF
#endif
#define PHM(j) ((MK_PHMASK >> (j)) & 1)
#ifndef PROBE_DUP
#define PROBE_DUP 0
#endif
#define REP(id) for (int rep_ = 0; rep_ < 1 + ((PROBE_DUP >> (id)) & 1); ++rep_)
#define IN(k) (lo <= (k) && (k) < hi)
#define SEAM(k) do { if (IN(k) && IN((k) + 1)) xcd_barrier(bar); } while (0)

#define FRESH() int lane; asm volatile("v_mbcnt_lo_u32_b32 %0, -1, 0\n\tv_mbcnt_hi_u32_b32 %0, -1, %0" : "=v"(lane)); int wave = wave0; asm volatile("" : "+s"(wave)); const int tid = wave * 64 + lane; (void)tid; \
    Args a = ka.a; { size_t z_ = 0; asm volatile("" : "+s"(z_)); a.ws = ka.a.ws + z_; a.out = ka.a.out + z_; } \
    bf16_t* PROJ = (bf16_t*)(a.ws + R_PROJ); bf16_t* MIX = (bf16_t*)(a.ws + R_MIX); bf16_t* HN = (bf16_t*)(a.ws + WS_HN); const bf16_t* SM = (const bf16_t*)(a.ws + WS_WSM); unsigned* ctl = (unsigned*)(a.ws + WS_CTL); (void)PROJ; (void)MIX; (void)HN; (void)SM; (void)ctl
    if (PHM(0) && IN(0)) { FRESH(); phase_init(a, lds, tid, G); SEAM(0); }

    for (int l = 0; l < DEPTH; ++l) {
        const int pb = 1 + l * PH_PER_LAYER;
        if (PHM(1) && IN(pb + 0)) { FRESH(); REP(0) phase_conv<0>(a, l, lds, tid, wave, lane, G); phase_norm1<0>(a, l, wave, lane, G); SEAM(pb + 0); }
        if (PHM(2) && IN(pb + 1)) { FRESH();
            pg8::Gemm g{HN, (const bf16_t*)(a.ws + WS_WIN), 1024, 1024, 1024, nullptr}; pg8::Order S; S.init(T / 256, INWP / 256, G, (int)blockIdx.x);
            pg8::EpiBf16 E{PROJ, INWP, nullptr, 0};
            REP(1) pg8::gemm_phase<pg8::EpiBf16, false>(lds, g, S, E, tid);
            SEAM(pb + 1);
        }
        if (PHM(3) && IN(pb + 2)) { FRESH(); REP(2) phase_pre(a, l, tid, G); s5_repack(a, tid, G); SEAM(pb + 2); }
        if (PHM(4) && IN(pb + 3)) { FRESH();
            const bf16_t* AP = (const bf16_t*)(a.ws + R_AP); bf16_t* QKV = (bf16_t*)(a.ws + R_QKV); bf16_t* LO = (bf16_t*)(a.ws + R_LO); bf16_t* BU = (bf16_t*)(a.ws + R_BU);
#define SMALL_GEMM(A_, LDA_, BOFF_, NN_, O_, LDC_) do { pg8::Gemm g{A_, SM + (BOFF_) / 2, LDA_, 256, 256, nullptr}; pg8::Order S; S.init(T / 256, NN_, G, (int)blockIdx.x); \
                pg8::EpiBf16 E{O_, LDC_, nullptr, 0}; pg8::gemm_phase<pg8::EpiBf16, false>(lds, g, S, E, tid); } while (0)
            REP(3) {
            SMALL_GEMM(PROJ + C_QC, INWP, SM_WQ, 2, QKV, 1024);
            SMALL_GEMM(PROJ + C_KVC, INWP, SM_WKV, 2, QKV + 512, 1024);
            SMALL_GEMM(AP, 512, SM_WLORA, 3, LO, 1024);
            if (l > 0) SMALL_GEMM(AP + 256, 512, SM_WVV, 1, LO + 768, 1024);
            { pg8::Gemm g{(const bf16_t*)(a.ws + R_UP), (const bf16_t*)(a.ws + R_WE), 768, 512, 512, nullptr}; pg8::Order S; S.init(128, 1, G, (int)blockIdx.x, (const int*)(a.ws + WS_S5TAB), (size_t)256 * 512);
              pg8::EpiS5E E{(float*)(a.ws + R_EB)}; pg8::gemm_phase<pg8::EpiS5E, false>(lds, g, S, E, tid); }
            }
#undef SMALL_GEMM
            SEAM(pb + 3);
        }
        if (PHM(5) && IN(pb + 4)) { FRESH();
            REP(4) mla_finish(a, lds, tid, G);
            REP(6) s5_chunk_scan(a, l, tid, G);
            __syncthreads();
            REP(7) ret_pass_a(a, lds, tid, wave, lane, G);
            SEAM(pb + 4);
        }
        if (PHM(6) && IN(pb + 5)) { FRESH();
            { pg8::Gemm g{(const bf16_t*)(a.ws + R_UP), (const bf16_t*)(a.ws + R_WY), 768, 768, 768, nullptr}; pg8::Order S; S.init(128, 2, G, (int)blockIdx.x, (const int*)(a.ws + WS_S5TAB), (size_t)512 * 768);
              pg8::EpiS5Y E{(bf16_t*)(a.ws + R_YG), PROJ, FIN(I_S5D) + l * 256}; pg8::gemm_phase<pg8::EpiS5Y, false>(lds, g, S, E, tid); }
            REP(9) { rwkv_pre(a, l, lds, wave, lane, G);
            __syncthreads(); }
            __syncthreads();
            REP(10) ret_pass_c(a, lds, tid, wave, lane, G);
            SEAM(pb + 5);
        }
        if (PHM(7) && IN(pb + 6)) { FRESH();
            pg8::Gemm g{(const bf16_t*)(a.ws + R_YG), SM + SM_WGLU / 2, 256, 256, 256, nullptr}; pg8::Order S; S.init(T / 256, 1, G > 64 ? G - 32 : G, G > 64 ? (int)blockIdx.x - 32 : (int)blockIdx.x);
            pg8::EpiGlu E{MIX, (const bf16_t*)(a.ws + R_YG), FIN(I_S5GB) + l * 256};
            if (G > 64) { if ((int)blockIdx.x < 32) rwkv_main(a, l, lds, (int)blockIdx.x, tid, wave, lane); else pg8::gemm_phase<pg8::EpiGlu, false>(lds, g, S, E, tid); }
            else { for (int bh = blockIdx.x; bh < 32; bh += G) rwkv_main(a, l, lds, bh, tid, wave, lane); pg8::gemm_phase<pg8::EpiGlu, false>(lds, g, S, E, tid); }
            __syncthreads();
            attn_queue(a, l, lds, (volatile LAS unsigned*)(lds + MISC_OFF + 64), ctl + CW_ATTQ + 64 * l, tid, wave, lane);
            SEAM(pb + 6);
        }
        if (PHM(8) && IN(pb + 7)) { FRESH();
        }
        if (PHM(9) && IN(pb + 8)) { FRESH();
            pg8::Gemm g{MIX, (const bf16_t*)(a.ws + WS_WOUT), 1024, 1024, 1024, nullptr}; pg8::Order S; S.init(T / 256, 4, G, (int)blockIdx.x);
            pg8::EpiResid E{l == 0 ? FIN(I_X) : a.out, a.out, (const float*)(a.ws + WS_MOD) + (size_t)(l * 8) * 6144 + 2048};
            pg8::gemm_phase<pg8::EpiResid, false>(lds, g, S, E, tid);
            SEAM(pb + 8);
        }
        if (PHM(10) && IN(pb + 9)) { FRESH(); REP(14) phase_norm2(a, l, lds, tid, wave, lane, G); SEAM(pb + 9); }
        if (PHM(11) && IN(pb + 10)) { FRESH(); REP(15) phase_plan(a, lds, tid, G); SEAM(pb + 10); }
        if (PHM(12) && IN(pb + 11)) { FRESH();
            const int ntiles = __builtin_amdgcn_readfirstlane((int)__hip_atomic_load(ctl + CW_NTILES, __ATOMIC_RELAXED, __HIP_MEMORY_SCOPE_AGENT));
            pg8::Gemm g{(const bf16_t*)(a.ws + WS_HN8), (const bf16_t*)(a.ws + WS_WGU), 512, 512, 512, (const int*)(a.ws + MO_ROWTOK)}; pg8::Order S; S.init(ntiles, 8, G, (int)blockIdx.x, (const int*)(a.ws + MO_TILEE), (size_t)2048 * 512);
            pg8::EpiSwiglu E{a.ws + R_H, FIN(I_EBG) + (size_t)l * 32 * 1024, FIN(I_EBU) + (size_t)l * 32 * 1024};
            REP(16) pg8::gemm_phase<pg8::EpiSwiglu, true, true>(lds, g, S, E, tid);
            SEAM(pb + 11);
        }
        if (PHM(13) && IN(pb + 12)) { FRESH();
            const int ntiles = __builtin_amdgcn_readfirstlane((int)__hip_atomic_load(ctl + CW_NTILES, __ATOMIC_RELAXED, __HIP_MEMORY_SCOPE_AGENT));
            pg8::Gemm g{(const bf16_t*)(a.ws + R_H), (const bf16_t*)(a.ws + WS_WDN), 512, 512, 512, nullptr}; pg8::Order S; S.init(ntiles, 4, G, (int)blockIdx.x, (const int*)(a.ws + MO_TILEE), (size_t)1024 * 512);
            pg8::EpiBf16 E{(bf16_t*)(a.ws + R_Y), 1024, FIN(I_EBD) + (size_t)l * 32 * 1024, 1024, 1};
            REP(17) pg8::gemm_phase<pg8::EpiBf16, false, true>(lds, g, S, E, tid);
            SEAM(pb + 12);
        }
    }
    if (PHM(14) && IN(NPH - 1)) { FRESH(); phase_norm1<1>(a, DEPTH, wave, lane, G); }
#undef IN
#undef SEAM
}

extern "C" void kernel_launch(void* const* d_in, const int* in_sizes, int n_in, void* d_out, int out_size, void* d_ws, size_t ws_size, hipStream_t stream) {
    static int grid = 0;
    if (grid == 0) {
        if (n_in != 46 || in_sizes[0] != T * D || out_size != T * D || ws_size < WS_END) {
            fprintf(stderr, "kernel_launch: unexpected problem: n_in %d in0 %d out %d ws %zu (need %zu)\n", n_in, n_in > 0 ? in_sizes[0] : -1, out_size, ws_size, (size_t)WS_END); grid = -1; return; }
        int dev = 0, cus = 0;
        if (hipGetDevice(&dev) != hipSuccess || hipDeviceGetAttribute(&cus, hipDeviceAttributeMultiprocessorCount, dev) != hipSuccess) { fprintf(stderr, "kernel_launch: device query failed\n"); grid = -1; return; }
        if (hipFuncSetAttribute((const void*)fwd, hipFuncAttributeMaxDynamicSharedMemorySize, LDS_BYTES) != hipSuccess) { fprintf(stderr, "kernel_launch: hipFuncSetAttribute failed\n"); grid = -1; return; }
        int per_cu = 0;
        if (hipOccupancyMaxActiveBlocksPerMultiprocessor(&per_cu, (const void*)fwd, NTHR, LDS_BYTES) != hipSuccess || per_cu < 1) fprintf(stderr, "kernel_launch: occupancy query reports %d\n", per_cu);
        (void)hipGetLastError();
        grid = cus;
    }
    if (grid < 0) return;
    if (hipMemsetAsync((char*)d_ws + WS_CTL, 0, CTL_ZERO_BYTES, stream) != hipSuccess) { fprintf(stderr, "kernel_launch: memset failed\n"); return; }
    KArgs ka{};
    for (int i = 0; i < 46; ++i) ka.a.in[i] = d_in[i];
    ka.a.out = (float*)d_out; ka.a.ws = (unsigned char*)d_ws;
#if MK_SPLIT
    for (int p = 0; p < NPH; ++p) { ka.a.ph_lo = p; ka.a.ph_hi = p + 1; ka.li = p; ka.pad = 0;
        hipLaunchKernelGGL(fwd, dim3(grid), dim3(NTHR), LDS_BYTES, stream, ka);
        const hipError_t le = hipPeekAtLastError(); if (le != hipSuccess) { fprintf(stderr, "kernel_launch: launch %d failed: %s\n", p, hipGetErrorName(le)); break; } }
#else
    ka.a.ph_lo = 0; ka.a.ph_hi = NPH; ka.li = 0; ka.pad = 0;
    hipLaunchKernelGGL(fwd, dim3(grid), dim3(NTHR), LDS_BYTES, stream, ka);
    const hipError_t le = hipPeekAtLastError(); if (le != hipSuccess) fprintf(stderr, "kernel_launch: launch failed: %s\n", hipGetErrorName(le));
#endif
}
```

```cpp
#include <hip/hip_runtime.h>
#include <cstdint>
#include <cstdio>

#define LAS __attribute__((address_space(3)))
#define GAS __attribute__((address_space(1)))
typedef unsigned short bf16_t;
typedef short bf16x8 __attribute__((ext_vector_type(8)));
typedef float f32x2 __attribute__((ext_vector_type(2)));
typedef float f32x4 __attribute__((ext_vector_type(4)));
typedef float f32x16 __attribute__((ext_vector_type(16)));
typedef unsigned u32x2 __attribute__((ext_vector_type(2)));
typedef unsigned u32x4 __attribute__((ext_vector_type(4)));

constexpr int NB = 8, SEQ = 8192, T = NB * SEQ, D = 1024, DEPTH = 4;
constexpr int INW = 2464, INWP = 2560;
constexpr int C_S5 = 0, C_RWR = 256, C_RWK = 512, C_RWV = 768, C_RWWD = 1024, C_QC = 1280, C_KVC = 1536, C_KPE = 1664;
constexpr int C_RQ = 1696, C_RK = 1824, C_RV = 1952, C_RG = 2208;
constexpr int NE = 32, TOPK = 4, PMAX = 270336  , MAXTILES = 1056;
constexpr float NORM_EPS = 1e-5f;

constexpr size_t MiB = 1u << 20;
constexpr size_t WS_CTL = 0, CTL_ZERO_BYTES = 1 * MiB;
constexpr size_t WS_MOD = 1 * MiB;
constexpr size_t WS_ROPE = 2 * MiB;
constexpr size_t WS_WIN = 10 * MiB;
constexpr size_t WS_WOUT = 15 * MiB;
constexpr size_t WS_WSM = 17 * MiB;
constexpr size_t WS_WGU = 21 * MiB;
constexpr size_t WS_WDN = 149 * MiB;
constexpr size_t WS_HN8 = 85 * MiB;
constexpr size_t WS_HN = 213 * MiB;
constexpr size_t WS_VF = 341 * MiB;
constexpr size_t WS_MOE = 405 * MiB;
constexpr size_t WS_REG = 413 * MiB;
constexpr size_t R_PROJ = WS_REG;
constexpr size_t R_MIX = R_PROJ + 320 * MiB;
constexpr size_t R_AP = R_MIX + 128 * MiB;
constexpr size_t R_E = R_AP;
constexpr size_t R_CKV = R_AP + 8 * MiB;
constexpr size_t R_YG = R_AP + 24 * MiB;
constexpr size_t R_LO = R_AP + 64 * MiB;
constexpr size_t R_SI = R_LO + 128 * MiB;
constexpr size_t R_QKV = R_SI + 384 * MiB;
constexpr size_t R_YRAW = R_QKV;
constexpr size_t R_BU = R_QKV + 128 * MiB;
constexpr size_t R_UP = R_BU;
constexpr size_t R_EB = R_BU + 64 * MiB;
constexpr size_t R_WE = R_BU + 96 * MiB;
constexpr size_t R_WY = R_BU + 104 * MiB;
constexpr size_t WS_KD = R_BU + 120 * MiB;
constexpr size_t WS_S5TAB = R_BU + 124 * MiB;
constexpr size_t R_QB = R_BU + 256 * MiB;
constexpr size_t R_KT = R_QB + 48 * MiB;
constexpr size_t R_VT = R_KT + 48 * MiB;
constexpr size_t R_END = R_VT + 32 * MiB;
constexpr size_t R_H = WS_REG;
constexpr size_t R_Y = WS_REG + 528 * MiB;
constexpr size_t WS_END = R_END;
static_assert(R_Y + 528 * MiB <= R_END, "MoE overlay fits the region");
constexpr size_t SM_WQ = 0;
constexpr size_t SM_WKV = 256 * 1024;
constexpr size_t SM_WLORA = 512 * 1024;
constexpr size_t SM_WVV = 896 * 1024;
constexpr size_t SM_WGLU = 1024 * 1024;
constexpr size_t SM_WBU = 1152 * 1024;
constexpr size_t SM_WC = 2176 * 1024;
constexpr size_t MO_IDX = WS_MOE, MO_W = WS_MOE + 1 * MiB, MO_POS = WS_MOE + 2 * MiB, MO_ROWTOK = WS_MOE + 3 * MiB, MO_BLKCNT = WS_MOE + 5 * MiB, MO_TILEE = WS_MOE + 5 * MiB + 64 * 1024;
constexpr int CW_NTILES = 16, CW_ATTQ = 64  , CW_BAR = 4096;

constexpr int NWAVES = 8, NTHR = 512;
constexpr int LDS_BYTES = 147456;
constexpr int MISC_OFF = 131072 + 8192;


__device__ __forceinline__ float bf2f(unsigned h) { return __builtin_bit_cast(float, h << 16); }
__device__ __forceinline__ float bflo(unsigned w) { return __builtin_bit_cast(float, w << 16); }
__device__ __forceinline__ float bfhi(unsigned w) { return __builtin_bit_cast(float, w & 0xffff0000u); }
typedef __bf16 bf16x2_t __attribute__((ext_vector_type(2)));
__device__ __forceinline__ unsigned cvt_pk_bf16(float lo, float hi) { const f32x2 v = {lo, hi}; const bf16x2_t b = __builtin_convertvector(v, bf16x2_t); return __builtin_bit_cast(unsigned, b); }
__device__ __forceinline__ u32x4 zero4() { unsigned z = 0u; asm volatile("" : "+v"(z)); u32x4 w; w.x = z; w.y = z; w.z = z; w.w = z; return w; }
__device__ __forceinline__ unsigned pk2(float lo, float hi) { return cvt_pk_bf16(lo, hi); }
__device__ __forceinline__ unsigned f2bf(float f) { return cvt_pk_bf16(f, f) & 0xffffu; }
__device__ __forceinline__ unsigned pk4_fp8(float a0, float a1, float a2, float a3) { int w = 0; w = __builtin_amdgcn_cvt_pk_fp8_f32(a0, a1, w, false); w = __builtin_amdgcn_cvt_pk_fp8_f32(a2, a3, w, true); return (unsigned)w; }
__device__ __forceinline__ bf16_t cvt1(float x) { return (bf16_t)(cvt_pk_bf16(x, x) & 0xffffu); }
__device__ __forceinline__ float sigmoidf_(float x) { return __builtin_amdgcn_rcpf(1.0f + __expf(-x)); }
template <int CTRL> __device__ __forceinline__ float dpp_f(float v) { return __builtin_bit_cast(float, __builtin_amdgcn_update_dpp(0, __builtin_bit_cast(int, v), CTRL, 0xF, 0xF, true)); }
__device__ __forceinline__ float wave_sum(float v) {
    v += dpp_f<0xB1>(v);
    v += dpp_f<0x4E>(v);
    v += dpp_f<0x141>(v);
    v += dpp_f<0x140>(v);
    const float a = __builtin_bit_cast(float, __builtin_amdgcn_readlane(__builtin_bit_cast(int, v), 0));
    const float b = __builtin_bit_cast(float, __builtin_amdgcn_readlane(__builtin_bit_cast(int, v), 16));
    const float c = __builtin_bit_cast(float, __builtin_amdgcn_readlane(__builtin_bit_cast(int, v), 32));
    const float d = __builtin_bit_cast(float, __builtin_amdgcn_readlane(__builtin_bit_cast(int, v), 48));
    return (a + b) + (c + d);
}
template <int CTRL, int RM> __device__ __forceinline__ float dpp_fm(float v) { return __builtin_bit_cast(float, __builtin_amdgcn_update_dpp(0, __builtin_bit_cast(int, v), CTRL, RM, 0xF, false)); }
__device__ __forceinline__ float wave_sum_bc(float v) {
    v += dpp_f<0xB1>(v); v += dpp_f<0x4E>(v); v += dpp_f<0x141>(v); v += dpp_f<0x140>(v);
    v += dpp_fm<0x142, 0xA>(v);
    v += dpp_fm<0x143, 0xC>(v);
    return __builtin_bit_cast(float, __builtin_amdgcn_readlane(__builtin_bit_cast(int, v), 63));
}
__device__ __forceinline__ int lds_add(LAS int* p) { return __hip_atomic_fetch_add(p, 1, __ATOMIC_RELAXED, __HIP_MEMORY_SCOPE_WORKGROUP); }
__device__ __forceinline__ float wave_sum_shfl(float v) {
#pragma unroll
    for (int o = 1; o < 64; o <<= 1) v += __shfl_xor(v, o);
    return v;
}

namespace pg8 {
constexpr int BM = 256, BK = 64, HALF = 128, HTB = HALF * BK * 2, STAGE_BYTES = 8 * HTB, NXCD = 8, WGM = 8;
__host__ __device__ __forceinline__ int lds_byte(int r, int c) { const int st = (r >> 4) * 2 + (c >> 5), rr = r & 15, cc = c & 31, ob = rr * 64 + cc * 2; return st * 1024 + (ob ^ (((ob >> 9) & 1) << 5)); }
__host__ __device__ __forceinline__ void stage_rc(int b, int& R, int& C) { const int st = b / 1024, sb = b % 1024, swz = sb ^ (((sb >> 9) & 1) << 5); R = (st >> 1) * 16 + swz / 64; C = (st & 1) * 32 + (swz % 64) / 2; }
__host__ __device__ __forceinline__ int perm32(int rho) { const int n = rho >> 4, i = rho & 15; return 8 * (i >> 2) + 4 * n + (i & 3); }

struct Unit { int pm, pn; };
struct Gemm { const bf16_t* A; const bf16_t* Bt; int lda, ldb, K; const int* rowtok; };

struct Order {
    int nM, nN, nwg, G, c; const int* tile_e; size_t bstride;
    int own = 0;
    __device__ void init(int nM_, int nN_, int G_, int c_, const int* te = nullptr, size_t bs = 0) { nM = nM_; nN = nN_; nwg = nM * nN; G = G_; c = c_; tile_e = te; bstride = bs; }
    __device__ bool next(int i, Unit& u) const {
        if (own) { if (i >= nN) return false; u.pm = c; u.pn = i; return true; }
        const long L = (long)i * G + c; if (L >= nwg) return false;
        int wgid = (int)L; { const int q = nwg / NXCD, r = nwg % NXCD, xcd = wgid % NXCD, off = wgid / NXCD; wgid = (xcd < r ? xcd * (q + 1) : r * (q + 1) + (xcd - r) * q) + off; }
        const int nig = WGM * nN, gid = wgid / nig, fm = gid * WGM, gsz = (nM - fm) < WGM ? (nM - fm) : WGM;
        u.pm = fm + ((wgid % nig) % gsz); u.pn = (wgid % nig) / gsz; return true;
    }
    __device__ __forceinline__ int expert(const Unit& u) const { return tile_e ? __builtin_amdgcn_readfirstlane(tile_e[u.pm]) : 0; }
};

typedef int v8i_t __attribute__((ext_vector_type(8)));
template <class Epi, bool GATHER, bool FP8 = false>
__device__ __forceinline__ void gemm_phase(LAS unsigned char* lds, const Gemm g, const Order& S, const Epi& E, int tid_in) {
    int tid = tid_in; asm volatile("" : "+v"(tid));
    const int wid = __builtin_amdgcn_readfirstlane(tid >> 6), lane = tid & 63, wr = wid >> 2, wc = wid & 3, fr = lane & 15, fq = lane >> 4;
    const int K = g.K, nt = K / BK;
    int Rst[2], Cst[2];
    unsigned voffB[2], vAc[2][2], vAn[2][2];
#pragma unroll
    for (int i = 0; i < 2; ++i) { int R, C; stage_rc(tid * 16 + i * 8192, R, C); Rst[i] = R; Cst[i] = C; const int Rb = Epi::PERM ? ((R & ~31) + perm32(R & 31)) : R;
        voffB[i] = (unsigned)(Rb * g.ldb + C) * 2u; }
    const size_t kstep = (size_t)(BK * 2);
    const size_t hstepB = (size_t)HALF * g.ldb * 2;
    const unsigned ldsw = (unsigned)wid * 1024u;
    const int aoff = lds_byte(wr * 64 + fr, fq * 8), boff = lds_byte(wc * 32 + fr, fq * 8);
    const int aoff1 = aoff + 1024, boff1 = boff + 1024;
#define PG8_SA(b, h) (((b) * 2 + (h)) * HTB)
#define PG8_SB(b, h) ((4 + (b) * 2 + (h)) * HTB)
#define PG8_STAGE(bufoff, gbase, voff) do { _Pragma("unroll") for (int _i = 0; _i < 2; ++_i) \
        __builtin_amdgcn_global_load_lds((const unsigned*)((const char*)(gbase) + (voff)[_i]), (LAS unsigned*)(lds + (bufoff) + ldsw + _i * 8192), 16, 0, 0); } while (0)
#define PG8_LD8(p0, p1) __builtin_bit_cast(v8i_t, __builtin_shufflevector(*(const LAS u32x4*)(p0), *(const LAS u32x4*)(p1), 0, 1, 2, 3, 4, 5, 6, 7))
#define PG8_LDA(dst, b, h) do { _Pragma("unroll") for (int m = 0; m < 4; ++m) { if (FP8) { dst##8[m] = PG8_LD8(lds + PG8_SA(b, h) + aoff + m * 2048, lds + PG8_SA(b, h) + aoff1 + m * 2048); } \
        else { _Pragma("unroll") for (int k = 0; k < 2; ++k) dst[m][k] = *(const LAS bf16x8*)(lds + PG8_SA(b, h) + aoff + m * 2048 + k * 1024); } } } while (0)
#define PG8_LDB(dst, b, h) do { _Pragma("unroll") for (int n = 0; n < 2; ++n) { if (FP8) { dst##8[n] = PG8_LD8(lds + PG8_SB(b, h) + boff + n * 2048, lds + PG8_SB(b, h) + boff1 + n * 2048); } \
        else { _Pragma("unroll") for (int k = 0; k < 2; ++k) dst[n][k] = *(const LAS bf16x8*)(lds + PG8_SB(b, h) + boff + n * 2048 + k * 1024); } } } while (0)
#define PG8_V8(x) __builtin_bit_cast(v8i_t, __builtin_shufflevector(__builtin_bit_cast(u32x4, x[0]), __builtin_bit_cast(u32x4, x[1]), 0, 1, 2, 3, 4, 5, 6, 7))
#define PG8_MMA(ai, bj, At, Bt) do { __builtin_amdgcn_s_setprio(1); _Pragma("unroll") for (int m = 0; m < 4; ++m) _Pragma("unroll") for (int n = 0; n < 2; ++n) { \
        if (FP8) asm volatile("v_mfma_scale_f32_16x16x128_f8f6f4 %0, %1, %2, %0, %3, %4 op_sel_hi:[0,0,0]" : "+v"(acc[ai][bj][m][n]) : "v"(Bt##8[n]), "v"(At##8[m]), "v"(scB), "v"(scA)); \
        else { _Pragma("unroll") for (int k = 0; k < 2; ++k) acc[ai][bj][m][n] = __builtin_amdgcn_mfma_f32_16x16x32_bf16(Bt[n][k], At[m][k], acc[ai][bj][m][n], 0, 0, 0); } } __builtin_amdgcn_s_setprio(0); } while (0)
#define PG8_WAIT_V(n) asm volatile("s_waitcnt vmcnt(" #n ")" ::: "memory")
#define PG8_WAIT_L(n) asm volatile("s_waitcnt lgkmcnt(" #n ")" ::: "memory")
#define PG8_BAR __builtin_amdgcn_s_barrier()
#define PG8_SCHED __builtin_amdgcn_sched_barrier(0)
#define PG8_AOFFS(dst, unit) do { int _t = tid; if (GATHER) asm volatile("" : "+v"(_t)); _Pragma("unroll") for (int _h = 0; _h < 2; ++_h) _Pragma("unroll") for (int _i = 0; _i < 2; ++_i) { \
        if (GATHER) { int _R, _C; stage_rc(_t * 16 + _i * 8192, _R, _C);        \
            const int _tok = g.rowtok[(unit).pm * BM + _h * HALF + _R]; dst[_h][_i] = (unsigned)(_tok * g.lda + _C) * 2u; } \
        else dst[_h][_i] = (unsigned)((_h * HALF + Rst[_i]) * g.lda + Cst[_i]) * 2u; } } while (0)
    Unit cur, nxt; int ui = 0;
    if (!S.next(0, cur)) return;
    f32x4 acc[2][2][4][2];
#pragma unroll
    for (int a = 0; a < 2; ++a)
#pragma unroll
        for (int b = 0; b < 2; ++b)
#pragma unroll
            for (int m = 0; m < 4; ++m)
#pragma unroll
                for (int n = 0; n < 2; ++n) acc[a][b][m][n] = (f32x4){0.f, 0.f, 0.f, 0.f};
    bf16x8 At[4][2], B0[2][2], B1[2][2];
    v8i_t At8[4], B08[2], B18[2];
    const int scB = 0x7a7a7a7a, scA = 0x7f7f7f7f;
    const size_t tstepA = GATHER ? 0 : (size_t)BM * g.lda * 2, tstepB = (size_t)BM * g.ldb * 2;
    const char* cA = (const char*)g.A + (size_t)cur.pm * tstepA;
    const char* cB = (const char*)g.Bt + ((size_t)S.expert(cur) * S.bstride) * 2 + (size_t)cur.pn * tstepB;
    PG8_AOFFS(vAc, cur);
    if (GATHER) { asm volatile("s_waitcnt vmcnt(0)" ::: "memory"); }
    PG8_STAGE(PG8_SB(0, 0), cB, voffB); PG8_STAGE(PG8_SB(0, 1), cB + hstepB, voffB); PG8_STAGE(PG8_SA(0, 0), cA, vAc[0]); PG8_STAGE(PG8_SA(0, 1), cA, vAc[1]);
    if (wr == 1) PG8_BAR;
    PG8_WAIT_V(2); PG8_BAR;
    PG8_STAGE(PG8_SB(1, 0), cB + kstep, voffB); PG8_STAGE(PG8_SA(1, 0), cA + kstep, vAc[0]); PG8_STAGE(PG8_SB(1, 1), cB + hstepB + kstep, voffB);
    PG8_WAIT_V(6); PG8_BAR;
    for (;;) {
        if constexpr (Epi::PRE && FP8) { if (wid == 0) E.pre_dma(lds + 131072 + (ui & 1) * 1024, cur, S.expert(cur), fq * 16 + fr); }
        const bool has_next = S.next(ui + 1, nxt);
        const char* nA = cA; const char* nB = cB;
        if (has_next) { nA = (const char*)g.A + (size_t)nxt.pm * tstepA; nB = (const char*)g.Bt + ((size_t)S.expert(nxt) * S.bstride) * 2 + (size_t)nxt.pn * tstepB; PG8_AOFFS(vAn, nxt); }
        else {
#pragma unroll
            for (int h = 0; h < 2; ++h)
#pragma unroll
                for (int i = 0; i < 2; ++i) vAn[h][i] = vAc[h][i];
        }
        if (GATHER) { asm volatile("" : "+v"(vAn[0][0]), "+v"(vAn[0][1]), "+v"(vAn[1][0]), "+v"(vAn[1][1])); }
#pragma nounroll
        for (int t = 0; t < nt; t += 2) {
            const bool last = (t == nt - 2);
            const char* a1 = cA + (size_t)(t + 1) * kstep;
            const char* a2 = last ? nA : cA + (size_t)(t + 2) * kstep; const char* b2 = last ? nB : cB + (size_t)(t + 2) * kstep;
            const char* a3 = a2 + kstep; const char* b3 = b2 + kstep;
            unsigned v2[2][2];
#pragma unroll
            for (int h = 0; h < 2; ++h)
#pragma unroll
                for (int i = 0; i < 2; ++i) v2[h][i] = (GATHER && last) ? vAn[h][i] : vAc[h][i];
            PG8_LDB(B0, 0, 0); PG8_LDB(B1, 0, 1); PG8_SCHED; PG8_LDA(At, 0, 0); PG8_STAGE(PG8_SA(1, 1), a1, vAc[1]);
            PG8_WAIT_V(8); PG8_WAIT_L(0); PG8_BAR; PG8_MMA(0, 0, At, B0); PG8_MMA(0, 1, At, B1); PG8_BAR; PG8_SCHED;
            PG8_LDA(At, 0, 1); PG8_STAGE(PG8_SB(0, 0), b2, voffB); PG8_STAGE(PG8_SB(0, 1), b2 + hstepB, voffB); PG8_STAGE(PG8_SA(0, 0), a2, v2[0]);
            PG8_WAIT_V(8); PG8_WAIT_L(0); PG8_BAR; PG8_MMA(1, 0, At, B0); PG8_MMA(1, 1, At, B1); PG8_BAR; PG8_SCHED;
            PG8_LDB(B0, 1, 0); PG8_LDB(B1, 1, 1); PG8_SCHED; PG8_LDA(At, 1, 0); PG8_STAGE(PG8_SA(0, 1), a2, v2[1]);
            PG8_WAIT_V(8); PG8_WAIT_L(0); PG8_BAR; PG8_MMA(0, 0, At, B0); PG8_MMA(0, 1, At, B1); PG8_BAR; PG8_SCHED;
            PG8_LDA(At, 1, 1); PG8_STAGE(PG8_SB(1, 0), b3, voffB); PG8_STAGE(PG8_SB(1, 1), b3 + hstepB, voffB); PG8_STAGE(PG8_SA(1, 0), a3, v2[0]);
            PG8_WAIT_V(8); PG8_WAIT_L(0); PG8_BAR; PG8_MMA(1, 0, At, B0); PG8_MMA(1, 1, At, B1); PG8_BAR; PG8_SCHED;
        }
        if (wr == 0) PG8_BAR;
        if (FP8) asm volatile("s_nop 15\n\ts_nop 15" ::: "memory");
        if constexpr (Epi::PRE && FP8) E(acc, cur, S.expert(cur), wr, wc, fr, fq, (const LAS float*)(lds + 131072 + (ui & 1) * 1024)); else E(acc, cur, S.expert(cur), wr, wc, fr, fq);
        if (!has_next) break;
#pragma unroll
        for (int a = 0; a < 2; ++a)
#pragma unroll
            for (int b = 0; b < 2; ++b)
#pragma unroll
                for (int m = 0; m < 4; ++m)
#pragma unroll
                    for (int n = 0; n < 2; ++n) acc[a][b][m][n] = (f32x4){0.f, 0.f, 0.f, 0.f};
        cur = nxt; cA = nA; cB = nB; ++ui;
#pragma unroll
        for (int h = 0; h < 2; ++h)
#pragma unroll
            for (int i = 0; i < 2; ++i) vAc[h][i] = vAn[h][i];
        if (wr == 1) PG8_BAR;
    }
    PG8_WAIT_V(0);
    PG8_BAR;
#undef PG8_SA
#undef PG8_SB
#undef PG8_STAGE
#undef PG8_LDA
#undef PG8_LDB
#undef PG8_MMA
#undef PG8_V8
#undef PG8_LD8
#undef PG8_WAIT_V
#undef PG8_WAIT_L
#undef PG8_BAR
#undef PG8_SCHED
#undef PG8_AOFFS
}

struct EpiBf16 {
    static constexpr bool PERM = true; static constexpr bool PRE = true;
    bf16_t* O; int ldc; const float* bias; int bias_estride; int nt;
    __device__ __forceinline__ void pre_dma(LAS unsigned char* dst, const Unit& u, int e, int lane) const {
        __builtin_amdgcn_global_load_lds((const unsigned*)(bias + (size_t)e * bias_estride + u.pn * BM + 4 * lane), (LAS unsigned*)dst, 16, 0, 0); }
    __device__ __forceinline__ void operator()(const f32x4 (&acc)[2][2][4][2], const Unit& u, int e, int wr, int wc, int fr, int fq, const LAS float* pb = nullptr) const {
        asm volatile("" : "+v"(fq), "+v"(fr));
        const int row0 = u.pm * BM + wr * 64 + fr, col0 = u.pn * BM + wc * 32 + 8 * fq;
        f32x4 bv[2][2];
#pragma unroll
        for (int bj = 0; bj < 2; ++bj)
#pragma unroll
            for (int n = 0; n < 2; ++n) bv[bj][n] = pb ? *(const LAS f32x4*)(pb + wc * 32 + 8 * fq + bj * HALF + 4 * n) : (bias ? *(const f32x4*)(bias + (size_t)e * bias_estride + col0 + bj * HALF + 4 * n) : (f32x4){0.f, 0.f, 0.f, 0.f});
#pragma unroll
        for (int ai = 0; ai < 2; ++ai)
#pragma unroll
            for (int m = 0; m < 4; ++m) { bf16_t* rowp = O + (size_t)(row0 + ai * HALF + m * 16) * ldc + col0;
#pragma unroll
                for (int bj = 0; bj < 2; ++bj) { const f32x4 v0 = acc[ai][bj][m][0] + bv[bj][0], v1 = acc[ai][bj][m][1] + bv[bj][1];
                    u32x4 w; w.x = cvt_pk_bf16(v0[0], v0[1]); w.y = cvt_pk_bf16(v0[2], v0[3]); w.z = cvt_pk_bf16(v1[0], v1[1]); w.w = cvt_pk_bf16(v1[2], v1[3]);
                    if (nt) __builtin_nontemporal_store(w, (u32x4*)(rowp + bj * HALF)); else *(u32x4*)(rowp + bj * HALF) = w; } }
    }
};
struct EpiResid {
    static constexpr bool PERM = false; static constexpr bool PRE = false;
    const float* R; float* X; const float* gate;
    __device__ __forceinline__ void operator()(const f32x4 (&acc)[2][2][4][2], const Unit& u, int, int wr, int wc, int fr, int fq) const {
        asm volatile("" : "+v"(fq), "+v"(fr));
        const int col0 = u.pn * BM + wc * 32 + 4 * fq; const int b = (u.pm * BM) / SEQ;
        f32x4 gv[2][2];
#pragma unroll
        for (int bj = 0; bj < 2; ++bj)
#pragma unroll
            for (int n = 0; n < 2; ++n) gv[bj][n] = *(const f32x4*)(gate + (size_t)b * 6144 + col0 + bj * HALF + n * 16);
#pragma unroll
        for (int ai = 0; ai < 2; ++ai)
#pragma unroll
            for (int m = 0; m < 4; ++m) { const size_t off = (size_t)(u.pm * BM + ai * HALF + wr * 64 + m * 16 + fr) * D + col0;
#pragma unroll
                for (int bj = 0; bj < 2; ++bj)
#pragma unroll
                    for (int n = 0; n < 2; ++n) { const f32x4 r = *(const f32x4*)(R + off + bj * HALF + n * 16); *(f32x4*)(X + off + bj * HALF + n * 16) = r + gv[bj][n] * acc[ai][bj][m][n]; } }
    }
};
struct EpiSwiglu {
    static constexpr bool PERM = true; static constexpr bool PRE = true;
    unsigned char* H; const float* bg; const float* bu;
    __device__ __forceinline__ void pre_dma(LAS unsigned char* dst, const Unit& u, int e, int lane) const {
        const float* src = (lane < 32 ? bg : bu) + (size_t)e * 1024 + u.pn * HALF + 4 * (lane & 31);
        __builtin_amdgcn_global_load_lds((const unsigned*)src, (LAS unsigned*)dst, 16, 0, 0); }
    __device__ __forceinline__ void operator()(const f32x4 (&acc)[2][2][4][2], const Unit& u, int e, int wr, int wc, int fr, int fq, const LAS float* pb) const {
        asm volatile("" : "+v"(fq), "+v"(fr));
        const int row0 = u.pm * BM + wr * 64 + fr, col0 = u.pn * HALF + wc * 32 + 8 * fq;
        const int cl = wc * 32 + 8 * fq;
        f32x4 g0 = *(const LAS f32x4*)(pb + cl), g1 = *(const LAS f32x4*)(pb + cl + 4);
        f32x4 u0 = *(const LAS f32x4*)(pb + 128 + cl), u1 = *(const LAS f32x4*)(pb + 128 + cl + 4);
#pragma unroll
        for (int ai = 0; ai < 2; ++ai)
#pragma unroll
            for (int m = 0; m < 4; ++m) {
                float o[8];
#pragma unroll
                for (int n = 0; n < 2; ++n)
#pragma unroll
                    for (int j = 0; j < 4; ++j) {
                        float gt = acc[ai][0][m][n][j] + (n ? g1[j] : g0[j]); gt = fminf(gt, 7.0f);
                        float up = acc[ai][1][m][n][j] + (n ? u1[j] : u0[j]); up = fminf(fmaxf(up, -7.0f), 7.0f);
                        o[n * 4 + j] = gt * sigmoidf_(1.702f * gt) * (up + 1.0f);
                    }
                u32x2 w; w.x = pk4_fp8(o[0], o[1], o[2], o[3]); w.y = pk4_fp8(o[4], o[5], o[6], o[7]);
                *(u32x2*)(H + (size_t)(row0 + ai * HALF + m * 16) * 1024 + col0) = w;
            }
    }
};
struct EpiS5C {
    static constexpr bool PERM = true; static constexpr bool PRE = false;
    bf16_t* YG; const bf16_t* PROJ; const float* dskip;
    __device__ __forceinline__ void operator()(const f32x4 (&acc)[2][2][4][2], const Unit& u, int, int wr, int wc, int fr, int fq) const {
        asm volatile("" : "+v"(fq), "+v"(fr));
        const int row0 = u.pm * BM + wr * 64 + fr, col0 = wc * 32 + 8 * fq;
#pragma unroll
        for (int ai = 0; ai < 2; ++ai)
#pragma unroll
            for (int m = 0; m < 4; ++m) { const size_t row = (size_t)(row0 + ai * HALF + m * 16);
#pragma unroll
                for (int bj = 0; bj < 2; ++bj) { const int c = col0 + bj * HALF;
                    const u32x4 uu = *(const u32x4*)(PROJ + row * INWP + C_S5 + c);
                    const f32x4 d0 = *(const f32x4*)(dskip + c), d1 = *(const f32x4*)(dskip + c + 4);
                    float y[8]; const unsigned uw[4] = {uu.x, uu.y, uu.z, uu.w};
#pragma unroll
                    for (int j = 0; j < 8; ++j) { const float uj = (j & 1) ? bfhi(uw[j >> 1]) : bflo(uw[j >> 1]); const float dj = j < 4 ? d0[j & 3] : d1[j & 3];
                        const float v = acc[ai][bj][m][j >> 2][j & 3] + dj * uj;
                        const float tt = 0.7978845608028654f * (v + 0.044715f * v * v * v);
                        const float th = 1.0f - 2.0f * __builtin_amdgcn_rcpf(1.0f + __expf(2.0f * tt));
                        y[j] = 0.5f * v * (1.0f + th); }
                    u32x4 w; w.x = cvt_pk_bf16(y[0], y[1]); w.y = cvt_pk_bf16(y[2], y[3]); w.z = cvt_pk_bf16(y[4], y[5]); w.w = cvt_pk_bf16(y[6], y[7]);
                    *(u32x4*)(YG + row * 256 + c) = w; asm volatile("" ::: "memory"); } }
    }
};
struct EpiS5E {
    static constexpr bool PERM = false; static constexpr bool PRE = false;
    float* EB;
    __device__ __forceinline__ void operator()(const f32x4 (&acc)[2][2][4][2], const Unit& u, int, int wr, int wc, int fr, int fq) const {
        asm volatile("" : "+v"(fq), "+v"(fr));
#pragma unroll
        for (int ai = 0; ai < 2; ++ai)
#pragma unroll
            for (int m = 0; m < 4; ++m) { float* rp = EB + (size_t)(u.pm * BM + ai * HALF + wr * 64 + m * 16 + fr) * 128 + wc * 32 + 4 * fq;
#pragma unroll
                for (int n = 0; n < 2; ++n) *(f32x4*)(rp + n * 16) = acc[ai][0][m][n]; }
    }
};
struct EpiS5Y {
    static constexpr bool PERM = true; static constexpr bool PRE = false;
    bf16_t* YG; const bf16_t* PROJ; const float* dskip;
    __device__ __forceinline__ void operator()(const f32x4 (&acc)[2][2][4][2], const Unit& u, int, int wr, int wc, int fr, int fq) const {
        asm volatile("" : "+v"(fq), "+v"(fr));
        const int g = u.pm >> 3;
#pragma unroll
        for (int ai = 0; ai < 2; ++ai)
#pragma unroll
            for (int m = 0; m < 4; ++m) { const int chunk = (u.pm & 7) * BM + ai * HALF + wr * 64 + m * 16 + fr;
#pragma unroll
                for (int bj = 0; bj < 2; ++bj) { const int col = u.pn * BM + bj * HALF + wc * 32 + 8 * fq, tau = col >> 4, c = g * 16 + (col & 15); const size_t tok = (size_t)chunk * 32 + tau;
                    const u32x4 uu = *(const u32x4*)(PROJ + tok * INWP + C_S5 + c);
                    const f32x4 d0 = *(const f32x4*)(dskip + c), d1 = *(const f32x4*)(dskip + c + 4);
                    float y[8]; const unsigned uw[4] = {uu.x, uu.y, uu.z, uu.w};
#pragma unroll
                    for (int j = 0; j < 8; ++j) { const float uj = (j & 1) ? bfhi(uw[j >> 1]) : bflo(uw[j >> 1]); const float dj = j < 4 ? d0[j & 3] : d1[j & 3];
                        const float v = acc[ai][bj][m][j >> 2][j & 3] + dj * uj;
                        const float tt = 0.7978845608028654f * (v + 0.044715f * v * v * v);
                        const float th = 1.0f - 2.0f * __builtin_amdgcn_rcpf(1.0f + __expf(2.0f * tt));
                        y[j] = 0.5f * v * (1.0f + th); }
                    u32x4 w; w.x = cvt_pk_bf16(y[0], y[1]); w.y = cvt_pk_bf16(y[2], y[3]); w.z = cvt_pk_bf16(y[4], y[5]); w.w = cvt_pk_bf16(y[6], y[7]);
                    *(u32x4*)(YG + tok * 256 + c) = w; asm volatile("" ::: "memory"); } }
    }
};
struct EpiGlu {
    static constexpr bool PERM = true; static constexpr bool PRE = false;
    bf16_t* MIX; const bf16_t* YG; const float* gb;
    __device__ __forceinline__ void operator()(const f32x4 (&acc)[2][2][4][2], const Unit& u, int, int wr, int wc, int fr, int fq) const {
        asm volatile("" : "+v"(fq), "+v"(fr));
        const int row0 = u.pm * BM + wr * 64 + fr, col0 = wc * 32 + 8 * fq;
#pragma unroll
        for (int ai = 0; ai < 2; ++ai)
#pragma unroll
            for (int m = 0; m < 4; ++m) { const size_t row = (size_t)(row0 + ai * HALF + m * 16);
#pragma unroll
                for (int bj = 0; bj < 2; ++bj) { const int c = col0 + bj * HALF;
                    const u32x4 yy = *(const u32x4*)(YG + row * 256 + c);
                    const f32x4 b0 = *(const f32x4*)(gb + c), b1 = *(const f32x4*)(gb + c + 4);
                    float o[8]; const unsigned yw[4] = {yy.x, yy.y, yy.z, yy.w};
#pragma unroll
                    for (int j = 0; j < 8; ++j) { const float yj = (j & 1) ? bfhi(yw[j >> 1]) : bflo(yw[j >> 1]); const float bj_ = j < 4 ? b0[j & 3] : b1[j & 3];
                        o[j] = yj * sigmoidf_(acc[ai][bj][m][j >> 2][j & 3] + bj_); }
                    u32x4 w; w.x = cvt_pk_bf16(o[0], o[1]); w.y = cvt_pk_bf16(o[2], o[3]); w.z = cvt_pk_bf16(o[4], o[5]); w.w = cvt_pk_bf16(o[6], o[7]);
                    *(u32x4*)(MIX + row * 1024 + c) = w; asm volatile("" ::: "memory"); } }
    }
};
}

#define XB_TMO      128
#define XB_XCNT(j)  (256  + 64 * (j))
#define XB_XSUB(j)  (1280 + 64 * (j))
#define XB_XGEN(j)  (2304 + 64 * (j))
#define XB_TOP      3328
#define XB_TOPGEN   3392
#define XCD_BAR_WORDS 3456
#define XB_SPIN_CAP (1u << 23)
__device__ __forceinline__ unsigned xb_ld(unsigned* p)              { return __hip_atomic_load(p, __ATOMIC_RELAXED, __HIP_MEMORY_SCOPE_AGENT); }
__device__ __forceinline__ unsigned xb_add(unsigned* p, unsigned v) { return __hip_atomic_fetch_add(p, v, __ATOMIC_RELAXED, __HIP_MEMORY_SCOPE_AGENT); }
__device__ __forceinline__ unsigned xb_xcc_id() { return (unsigned)__builtin_amdgcn_s_getreg((3 << 11) | 20) & 0xFu; }
#define XB_SPIN(cond, bar) do { unsigned _sp = 0; while (cond) { __builtin_amdgcn_s_sleep(1); \
    if ((++_sp & 255u) == 0u) { if (xb_ld(&(bar)[XB_TMO])) break; if (_sp > XB_SPIN_CAP) { atomicAdd(&(bar)[XB_TMO], 1u); break; } } } } while (0)
struct XcdBarrier { unsigned* bar; unsigned x; volatile LAS unsigned* st; };
__device__ __forceinline__ XcdBarrier xcd_barrier_post(unsigned* bar, volatile LAS unsigned* st) {
    XcdBarrier b; b.bar = bar; b.x = xb_xcc_id(); b.st = st;
    if (threadIdx.x == 0) (void)xb_add(&bar[XB_XCNT(b.x)], 1u);
    return b;
}
__device__ __forceinline__ void xcd_barrier_complete(unsigned* bar, unsigned x, unsigned& nloc, unsigned& nx) {
    const unsigned G = gridDim.x * gridDim.y * gridDim.z;
    unsigned sum, cnt, mine, sp = 0u;
    for (;;) {
        sum = 0u; cnt = 0u; mine = 0u;
#pragma unroll
        for (unsigned j = 0; j < 16; ++j) { const unsigned c = xb_ld(&bar[XB_XCNT(j)]); sum += c; cnt += (c > 0u) ? 1u : 0u; mine = (j == x) ? c : mine; }
        if (sum == G) break;
        __builtin_amdgcn_s_sleep(1);
        if ((++sp & 255u) == 0u) { if (xb_ld(&bar[XB_TMO])) break; if (sp > XB_SPIN_CAP) { atomicAdd(&bar[XB_TMO], 1u); break; } }
    }
    nloc = mine > 0u ? mine : 1u; nx = cnt > 0u ? cnt : 1u;
}
__device__ __forceinline__ void xcd_barrier(const XcdBarrier& b) {
    asm volatile("s_waitcnt vmcnt(0)" ::: "memory");
    __syncthreads();
    if (threadIdx.x == 0) {
        unsigned* bar = b.bar;
        __builtin_amdgcn_s_waitcnt(0);
        unsigned nloc = b.st[0], nx = b.st[1];
        if (nloc == 0u) { xcd_barrier_complete(bar, b.x, nloc, nx); b.st[0] = nloc; b.st[1] = nx; }
        const unsigned old = xb_add(&bar[XB_XSUB(b.x)], 1u);
        const unsigned gen = old / nloc;
        if (old + 1u == (gen + 1u) * nloc) {
            __builtin_amdgcn_fence(__ATOMIC_RELEASE, "agent");
            asm volatile("s_waitcnt vmcnt(0)" ::: "memory");
            const unsigned og = xb_add(&bar[XB_TOP], 1u);
            const unsigned tg = og / nx;
            if (og + 1u == (tg + 1u) * nx) xb_add(&bar[XB_TOPGEN], 1u);
            else XB_SPIN(xb_ld(&bar[XB_TOPGEN]) == tg, bar);
            __builtin_amdgcn_fence(__ATOMIC_ACQUIRE, "agent");
            xb_add(&bar[XB_XGEN(b.x)], 1u);
            asm volatile("s_waitcnt vmcnt(0)" ::: "memory");
        } else {
            XB_SPIN(xb_ld(&bar[XB_XGEN(b.x)]) == gen, bar);
            __builtin_amdgcn_fence(__ATOMIC_ACQUIRE, "agent");
            asm volatile("s_waitcnt vmcnt(0)" ::: "memory");
        }
    }
    __syncthreads();
}

struct Args { const void* in[46]; float* out; unsigned char* ws; int ph_lo, ph_hi; };
enum { I_X = 0, I_C, I_POS, I_ADAW, I_ADAB, I_NMG, I_NFG, I_WIN, I_WOUT, I_S5LR, I_S5LI, I_S5LS, I_S5BR, I_S5BI, I_S5CR, I_S5CI, I_S5D, I_S5GW, I_S5GB,
       I_RWMU, I_RWW0, I_RWW2, I_RWA0, I_RWA2, I_RWG2, I_RWKK, I_RWKA, I_RWRK, I_RWLG, I_RWLB, I_RWV0, I_RWV1, I_RWV2,
       I_MQG, I_MKVG, I_MWQ, I_MWKV, I_RTW, I_RTB, I_EWG, I_EBG, I_EWU, I_EBU, I_EWD, I_EBD, I_FNG };
#define FIN(k) ((const float*)a.in[k])
__constant__ float ROPE_INV[16] = {1.000000000e+00f, 5.623413324e-01f, 3.162277639e-01f, 1.778279394e-01f, 1.000000015e-01f, 5.623413250e-02f, 3.162277490e-02f, 1.778279431e-02f,
                                   9.999999776e-03f, 5.623413250e-03f, 3.162277630e-03f, 1.778279431e-03f, 1.000000047e-03f, 5.623413017e-04f, 3.162277571e-04f, 1.778279402e-04f};
#define LDS_BARRIER() asm volatile("s_waitcnt lgkmcnt(0)\n\ts_barrier" ::: "memory")
#define LDS_WAIT() asm volatile("s_waitcnt lgkmcnt(0)" ::: "memory")

__device__ __forceinline__ void transpose_item_fp8(const float* W, int N, unsigned char* WT, int ldo, int k0, int n0, int drow0, LAS float* scr, int lane) {
#pragma unroll 8
    for (int i = 0; i < 32; ++i) { const int kk = 2 * i + (lane >> 5); scr[kk * 33 + (lane & 31)] = W[(size_t)(k0 + kk) * N + n0 + (lane & 31)]; }
    LDS_WAIT();
    const int c = lane & 7;
#pragma unroll
    for (int j = 0; j < 4; ++j) { const int n = (lane >> 3) + 8 * j; const LAS float* sp = scr + (8 * c) * 33 + n;
        u32x2 o; o.x = pk4_fp8(sp[0 * 33] * 32.f, sp[1 * 33] * 32.f, sp[2 * 33] * 32.f, sp[3 * 33] * 32.f); o.y = pk4_fp8(sp[4 * 33] * 32.f, sp[5 * 33] * 32.f, sp[6 * 33] * 32.f, sp[7 * 33] * 32.f);
        *(u32x2*)(WT + (size_t)(drow0 + n) * ldo + k0 + 8 * c) = o; }
    LDS_WAIT();
}
__device__ __forceinline__ void s5_lambda_bar(const Args& a, int l, int g, int p, float& lbr, float& lbi, float& fre, float& fim) {
    const float dt = __expf(FIN(I_S5LS)[l * 16 + g]);
    const float lr = FIN(I_S5LR)[(l * 16 + g) * 64 + p], li = FIN(I_S5LI)[(l * 16 + g) * 64 + p];
    const float mag = __expf(lr * dt);
    const float ang = li * dt;
    double x = (double)ang * 0.15915494309189535; x -= __builtin_rint(x);
    const float fr = (float)x;
    lbr = mag * __builtin_amdgcn_cosf(fr); lbi = mag * __builtin_amdgcn_sinf(fr);
    const float den = lr * lr + li * li, nre = lbr - 1.0f;
    fre = (nre * lr + lbi * li) / den; fim = (lbi * lr - nre * li) / den;
}
__device__ __forceinline__ void phase_init(const Args& a, LAS unsigned char* lds, int tid, int G) {
    LAS float* sc = (LAS float*)lds;
    const float* c = FIN(I_C);
    for (int i = tid; i < 8192; i += NTHR) { const float v = c[i]; sc[i] = v / (1.0f + __expf(-v)); }
    __syncthreads();
    float* MOD = (float*)(a.ws + WS_MOD);
    {
        LAS float* red = (LAS float*)(lds + 65536);
        const bool wide = (G >= 256);
        int item0 = (int)blockIdx.x; if (wide) item0 = (int)blockIdx.x < 64 ? (int)blockIdx.x : ((int)blockIdx.x >= 128 ? (int)blockIdx.x - 64 : 1 << 20);
        for (int item = item0; item < 192; item += (wide ? (1 << 20) : G)) {
            const int l = item / 48, cl = tid & 127, kq = tid >> 7, col = (item % 48) * 128 + cl;
            float acc[8];
#pragma unroll
            for (int b = 0; b < 8; ++b) acc[b] = 0.f;
            const float* w = FIN(I_ADAW) + (size_t)l * 1024 * 6144 + col;
#pragma unroll 8
            for (int k = kq * 256; k < kq * 256 + 256; ++k) { const float wv = w[(size_t)k * 6144];
#pragma unroll
                for (int b = 0; b < 8; ++b) acc[b] += sc[b * 1024 + k] * wv; }
#pragma unroll
            for (int b = 0; b < 8; ++b) red[(kq * 8 + b) * 128 + cl] = acc[b];
            __syncthreads();
            if (kq == 0) {
                const float bias = FIN(I_ADAB)[l * 6144 + col];
#pragma unroll
                for (int b = 0; b < 8; ++b) MOD[(size_t)(l * 8 + b) * 6144 + col] = bias + ((red[b * 128 + cl] + red[(8 + b) * 128 + cl]) + (red[(16 + b) * 128 + cl] + red[(24 + b) * 128 + cl])); }
            __syncthreads();
        }
    }
    {
        float* KD = (float*)(a.ws + WS_KD); int* tab = (int*)(a.ws + WS_S5TAB);
        if (blockIdx.x == 0 && tid < 128) tab[tid] = tid >> 3;
        LAS float* PW = (LAS float*)(lds + 32768);
        LAS float* BBl = PW + 32 * 64 * 2;
        LAS float* CCl = BBl + 64 * 16 * 2;
        for (int lg = (G >= 128 ? (int)blockIdx.x - 64 : (int)blockIdx.x); lg >= 0 && lg < DEPTH * 16; lg += G) {
            const int l = lg >> 4, g = lg & 15;
            __syncthreads();
            for (int i = tid; i < 32 * 64; i += NTHR) { const int p = i & 63, d = i >> 6;
                const float dt = __expf(FIN(I_S5LS)[l * 16 + g]), lr = FIN(I_S5LR)[(l * 16 + g) * 64 + p], li = FIN(I_S5LI)[(l * 16 + g) * 64 + p];
                const float mag = __expf((float)d * lr * dt); double x = (double)((float)d * (li * dt)) * 0.15915494309189535; x -= __builtin_rint(x);
                PW[i * 2] = mag * __builtin_amdgcn_cosf((float)x); PW[i * 2 + 1] = mag * __builtin_amdgcn_sinf((float)x); }
            for (int i = tid; i < 64 * 16; i += NTHR) { const int hq = i & 15, p = i >> 4; float lbr, lbi, fre, fim; s5_lambda_bar(a, l, g, p, lbr, lbi, fre, fim);
                const float bre = FIN(I_S5BR)[(((size_t)l * 16 + g) * 64 + p) * 16 + hq], bim = FIN(I_S5BI)[(((size_t)l * 16 + g) * 64 + p) * 16 + hq];
                BBl[i * 2] = fre * bre - fim * bim; BBl[i * 2 + 1] = fre * bim + fim * bre;
                const int hp = i >> 6, pp = i & 63;
                CCl[i * 2] = FIN(I_S5CR)[(((size_t)l * 16 + g) * 16 + hp) * 64 + pp]; CCl[i * 2 + 1] = FIN(I_S5CI)[(((size_t)l * 16 + g) * 16 + hp) * 64 + pp]; }
            __syncthreads();
            for (int i = tid; i < 32 * 256; i += NTHR) { const int hk = i & 255, d = i >> 8, hp = hk >> 4, hq = hk & 15; float acc = 0.f;
                for (int p = 0; p < 64; ++p) { const float pr = PW[(d * 64 + p) * 2], pi_ = PW[(d * 64 + p) * 2 + 1], bbr = BBl[(p * 16 + hq) * 2], bbi = BBl[(p * 16 + hq) * 2 + 1];
                    const float cr = CCl[(hp * 64 + p) * 2], ci = CCl[(hp * 64 + p) * 2 + 1];
                    const float tr = pr * bbr - pi_ * bbi, ti = pr * bbi + pi_ * bbr; acc += cr * tr - ci * ti; }
                KD[((size_t)lg * 32 + d) * 256 + hk] = acc; }
        }
        __syncthreads();
    }
    float* rope = (float*)(a.ws + WS_ROPE);
    const int* pos = (const int*)a.in[I_POS];
    for (int idx = blockIdx.x * NTHR + tid; idx < T * 16; idx += G * NTHR) {
        const int t = idx >> 4, i = idx & 15;
        const float ang = (float)pos[t] * ROPE_INV[i];
        double x = (double)ang * 0.15915494309189535; x -= __builtin_rint(x);
        const float fr = (float)x;
        rope[(size_t)idx * 2] = __builtin_amdgcn_cosf(fr); rope[(size_t)idx * 2 + 1] = __builtin_amdgcn_sinf(fr);
    }
    __syncthreads();
}

__device__ __forceinline__ void transpose_item(const float* W, int N, bf16_t* WT, int ldo, int k0, int n0, int drow0, LAS float* scr, int lane) {
#pragma unroll 8
    for (int i = 0; i < 32; ++i) { const int kk = 2 * i + (lane >> 5); scr[kk * 33 + (lane & 31)] = W[(size_t)(k0 + kk) * N + n0 + (lane & 31)]; }
    LDS_WAIT();
    const int c = lane & 7;
#pragma unroll
    for (int j = 0; j < 4; ++j) { const int n = (lane >> 3) + 8 * j; const LAS float* s = scr + (8 * c) * 33 + n;
        u32x4 o; o.x = pk2(s[0 * 33], s[1 * 33]); o.y = pk2(s[2 * 33], s[3 * 33]); o.z = pk2(s[4 * 33], s[5 * 33]); o.w = pk2(s[6 * 33], s[7 * 33]);
        *(u32x4*)(WT + (size_t)(drow0 + n) * ldo + k0 + 8 * c) = o; }
    LDS_WAIT();
}
__device__ __forceinline__ void conv_expert_item(const Args& a, int l, int bi, LAS float* scr, int wave, int lane) {
    unsigned char* WGU = a.ws + WS_WGU; unsigned char* WDN = a.ws + WS_WDN;
    for (int k = 0; k < 12; ++k) {
        const int r = bi * 96 + k * 8 + wave;
        const int e = r / 1536, mm = (r % 1536) / 512, q = r % 512, kb = q / 32, nb = q % 32, n0 = 32 * nb;
        const size_t eoff = ((size_t)l * 32 + e) * 1024 * 1024;
        if (mm == 0) transpose_item_fp8(FIN(I_EWG) + eoff, 1024, WGU + (size_t)e * 2048 * 1024, 1024, 64 * kb, n0, (n0 >> 7) * 256 + (n0 & 127), scr, lane);
        else if (mm == 1) transpose_item_fp8(FIN(I_EWU) + eoff, 1024, WGU + (size_t)e * 2048 * 1024, 1024, 64 * kb, n0, (n0 >> 7) * 256 + 128 + (n0 & 127), scr, lane);
        else transpose_item_fp8(FIN(I_EWD) + eoff, 1024, WDN + (size_t)e * 1024 * 1024, 1024, 64 * kb, n0, n0, scr, lane);
    }
}
template <int PART> __device__ __forceinline__ void phase_conv(const Args& a, int l, LAS unsigned char* lds, int tid, int wave, int lane, int G) {
    LAS float* scr = (LAS float*)(lds + wave * 8704);
    const int gw = blockIdx.x * NWAVES + wave, NGW = G * NWAVES;
    bf16_t* WIN = (bf16_t*)(a.ws + WS_WIN); bf16_t* WOUT = (bf16_t*)(a.ws + WS_WOUT); bf16_t* WGU = (bf16_t*)(a.ws + WS_WGU); bf16_t* WDN = (bf16_t*)(a.ws + WS_WDN);
    constexpr int I_A = 16 * 77, I_Z = 96, I_O = 512, I_E = 32 * 1536;
    for (int it = (PART == 0 ? gw : gw + I_A + I_Z + I_O); it < (PART == 0 ? I_A + I_Z + I_O : I_A + I_Z + I_O + I_E); it += NGW) {
        int r = it;
        if (r < I_A) { const int kb = r / 77, nb = r % 77; transpose_item(FIN(I_WIN) + (size_t)l * 1024 * INW, INW, WIN, 1024, 64 * kb, 32 * nb, 32 * nb, scr, lane); continue; } r -= I_A;
        if (r < I_Z) { u32x4 z = zero4(); u32x4* d = (u32x4*)(WIN + (size_t)(INW + r) * 1024);
#pragma unroll
            for (int j = 0; j < 2; ++j) d[j * 64 + lane] = z; continue; } r -= I_Z;
        if (r < I_O) { const int kb = r / 32, nb = r % 32; transpose_item(FIN(I_WOUT) + (size_t)l * 1024 * 1024, 1024, WOUT, 1024, 64 * kb, 32 * nb, 32 * nb, scr, lane); continue; } r -= I_O;
        const int e = r / 1536, mm = (r % 1536) / 512, q = r % 512, kb = q / 32, nb = q % 32, n0 = 32 * nb;
        const size_t eoff = ((size_t)l * 32 + e) * 1024 * 1024;
        if (mm == 0) transpose_item(FIN(I_EWG) + eoff, 1024, WGU + (size_t)e * 2048 * 1024, 1024, 64 * kb, n0, (n0 >> 7) * 256 + (n0 & 127), scr, lane);
        else if (mm == 1) transpose_item(FIN(I_EWU) + eoff, 1024, WGU + (size_t)e * 2048 * 1024, 1024, 64 * kb, n0, (n0 >> 7) * 256 + 128 + (n0 & 127), scr, lane);
        else transpose_item(FIN(I_EWD) + eoff, 1024, WDN + (size_t)e * 1024 * 1024, 1024, 64 * kb, n0, n0, scr, lane);
    }
    if (PART == 1) return;
    bf16_t* SM = (bf16_t*)(a.ws + WS_WSM);
    const int gt = blockIdx.x * NTHR + tid, NGT = G * NTHR;
    for (int i = gt; i < 512 * 256; i += NGT) { const int n = i >> 8, k = i & 255;
        const float vq = n < 384 ? FIN(I_MQG)[l * 256 + k] * FIN(I_MWQ)[((size_t)l * 256 + k) * 384 + n] : 0.f;
        const float vk = k < 128 ? FIN(I_MKVG)[l * 128 + k] * FIN(I_MWKV)[((size_t)l * 128 + k) * 512 + n] : 0.f;
        SM[SM_WQ / 2 + i] = (bf16_t)f2bf(vq); SM[SM_WKV / 2 + i] = (bf16_t)f2bf(vk); }
    for (int i = gt; i < 768 * 256; i += NGT) { const int n = i >> 8, k = i & 255; float v = 0.f;
        if (n < 256) { if (k < 64) v = FIN(I_RWW2)[((size_t)l * 64 + k) * 256 + n]; }
        else if (n < 512) { if (k >= 64 && k < 128) v = FIN(I_RWA2)[((size_t)l * 64 + (k - 64)) * 256 + (n - 256)]; }
        else { if (k >= 128) v = FIN(I_RWG2)[((size_t)l * 128 + (k - 128)) * 256 + (n - 512)]; }
        SM[SM_WLORA / 2 + i] = (bf16_t)f2bf(v); }
    for (int i = gt; i < 256 * 256; i += NGT) { const int n = i >> 8, k = i & 255; float v = 0.f;
        if (l > 0) { const float* v1 = FIN(I_RWV1) + (size_t)(l - 1) * 256 * 32 + k * 32; const float* v2 = FIN(I_RWV2) + (size_t)(l - 1) * 32 * 256 + n;
#pragma unroll 8
            for (int m = 0; m < 32; ++m) v += v1[m] * v2[m * 256]; }
        SM[SM_WVV / 2 + i] = (bf16_t)f2bf(v);
        SM[SM_WGLU / 2 + i] = (bf16_t)f2bf(FIN(I_S5GW)[((size_t)l * 256 + k) * 256 + n]); }
    {
        bf16_t* WE = (bf16_t*)(a.ws + R_WE); bf16_t* WY = (bf16_t*)(a.ws + R_WY); const float* KD = (const float*)(a.ws + WS_KD) + (size_t)l * 16 * 32 * 256;
        for (int i0 = gt; i0 < 16 * 256 * 512; i0 += 4 * NGT) { float v4[4];
#pragma unroll
          for (int u = 0; u < 4; ++u) { const int i = i0 + u * NGT; const int k = i & 511, q = (i >> 9) & 255, g = i >> 17; float v = 0.f;
            if (q < 128 && i < 16 * 256 * 512) { const int p = q & 63, tau = k >> 4, h = k & 15; float lbr, lbi, fre, fim; s5_lambda_bar(a, l, g, p, lbr, lbi, fre, fim);
                const float bre = FIN(I_S5BR)[(((size_t)l * 16 + g) * 64 + p) * 16 + h], bim = FIN(I_S5BI)[(((size_t)l * 16 + g) * 64 + p) * 16 + h];
                const float bbr = fre * bre - fim * bim, bbi = fre * bim + fim * bre;
                const float dt = __expf(FIN(I_S5LS)[l * 16 + g]), lr = FIN(I_S5LR)[(l * 16 + g) * 64 + p], li = FIN(I_S5LI)[(l * 16 + g) * 64 + p]; const float d = (float)(31 - tau);
                const float mag = __expf(d * lr * dt); double x = (double)(d * (li * dt)) * 0.15915494309189535; x -= __builtin_rint(x);
                const float pr = mag * __builtin_amdgcn_cosf((float)x), pi_ = mag * __builtin_amdgcn_sinf((float)x);
                v = (q < 64) ? (pr * bbr - pi_ * bbi) : (pr * bbi + pi_ * bbr); }
            v4[u] = v; }
#pragma unroll
          for (int u = 0; u < 4; ++u) if (i0 + u * NGT < 16 * 256 * 512) WE[i0 + u * NGT] = (bf16_t)f2bf(v4[u]); }
        for (int i0 = gt; i0 < 16 * 512 * 768; i0 += 4 * NGT) { float v4[4];
#pragma unroll
          for (int u = 0; u < 4; ++u) { const int i = i0 + u * NGT; const int k = i % 768, n = (i / 768) & 511, g = i / (768 * 512), tau = n >> 4, hp = n & 15; float v = 0.f;
            if (i >= 16 * 512 * 768) { } else if (k < 512) { const int j = k >> 4, h = k & 15; if (j <= tau) v = KD[((g * 32 + (tau - j)) * 16 + hp) * 16 + h]; }
            else if (k < 640) { const int q = k - 512, p = q & 63;
                const float dt = __expf(FIN(I_S5LS)[l * 16 + g]), lr = FIN(I_S5LR)[(l * 16 + g) * 64 + p], li = FIN(I_S5LI)[(l * 16 + g) * 64 + p]; const float d = (float)(tau + 1);
                const float mag = __expf(d * lr * dt); double x = (double)(d * (li * dt)) * 0.15915494309189535; x -= __builtin_rint(x);
                const float pr = mag * __builtin_amdgcn_cosf((float)x), pi_ = mag * __builtin_amdgcn_sinf((float)x);
                const float cr = FIN(I_S5CR)[(((size_t)l * 16 + g) * 16 + hp) * 64 + p], ci = FIN(I_S5CI)[(((size_t)l * 16 + g) * 16 + hp) * 64 + p];
                v = (q < 64) ? (cr * pr - ci * pi_) : -(cr * pi_ + ci * pr); }
            v4[u] = v; }
#pragma unroll
          for (int u = 0; u < 4; ++u) if (i0 + u * NGT < 16 * 512 * 768) WY[i0 + u * NGT] = (bf16_t)f2bf(v4[u]); }
    }
}

template <int MODE>
__device__ __forceinline__ void phase_norm1(const Args& a, int l, int wave, int lane, int G) {
    const int gw = blockIdx.x * NWAVES + wave, NGW = G * NWAVES;
    const float* MOD = (const float*)(a.ws + WS_MOD);
    const int* pos = (const int*)(a.ws + MO_POS); const float* tw = (const float*)(a.ws + MO_W);
    const bf16_t* Y = (const bf16_t*)(a.ws + R_Y);
    bf16_t* HN = (bf16_t*)(a.ws + WS_HN);
#pragma unroll 2
    for (int m = gw; m < T; m += NGW) {
        const int b = m >> 13;
        const float* xr = (l == 0 ? FIN(I_X) : a.out) + (size_t)m * D;
        f32x4 v[4];
#pragma unroll
        for (int j = 0; j < 4; ++j) v[j] = ((const f32x4*)xr)[64 * j + lane];
        if (l > 0) {
            f32x4 acc[4];
#pragma unroll
            for (int j = 0; j < 4; ++j) acc[j] = (f32x4){0.f, 0.f, 0.f, 0.f};
#pragma unroll
            for (int k = 0; k < 4; ++k) { const int p = pos[m * 4 + k]; const float w = tw[m * 4 + k]; const u32x2* yr = (const u32x2*)(Y + (size_t)p * 1024);
#pragma unroll
                for (int j = 0; j < 4; ++j) { const u32x2 yy = __builtin_nontemporal_load(yr + 64 * j + lane); acc[j] += w * (f32x4){bflo(yy.x), bfhi(yy.x), bflo(yy.y), bfhi(yy.y)}; } }
            const float* g2 = MOD + (size_t)((l - 1) * 8 + b) * 6144 + 5120;
#pragma unroll
            for (int j = 0; j < 4; ++j) { v[j] += ((const f32x4*)g2)[64 * j + lane] * acc[j]; ((f32x4*)(a.out + (size_t)m * D))[64 * j + lane] = v[j]; }
        }
        float ss = 0.f;
#pragma unroll
        for (int j = 0; j < 4; ++j) ss += (v[j].x * v[j].x + v[j].y * v[j].y) + (v[j].z * v[j].z + v[j].w * v[j].w);
        ss = wave_sum(ss);
        const float rstd = __builtin_amdgcn_rsqf(ss * (1.0f / D) + NORM_EPS);
        if (MODE == 0) {
            const float* gn = FIN(I_NMG) + l * D; const float* sh = MOD + (size_t)(l * 8 + b) * 6144; const float* sc = sh + 1024;
            u32x2* o = (u32x2*)(HN + (size_t)m * D);
#pragma unroll
            for (int j = 0; j < 4; ++j) { const f32x4 g = ((const f32x4*)gn)[64 * j + lane], s1 = ((const f32x4*)sc)[64 * j + lane], s0 = ((const f32x4*)sh)[64 * j + lane];
                const f32x4 h = v[j] * rstd * g * (1.0f + s1) + s0; u32x2 w; w.x = pk2(h.x, h.y); w.y = pk2(h.z, h.w); o[64 * j + lane] = w; }
        } else {
            const float* gn = FIN(I_FNG);
#pragma unroll
            for (int j = 0; j < 4; ++j) { const f32x4 g = ((const f32x4*)gn)[64 * j + lane]; ((f32x4*)(a.out + (size_t)m * D))[64 * j + lane] = v[j] * rstd * g; }
        }
    }
}

__device__ __forceinline__ void phase_pre(const Args& a, int l, int tid, int G) {
    const bf16_t* PROJ = (const bf16_t*)(a.ws + R_PROJ); bf16_t* AP = (bf16_t*)(a.ws + R_AP);
    const float* mu = FIN(I_RWMU) + l * 1024;
    const int stride = G * NTHR;
    float muv[8];
    { const int ch0 = tid & 63, mi0 = ch0 < 32 ? (768 + ch0 * 8) : (512 + (ch0 - 32) * 8);
#pragma unroll
      for (int j = 0; j < 8; ++j) muv[j] = mu[mi0 + j]; }
    for (int idx0 = blockIdx.x * NTHR + tid; idx0 < T * 64; idx0 += 4 * stride) {
        u32x4 cu[4], pv[4];
#pragma unroll
        for (int u = 0; u < 4; ++u) { const int idx = idx0 + u * stride; cu[u] = zero4(); pv[u] = zero4();
            if (idx < T * 64) { const int t = idx >> 6, ch = idx & 63; const int pc = ch < 32 ? (C_RWWD + ch * 8) : (C_RWV + (ch - 32) * 8);
                cu[u] = *(const u32x4*)(PROJ + (size_t)t * INWP + pc); if ((t & (SEQ - 1)) != 0) pv[u] = *(const u32x4*)(PROJ + (size_t)(t - 1) * INWP + pc); } }
#pragma unroll
        for (int u = 0; u < 4; ++u) { const int idx = idx0 + u * stride; if (idx >= T * 64) break;
            const int t = idx >> 6, ch = idx & 63;
            const unsigned cw[4] = {cu[u].x, cu[u].y, cu[u].z, cu[u].w}, pw[4] = {pv[u].x, pv[u].y, pv[u].z, pv[u].w};
            float o[8];
#pragma unroll
            for (int j = 0; j < 8; ++j) { const float c = (j & 1) ? bfhi(cw[j >> 1]) : bflo(cw[j >> 1]), p = (j & 1) ? bfhi(pw[j >> 1]) : bflo(pw[j >> 1]);
                float x = c + (p - c) * muv[j];
                if (ch < 8) x = 1.0f - 2.0f * __builtin_amdgcn_rcpf(1.0f + __expf(2.0f * x)); else if (ch >= 16 && ch < 32) x = sigmoidf_(x);
                o[j] = x; }
            u32x4 w; w.x = pk2(o[0], o[1]); w.y = pk2(o[2], o[3]); w.z = pk2(o[4], o[5]); w.w = pk2(o[6], o[7]);
            *(u32x4*)(AP + (size_t)t * 512 + ch * 8) = w;
        }
    }
}

constexpr float QSCALE = 0.14724444602590306f;
__device__ __forceinline__ void mla_finish(const Args& a, LAS unsigned char* lds, int tid, int G) {
    const bf16_t* PROJ = (const bf16_t*)(a.ws + R_PROJ); const bf16_t* RAW = (const bf16_t*)(a.ws + R_QKV);
    bf16_t* QB = (bf16_t*)(a.ws + R_QB); unsigned char* KT = a.ws + R_KT; unsigned char* VT = a.ws + R_VT;
    const float* rope = (const float*)(a.ws + WS_ROPE);
    LAS float* rs = (LAS float*)lds;
    for (int tile = blockIdx.x; tile < T / 64; tile += G) {
        const int t0 = tile * 64, b = t0 >> 13, tidx = (t0 & (SEQ - 1)) >> 6;
        {
            const int tk = tid >> 3, part = tid & 7; const bf16_t* pr = PROJ + (size_t)(t0 + tk) * INWP;
            float sq = 0.f, sk = 0.f;
#pragma unroll
            for (int i = 0; i < 4; ++i) { const u32x4 w = *(const u32x4*)(pr + C_QC + part * 32 + i * 8); const unsigned ww[4] = {w.x, w.y, w.z, w.w};
#pragma unroll
                for (int j = 0; j < 4; ++j) { const float x0 = bflo(ww[j]), x1 = bfhi(ww[j]); sq += x0 * x0 + x1 * x1; } }
#pragma unroll
            for (int i = 0; i < 2; ++i) { const u32x4 w = *(const u32x4*)(pr + C_KVC + part * 16 + i * 8); const unsigned ww[4] = {w.x, w.y, w.z, w.w};
#pragma unroll
                for (int j = 0; j < 4; ++j) { const float x0 = bflo(ww[j]), x1 = bfhi(ww[j]); sk += x0 * x0 + x1 * x1; } }
            sq += __shfl_xor(sq, 1); sq += __shfl_xor(sq, 2); sq += __shfl_xor(sq, 4);
            sk += __shfl_xor(sk, 1); sk += __shfl_xor(sk, 2); sk += __shfl_xor(sk, 4);
            if (part == 0) { rs[tk * 2] = __builtin_amdgcn_rsqf(sq * (1.0f / 256.0f) + NORM_EPS); rs[tk * 2 + 1] = __builtin_amdgcn_rsqf(sk * (1.0f / 128.0f) + NORM_EPS); }
        }
        __syncthreads();
#pragma nounroll
        for (int c0 = 0; c0 < 6; c0 += 3) {
            asm volatile("" ::: "memory");
            u32x4 w_[3], wp_[3]; f32x4 rp_[3][4];
#pragma unroll
            for (int u = 0; u < 3; ++u) { const int ci = tid + (c0 + u) * NTHR; const int tk = ci / 48, rem = ci % 48, h = rem / 12, c = rem % 12; const size_t t = (size_t)t0 + tk;
                w_[u] = *(const u32x4*)(RAW + t * 1024 + h * 96 + c * 8); wp_[u] = zero4();
#pragma unroll
                for (int q = 0; q < 4; ++q) rp_[u][q] = (f32x4){0.f, 0.f, 0.f, 0.f};
                if (c >= 8) { const int cp = (c < 10) ? c + 2 : c - 2; wp_[u] = *(const u32x4*)(RAW + t * 1024 + h * 96 + cp * 8); const f32x4* rr = (const f32x4*)(rope + (t * 16 + ((c - 8) & 1) * 8) * 2);
#pragma unroll
                    for (int q = 0; q < 4; ++q) rp_[u][q] = rr[q]; } }
#pragma unroll
            for (int u = 0; u < 3; ++u) { const int ci = tid + (c0 + u) * NTHR; const int tk = ci / 48, rem = ci % 48, h = rem / 12, c = rem % 12; const size_t t = (size_t)t0 + tk;
                const float sc = rs[tk * 2] * QSCALE;
                const unsigned ww[4] = {w_[u].x, w_[u].y, w_[u].z, w_[u].w}, pp[4] = {wp_[u].x, wp_[u].y, wp_[u].z, wp_[u].w};
                float o[8];
#pragma unroll
                for (int j = 0; j < 8; ++j) { const float xo = (j & 1) ? bfhi(ww[j >> 1]) : bflo(ww[j >> 1]), xp = (j & 1) ? bfhi(pp[j >> 1]) : bflo(pp[j >> 1]);
                    const float cs = rp_[u][j >> 1][(j & 1) * 2], sn = rp_[u][j >> 1][(j & 1) * 2 + 1];
                    o[j] = (c < 8) ? xo * sc : ((c < 10) ? (xo * cs - xp * sn) : (xp * sn + xo * cs)) * sc; }
                u32x4 ow; ow.x = pk2(o[0], o[1]); ow.y = pk2(o[2], o[3]); ow.z = pk2(o[4], o[5]); ow.w = pk2(o[6], o[7]);
                *(u32x4*)(QB + t * 384 + h * 96 + c * 8) = ow; }
        }
#pragma nounroll
        for (int c0 = 0; c0 < 6; c0 += 3) {
            asm volatile("" ::: "memory");
            u32x4 w_[3], wp_[3]; f32x4 rp_[3][4];
#pragma unroll
            for (int u = 0; u < 3; ++u) { const int ci = tid + (c0 + u) * NTHR; const int h = ci / 768, rem = ci % 768, c = rem >> 6, key = rem & 63; const size_t t = (size_t)t0 + key;
                wp_[u] = zero4();
#pragma unroll
                for (int q = 0; q < 4; ++q) rp_[u][q] = (f32x4){0.f, 0.f, 0.f, 0.f};
                if (c < 8) w_[u] = *(const u32x4*)(RAW + t * 1024 + 512 + h * 128 + c * 8);
                else { const int cp = (c < 10) ? c + 2 : c - 2; w_[u] = *(const u32x4*)(PROJ + t * INWP + C_KPE + (c - 8) * 8); wp_[u] = *(const u32x4*)(PROJ + t * INWP + C_KPE + (cp - 8) * 8);
                    const f32x4* rr = (const f32x4*)(rope + (t * 16 + ((c - 8) & 1) * 8) * 2);
#pragma unroll
                    for (int q = 0; q < 4; ++q) rp_[u][q] = rr[q]; } }
#pragma unroll
            for (int u = 0; u < 3; ++u) { const int ci = tid + (c0 + u) * NTHR; const int h = ci / 768, rem = ci % 768, c = rem >> 6, key = rem & 63;
                const float sc = rs[key * 2 + 1];
                const unsigned ww[4] = {w_[u].x, w_[u].y, w_[u].z, w_[u].w}, pp[4] = {wp_[u].x, wp_[u].y, wp_[u].z, wp_[u].w};
                float o[8];
#pragma unroll
                for (int j = 0; j < 8; ++j) { const float xo = (j & 1) ? bfhi(ww[j >> 1]) : bflo(ww[j >> 1]), xp = (j & 1) ? bfhi(pp[j >> 1]) : bflo(pp[j >> 1]);
                    const float cs = rp_[u][j >> 1][(j & 1) * 2], sn = rp_[u][j >> 1][(j & 1) * 2 + 1];
                    o[j] = (c < 8) ? xo * sc : ((c < 10) ? (xo * cs - xp * sn) : (xp * sn + xo * cs)); }
                u32x4 ow; ow.x = pk2(o[0], o[1]); ow.y = pk2(o[2], o[3]); ow.z = pk2(o[4], o[5]); ow.w = pk2(o[6], o[7]);
                *(u32x4*)(KT + ((size_t)((b * 4 + h) * 128 + tidx)) * 12288 + (size_t)(c * 64 + key) * 16) = ow; }
        }
        {
            asm volatile("" ::: "memory");
            unsigned rv[4][8];
#pragma unroll
            for (int u = 0; u < 4; ++u) { const int ci = tid + u * NTHR; const int h = ci >> 9, rem = ci & 511, kh = rem >> 6, dv = rem & 63, ks = kh >> 1, hh = kh & 1;
#pragma unroll
                for (int j = 0; j < 8; ++j) { const int key = 16 * ks + 8 * (j >> 2) + 4 * hh + (j & 3); rv[u][j] = RAW[((size_t)t0 + key) * 1024 + 512 + h * 128 + 64 + dv]; } }
#pragma unroll
            for (int u = 0; u < 4; ++u) { const int ci = tid + u * NTHR; const int h = ci >> 9, rem = ci & 511, kh = rem >> 6, dv = rem & 63, ks = kh >> 1, hh = kh & 1;
                float o[8];
#pragma unroll
                for (int j = 0; j < 8; ++j) { const int key = 16 * ks + 8 * (j >> 2) + 4 * hh + (j & 3); o[j] = bf2f(rv[u][j]) * rs[key * 2 + 1]; }
                u32x4 ow; ow.x = pk2(o[0], o[1]); ow.y = pk2(o[2], o[3]); ow.z = pk2(o[4], o[5]); ow.w = pk2(o[6], o[7]);
                *(u32x4*)(VT + ((size_t)((b * 4 + h) * 128 + tidx)) * 8192 + (size_t)(kh * 64 + dv) * 16) = ow; }
        }
        __syncthreads();
    }
}
__device__ __forceinline__ void rwkv_finish(const Args& a, int l, int wave, int lane, int G) {
    const bf16_t* PROJ = (const bf16_t*)(a.ws + R_PROJ); const bf16_t* LO = (const bf16_t*)(a.ws + R_LO);
    float* SI = (float*)(a.ws + R_SI); float* VF = (float*)(a.ws + WS_VF);
    const float* mu = FIN(I_RWMU) + l * 1024;
    const int h = wave & 3, j = h * 64 + lane;
    const float mur = mu[j], muk = mu[256 + j], muv = mu[512 + j];
    const float w0 = FIN(I_RWW0)[l * 256 + j], a0 = FIN(I_RWA0)[l * 256 + j], kkp = FIN(I_RWKK)[l * 256 + j], kap = FIN(I_RWKA)[l * 256 + j];
    const float v0 = l > 0 ? FIN(I_RWV0)[(l - 1) * 256 + j] : 0.f;
#pragma unroll 4
    for (int tp = blockIdx.x; tp < T / 2; tp += G) {
        const size_t t = (size_t)tp * 2 + (wave >> 2); const bool first = (t & (SEQ - 1)) == 0;
        const bf16_t* pc = PROJ + t * INWP; const bf16_t* pp = pc - INWP;
        float r = bf2f(pc[C_RWR + j]), k = bf2f(pc[C_RWK + j]), v = bf2f(pc[C_RWV + j]);
        const float rp = first ? 0.f : bf2f(pp[C_RWR + j]), kp = first ? 0.f : bf2f(pp[C_RWK + j]), vp = first ? 0.f : bf2f(pp[C_RWV + j]);
        r += (rp - r) * mur; k += (kp - k) * muk; v += (vp - v) * muv;
        const float wl = w0 + bf2f(LO[t * 1024 + j]);
        const float sp = log1pf(__expf(-wl));
        const float wraw = -sp - 0.5f;
        const float decay = __expf(-__expf(wraw));
        const float aa = sigmoidf_(a0 + bf2f(LO[t * 1024 + 256 + j]));
        if (l > 0) { const float vf = VF[t * 256 + j]; v += (vf - v) * sigmoidf_(v0 + bf2f(LO[t * 1024 + 768 + j])); }
        else VF[t * 256 + j] = v;
        const float kk0 = k * kkp;
        const float nrm = sqrtf(wave_sum(kk0 * kk0));
        const float kk = kk0 / fmaxf(nrm, 1e-12f);
        const float k2 = k * (1.0f + (aa - 1.0f) * kap);
        float* o = SI + (t * 4 + h) * 384;
        o[lane] = r; o[64 + lane] = decay; o[128 + lane] = k2; o[192 + lane] = kk; o[256 + lane] = kk * aa; o[320 + lane] = v;
    }
}
struct S5State { float lbr, lbi; int cre, cim; };
__device__ __forceinline__ S5State s5_state(const Args& a, int l, int s) { S5State st; const int g = s >> 6, p = s & 63; float fre, fim; s5_lambda_bar(a, l, g, p, st.lbr, st.lbi, fre, fim); st.cre = g * 128 + p; st.cim = st.cre + 64; return st; }
__device__ __forceinline__ void s5_repack(const Args& a, int tid, int G) {
    const bf16_t* PROJ = (const bf16_t*)(a.ws + R_PROJ); bf16_t* UP = (bf16_t*)(a.ws + R_UP);
    for (int i = blockIdx.x * NTHR + tid; i < T * 32; i += G * NTHR) { const int p8 = i & 31, t = i >> 5, g = p8 >> 1, h0 = (p8 & 1) * 8;
        *(u32x4*)(UP + ((size_t)g * 2048 + (t >> 5)) * 768 + (t & 31) * 16 + h0) = *(const u32x4*)(PROJ + (size_t)t * INWP + C_S5 + p8 * 8); }
    for (int i = blockIdx.x * NTHR + tid; i < 16 * 2048 * 16; i += G * NTHR) { const int r = i >> 4, c8 = i & 15; *(u32x4*)(UP + (size_t)r * 768 + 640 + c8 * 8) = zero4(); }
}
__device__ __forceinline__ void s5_chunk_scan(const Args& a, int l, int tid, int G) {
    bf16_t* UP = (bf16_t*)(a.ws + R_UP); const float* EB = (const float*)(a.ws + R_EB);
    if (tid < 64)
    for (int i = blockIdx.x * 64 + tid; i < NB * 16 * 64; i += G * 64) { const int p = i & 63, g = (i >> 6) & 15, b = i >> 10;
        float lbr, lbi, fre, fim; s5_lambda_bar(a, l, g, p, lbr, lbi, fre, fim);
        float pr = lbr, pi_ = lbi;
#pragma unroll
        for (int k = 0; k < 5; ++k) { const float tr = pr * pr - pi_ * pi_, ti = 2.f * pr * pi_; pr = tr; pi_ = ti; }
        float sr = 0.f, si = 0.f;
        for (int c0 = 0; c0 < 256; c0 += 32) { float er[32], ei[32];
#pragma unroll
            for (int c = 0; c < 32; ++c) { const size_t row = (size_t)g * 2048 + b * 256 + c0 + c; er[c] = EB[row * 128 + p]; ei[c] = EB[row * 128 + 64 + p]; }
#pragma unroll
            for (int c = 0; c < 32; ++c) { const size_t row = (size_t)g * 2048 + b * 256 + c0 + c;
                UP[row * 768 + 512 + p] = (bf16_t)f2bf(sr); UP[row * 768 + 576 + p] = (bf16_t)f2bf(si);
                const float nr = pr * sr - pi_ * si + er[c], ni = pr * si + pi_ * sr + ei[c]; sr = nr; si = ni; }
        }
    }
}
__device__ __forceinline__ void s5_pass_a(const Args& a, int l, int tid, int G) {
    const bf16_t* BU = (const bf16_t*)(a.ws + R_BU); float* E = (float*)(a.ws + R_E);
    const S5State s0 = s5_state(a, l, tid), s1 = s5_state(a, l, tid + 512);
    for (int u = blockIdx.x; u < NB * 64; u += G) {
        const size_t t0 = (size_t)(u >> 6) * SEQ + (size_t)(u & 63) * 128;
        float ar = 0.f, ai = 0.f, br = 0.f, bi = 0.f;
#pragma unroll 4
        for (int tk = 0; tk < 128; ++tk) { const bf16_t* row = BU + (t0 + tk) * 2048;
            const float x0 = bf2f(row[s0.cre]), y0 = bf2f(row[s0.cim]), x1 = bf2f(row[s1.cre]), y1 = bf2f(row[s1.cim]);
            const float nar = s0.lbr * ar - s0.lbi * ai + x0, nai = s0.lbr * ai + s0.lbi * ar + y0; ar = nar; ai = nai;
            const float nbr = s1.lbr * br - s1.lbi * bi + x1, nbi = s1.lbr * bi + s1.lbi * br + y1; br = nbr; bi = nbi; }
        float* e = E + (size_t)u * 2048;
        e[tid * 2] = ar; e[tid * 2 + 1] = ai; e[(tid + 512) * 2] = br; e[(tid + 512) * 2 + 1] = bi;
    }
}
__device__ __forceinline__ void s5_pass_c(const Args& a, int l, int tid, int G) {
    bf16_t* BU = (bf16_t*)(a.ws + R_BU); const float* E = (const float*)(a.ws + R_E);
    const S5State s0 = s5_state(a, l, tid), s1 = s5_state(a, l, tid + 512);
    float p0r = s0.lbr, p0i = s0.lbi, p1r = s1.lbr, p1i = s1.lbi;
#pragma unroll
    for (int i = 0; i < 7; ++i) { const float t0r = p0r * p0r - p0i * p0i, t0i = 2.f * p0r * p0i; p0r = t0r; p0i = t0i; const float t1r = p1r * p1r - p1i * p1i, t1i = 2.f * p1r * p1i; p1r = t1r; p1i = t1i; }
    for (int u = blockIdx.x; u < NB * 64; u += G) {
        const int b = u >> 6, c = u & 63; const size_t t0 = (size_t)b * SEQ + (size_t)c * 128;
        float ar = 0.f, ai = 0.f, br = 0.f, bi = 0.f;
        for (int cc = 0; cc < c; ++cc) { const float* e = E + (size_t)(b * 64 + cc) * 2048;
            const float e0r = e[tid * 2], e0i = e[tid * 2 + 1], e1r = e[(tid + 512) * 2], e1i = e[(tid + 512) * 2 + 1];
            const float nar = p0r * ar - p0i * ai + e0r, nai = p0r * ai + p0i * ar + e0i; ar = nar; ai = nai;
            const float nbr = p1r * br - p1i * bi + e1r, nbi = p1r * bi + p1i * br + e1i; br = nbr; bi = nbi; }
#pragma unroll 4
        for (int tk = 0; tk < 128; ++tk) { bf16_t* row = BU + (t0 + tk) * 2048;
            const float x0 = bf2f(row[s0.cre]), y0 = bf2f(row[s0.cim]), x1 = bf2f(row[s1.cre]), y1 = bf2f(row[s1.cim]);
            const float nar = s0.lbr * ar - s0.lbi * ai + x0, nai = s0.lbr * ai + s0.lbi * ar + y0; ar = nar; ai = nai;
            const float nbr = s1.lbr * br - s1.lbi * bi + x1, nbi = s1.lbr * bi + s1.lbi * br + y1; br = nbr; bi = nbi;
            row[s0.cre] = (bf16_t)f2bf(ar); row[s0.cim] = (bf16_t)f2bf(ai); row[s1.cre] = (bf16_t)f2bf(br); row[s1.cim] = (bf16_t)f2bf(bi); }
    }
}
__device__ __forceinline__ float ret_rope(const bf16_t* PROJ, const float* rope, size_t t, int colbase, int h, int d) {
    const bf16_t* p = PROJ + t * INWP + colbase + h * 32; const int i = d & 15;
    const float x1 = bf2f(p[i]), x2 = bf2f(p[i + 16]); const float cs = rope[(t * 16 + i) * 2], sn = rope[(t * 16 + i) * 2 + 1];
    return d < 16 ? (x1 * cs - x2 * sn) : (x1 * sn + x2 * cs);
}
__device__ __forceinline__ void ret_rope8(const bf16_t* PROJ, const float* rope, size_t t, int colbase, int h, int ch, float (&o)[8]) {
    const bf16_t* p = PROJ + t * INWP + colbase + h * 32;
    const u32x4 wo = *(const u32x4*)(p + 8 * ch), wp = *(const u32x4*)(p + 8 * (ch ^ 2));
    const unsigned ow[4] = {wo.x, wo.y, wo.z, wo.w}, pw[4] = {wp.x, wp.y, wp.z, wp.w};
    const f32x4* cs = (const f32x4*)(rope + (t * 16 + (ch & 1) * 8) * 2);
    const f32x4 c0 = cs[0], c1 = cs[1], c2 = cs[2], c3 = cs[3];
    const float cc[8] = {c0.x, c0.z, c1.x, c1.z, c2.x, c2.z, c3.x, c3.z}, sn[8] = {c0.y, c0.w, c1.y, c1.w, c2.y, c2.w, c3.y, c3.w};
#pragma unroll
    for (int j = 0; j < 8; ++j) { const float xo = (j & 1) ? bfhi(ow[j >> 1]) : bflo(ow[j >> 1]), xp = (j & 1) ? bfhi(pw[j >> 1]) : bflo(pw[j >> 1]);
        o[j] = (ch < 2) ? (xo * cc[j] - xp * sn[j]) : (xp * sn[j] + xo * cc[j]); }
}
__device__ __forceinline__ void ret_stage_vt(const bf16_t* PROJ, LAS bf16_t* VT, size_t t0, int h, int tid) {
    const int m = tid >> 2, eg = tid & 3, ks = m >> 4, w = m & 15, hh = (w >> 2) & 1, j = 4 * (w >> 3) + (w & 3);
    const u32x4 v0 = *(const u32x4*)(PROJ + (t0 + m) * INWP + C_RV + h * 64 + eg * 16), v1 = *(const u32x4*)(PROJ + (t0 + m) * INWP + C_RV + h * 64 + eg * 16 + 8);
    const unsigned vw[8] = {v0.x, v0.y, v0.z, v0.w, v1.x, v1.y, v1.z, v1.w};
    LAS bf16_t* d = VT + ((ks * 2 + hh) * 64 + eg * 16) * 8 + j;
#pragma unroll
    for (int i = 0; i < 16; ++i) d[i * 8] = (bf16_t)((i & 1) ? (vw[i >> 1] >> 16) : (vw[i >> 1] & 0xffffu));
}
__device__ __forceinline__ void ret_pass_a(const Args& a, LAS unsigned char* lds, int tid, int wave, int lane, int G) {
    const bf16_t* PROJ = (const bf16_t*)(a.ws + R_PROJ); const float* rope = (const float*)(a.ws + WS_ROPE); float* CKV = (float*)(a.ws + R_CKV);
    LAS bf16_t* VT = (LAS bf16_t*)lds; LAS bf16_t* KW = (LAS bf16_t*)(lds + 16384);
    const int hh = lane >> 5, l31 = lane & 31;
    for (int u = blockIdx.x; u < NB * 64 * 4; u += G) {
        const int h = u & 3, n = (u >> 2) & 63, b = u >> 8; const size_t t0 = (size_t)b * SEQ + (size_t)n * 128;
        const float lg2 = log2f(1.0f - exp2f(-5.0f - (float)h));
        ret_stage_vt(PROJ, VT, t0, h, tid);
        {
            const int d = tid & 31, kh = tid >> 5, ks = kh >> 1, khh = kh & 1, i = d & 15; float o[8];
#pragma unroll
            for (int j = 0; j < 8; ++j) { const int m = 16 * ks + 8 * (j >> 2) + 4 * khh + (j & 3); const size_t t = t0 + m;
                const bf16_t* p = PROJ + t * INWP + C_RK + h * 32; const float x1 = bf2f(p[i]), x2 = bf2f(p[i + 16]);
                const float cs = rope[(t * 16 + i) * 2], sn = rope[(t * 16 + i) * 2 + 1];
                o[j] = (d < 16 ? (x1 * cs - x2 * sn) : (x1 * sn + x2 * cs)) * 0.17677669529663687f * exp2f((float)(127 - m) * lg2); }
            u32x4 w; w.x = pk2(o[0], o[1]); w.y = pk2(o[2], o[3]); w.z = pk2(o[4], o[5]); w.w = pk2(o[6], o[7]);
            *(LAS u32x4*)(KW + (kh * 32 + d) * 8) = w;
        }
        __syncthreads();
        if (wave < 2) {
            f32x16 acc;
#pragma unroll
            for (int r = 0; r < 16; ++r) acc[r] = 0.f;
#pragma unroll
            for (int ks = 0; ks < 8; ++ks) {
                const bf16x8 va = *(const LAS bf16x8*)(VT + ((ks * 2 + hh) * 64 + 32 * wave + l31) * 8);
                const bf16x8 kb = *(const LAS bf16x8*)(KW + ((ks * 2 + hh) * 32 + l31) * 8);
                acc = __builtin_amdgcn_mfma_f32_32x32x16_bf16(va, kb, acc, 0, 0, 0);
            }
            float* o = CKV + (size_t)u * 2048;
#pragma unroll
            for (int r = 0; r < 16; ++r) { const int e = 32 * wave + (r & 3) + 8 * (r >> 2) + 4 * hh; o[e * 32 + l31] = acc[r]; }
        }
        __syncthreads();
    }
}
__device__ __forceinline__ void ret_pass_c(const Args& a, LAS unsigned char* lds, int tid, int wave, int lane, int G) {
    const bf16_t* PROJ = (const bf16_t*)(a.ws + R_PROJ); const float* rope = (const float*)(a.ws + WS_ROPE); const float* CKV = (const float*)(a.ws + R_CKV);
    bf16_t* MIX = (bf16_t*)(a.ws + R_MIX);
    LAS bf16_t* VT = (LAS bf16_t*)lds; LAS bf16_t* QS = (LAS bf16_t*)(lds + 16384); LAS bf16_t* KS = (LAS bf16_t*)(lds + 24576); LAS bf16_t* RT = (LAS bf16_t*)(lds + 32768);
    LAS float* SSQ = (LAS float*)(lds + 36864);
    const int hh = lane >> 5, l31 = lane & 31, cb = wave & 3, eb = wave >> 2;
    const int vm = tid >> 2, veg = tid & 3;
    const int row = tid & 127, ch = tid >> 7;
    const int re = tid >> 3, rd0 = (tid & 7) * 4;
    for (int su = blockIdx.x; su < NB * 4 * 8; su += G) {
        const int bh = su >> 3, h = bh & 3, b = bh >> 2, n0 = (su & 7) * 8;
        const float gam = 1.0f - exp2f(-5.0f - (float)h), lg2 = log2f(gam), cd = exp2f(128.0f * lg2);
        const float* ck = CKV + ((size_t)((b * 64) * 4 + h)) * 2048 + re * 32 + rd0;
        f32x4 Rc = (f32x4){0.f, 0.f, 0.f, 0.f};
        for (int nn = 0; nn + 1 < n0; nn += 8) { f32x4 c8[8];
#pragma unroll
            for (int i = 0; i < 8; ++i) c8[i] = (nn + i < n0 - 1) ? *(const f32x4*)(ck + (size_t)(nn + i) * 4 * 2048) : (f32x4){0.f, 0.f, 0.f, 0.f};
#pragma unroll
            for (int i = 0; i < 8; ++i) if (nn + i < n0 - 1) Rc = Rc * cd + c8[i]; }
        u32x4 sv0, sv1, sqo, sqp, sko, skp; f32x4 sc0, sc1, sc2, sc3, sck;
#define RC_LOAD(n_) do { const size_t t0_ = (size_t)b * SEQ + (size_t)(n_) * 128; \
            const bf16_t* pv_ = PROJ + (t0_ + vm) * INWP + C_RV + h * 64 + veg * 16; sv0 = *(const u32x4*)pv_; sv1 = *(const u32x4*)(pv_ + 8); \
            const bf16_t* pq_ = PROJ + (t0_ + row) * INWP + C_RQ + h * 32; sqo = *(const u32x4*)(pq_ + 8 * ch); sqp = *(const u32x4*)(pq_ + 8 * (ch ^ 2)); \
            const bf16_t* pk_ = PROJ + (t0_ + row) * INWP + C_RK + h * 32; sko = *(const u32x4*)(pk_ + 8 * ch); skp = *(const u32x4*)(pk_ + 8 * (ch ^ 2)); \
            const f32x4* cs_ = (const f32x4*)(rope + ((t0_ + row) * 16 + (ch & 1) * 8) * 2); sc0 = cs_[0]; sc1 = cs_[1]; sc2 = cs_[2]; sc3 = cs_[3]; \
            sck = (n_) > 0 ? *(const f32x4*)(ck + (size_t)((n_) - 1) * 4 * 2048) : (f32x4){0.f, 0.f, 0.f, 0.f}; } while (0)
        RC_LOAD(n0);
        for (int kq = 0; kq < 8; ++kq) {
            const int n = n0 + kq; const size_t t0 = (size_t)b * SEQ + (size_t)n * 128;
            {
                const int ks = vm >> 4, w = vm & 15, vh = (w >> 2) & 1, j = 4 * (w >> 3) + (w & 3);
                const unsigned vw[8] = {sv0.x, sv0.y, sv0.z, sv0.w, sv1.x, sv1.y, sv1.z, sv1.w};
                LAS bf16_t* d = VT + ((ks * 2 + vh) * 64 + veg * 16) * 8 + j;
#pragma unroll
                for (int i = 0; i < 16; ++i) d[i * 8] = (bf16_t)((i & 1) ? (vw[i >> 1] >> 16) : (vw[i >> 1] & 0xffffu));
            }
            {
                const float cc[8] = {sc0.x, sc0.z, sc1.x, sc1.z, sc2.x, sc2.z, sc3.x, sc3.z}, sn[8] = {sc0.y, sc0.w, sc1.y, sc1.w, sc2.y, sc2.w, sc3.y, sc3.w};
                const unsigned qo[4] = {sqo.x, sqo.y, sqo.z, sqo.w}, qp[4] = {sqp.x, sqp.y, sqp.z, sqp.w}, ko[4] = {sko.x, sko.y, sko.z, sko.w}, kp[4] = {skp.x, skp.y, skp.z, skp.w};
                float oq[8], ok[8];
#pragma unroll
                for (int j = 0; j < 8; ++j) { const float xo = (j & 1) ? bfhi(qo[j >> 1]) : bflo(qo[j >> 1]), xp = (j & 1) ? bfhi(qp[j >> 1]) : bflo(qp[j >> 1]);
                    oq[j] = (ch < 2) ? (xo * cc[j] - xp * sn[j]) : (xp * sn[j] + xo * cc[j]);
                    const float yo = (j & 1) ? bfhi(ko[j >> 1]) : bflo(ko[j >> 1]), yp = (j & 1) ? bfhi(kp[j >> 1]) : bflo(kp[j >> 1]);
                    ok[j] = (ch < 2) ? (yo * cc[j] - yp * sn[j]) : (yp * sn[j] + yo * cc[j]); }
                const float qs = exp2f((float)row * lg2);
                u32x4 w; w.x = pk2(oq[0] * qs, oq[1] * qs); w.y = pk2(oq[2] * qs, oq[3] * qs); w.z = pk2(oq[4] * qs, oq[5] * qs); w.w = pk2(oq[6] * qs, oq[7] * qs);
                *(LAS u32x4*)(QS + (ch * 128 + row) * 8) = w;
                const float ks_ = 0.17677669529663687f * exp2f(-(float)row * lg2);
                w.x = pk2(ok[0] * ks_, ok[1] * ks_); w.y = pk2(ok[2] * ks_, ok[3] * ks_); w.z = pk2(ok[4] * ks_, ok[5] * ks_); w.w = pk2(ok[6] * ks_, ok[7] * ks_);
                *(LAS u32x4*)(KS + (ch * 128 + row) * 8) = w;
            }
            {
                if (n > 0) Rc = Rc * cd + sck;
                const f32x4 R = Rc;
                u32x2 w; w.x = pk2(R.x * gam, R.y * gam); w.y = pk2(R.z * gam, R.w * gam);
                *(LAS u32x2*)(RT + ((rd0 >> 3) * 64 + re) * 8 + (rd0 & 7)) = w;
            }
            LDS_BARRIER();
            if (kq < 7) RC_LOAD(n + 1);
            const size_t t = t0 + 32 * cb + l31;
            u32x2 gwv[4];
#pragma unroll
            for (int g = 0; g < 4; ++g) gwv[g] = *(const u32x2*)(PROJ + t * INWP + C_RG + h * 64 + 32 * eb + 8 * g + 4 * hh);
            f32x16 o;
#pragma unroll
            for (int r = 0; r < 16; ++r) o[r] = 0.f;
            bf16x8 qf[2];
#pragma unroll
            for (int s2 = 0; s2 < 2; ++s2) qf[s2] = *(const LAS bf16x8*)(QS + ((2 * s2 + hh) * 128 + 32 * cb + l31) * 8);
#pragma unroll
            for (int s2 = 0; s2 < 2; ++s2) { const bf16x8 ra = *(const LAS bf16x8*)(RT + ((2 * s2 + hh) * 64 + 32 * eb + l31) * 8); o = __builtin_amdgcn_mfma_f32_32x32x16_bf16(ra, qf[s2], o, 0, 0, 0); }
            for (int mb = 0; mb <= cb; ++mb) {
                f32x16 sc;
#pragma unroll
                for (int r = 0; r < 16; ++r) sc[r] = 0.f;
#pragma unroll
                for (int s2 = 0; s2 < 2; ++s2) { const bf16x8 ka = *(const LAS bf16x8*)(KS + ((2 * s2 + hh) * 128 + 32 * mb + l31) * 8); sc = __builtin_amdgcn_mfma_f32_32x32x16_bf16(ka, qf[s2], sc, 0, 0, 0); }
                if (mb == cb) {
#pragma unroll
                    for (int r = 0; r < 16; ++r) if ((r & 3) + 8 * (r >> 2) + 4 * hh > l31) sc[r] = 0.f;
                }
#pragma unroll
                for (int sb = 0; sb < 2; ++sb) { u32x4 w; w.x = cvt_pk_bf16(sc[8 * sb], sc[8 * sb + 1]); w.y = cvt_pk_bf16(sc[8 * sb + 2], sc[8 * sb + 3]); w.z = cvt_pk_bf16(sc[8 * sb + 4], sc[8 * sb + 5]); w.w = cvt_pk_bf16(sc[8 * sb + 6], sc[8 * sb + 7]);
                    const bf16x8 pb = __builtin_bit_cast(bf16x8, w);
                    const bf16x8 va = *(const LAS bf16x8*)(VT + (((2 * mb + sb) * 2 + hh) * 64 + 32 * eb + l31) * 8);
                    o = __builtin_amdgcn_mfma_f32_32x32x16_bf16(va, pb, o, 0, 0, 0); }
            }
            float ss = 0.f;
#pragma unroll
            for (int r = 0; r < 16; ++r) ss += o[r] * o[r];
            ss += __shfl_xor(ss, 32);
            if (hh == 0) SSQ[(cb * 2 + eb) * 32 + l31] = ss;
            LDS_BARRIER();
            const float tot = SSQ[(cb * 2) * 32 + l31] + SSQ[(cb * 2 + 1) * 32 + l31];
            const float rstd = __builtin_amdgcn_rsqf(tot * (1.0f / 64.0f) + NORM_EPS);
#pragma unroll
            for (int g = 0; g < 4; ++g) { const int e0 = 32 * eb + 8 * g + 4 * hh;
                const float g0 = bflo(gwv[g].x), g1 = bfhi(gwv[g].x), g2 = bflo(gwv[g].y), g3 = bfhi(gwv[g].y);
                u32x2 w; w.x = cvt_pk_bf16(o[4 * g] * rstd * g0 * sigmoidf_(g0), o[4 * g + 1] * rstd * g1 * sigmoidf_(g1)); w.y = cvt_pk_bf16(o[4 * g + 2] * rstd * g2 * sigmoidf_(g2), o[4 * g + 3] * rstd * g3 * sigmoidf_(g3));
                *(u32x2*)(MIX + t * 1024 + 768 + h * 64 + e0) = w; }
        }
#undef RC_LOAD
        __syncthreads();
    }
}
__device__ __forceinline__ float exp2_(float x) { return __builtin_amdgcn_exp2f(x); }
__device__ __forceinline__ void attn_unit(LAS unsigned char* lds, const bf16_t* QB, const unsigned char* KT, const unsigned char* VT, bf16_t* MIX, int bh, int qb, int tid, int wave, int lane) {
    const int b = bh >> 2, h = bh & 3, hh = lane >> 5, l31 = lane & 31, grp = wave >> 2;
    const int qrel = wave * 32 + l31;
    const size_t trow = (size_t)b * SEQ + (size_t)qb * 256 + qrel;
    bf16x8 qf[6];
#pragma unroll
    for (int s = 0; s < 6; ++s) qf[s] = *(const bf16x8*)(QB + trow * 384 + h * 96 + 16 * s + 8 * hh);
    f32x16 o0, o1;
#pragma unroll
    for (int r = 0; r < 16; ++r) { o0[r] = 0.f; o1[r] = 0.f; }
    float mrun = -1e30f, lsum = 0.f;
    const int ntile = 4 * (qb + 1);
    const unsigned char* kbase = KT + (size_t)bh * 128 * 12288 + lane * 16; const unsigned char* vbase = VT + (size_t)bh * 128 * 8192 + wave * 1024 + lane * 16;
    const int kp0 = wave * 1024, kp1 = (wave < 4 ? wave + 8 : wave) * 1024;
    LAS unsigned char* vring = lds + 36864;
#define AT_DMA_K(T, SLOT) do { const unsigned char* kp_ = kbase + (size_t)(T) * 12288; LAS unsigned char* kd_ = lds + (SLOT) * 12288; \
        __builtin_amdgcn_global_load_lds((const unsigned*)(kp_ + kp0), (LAS unsigned*)(kd_ + kp0), 16, 0, 0); \
        __builtin_amdgcn_global_load_lds((const unsigned*)(kp_ + kp1), (LAS unsigned*)(kd_ + kp1), 16, 0, 0); } while (0)
#define AT_DMA_V(T, SLOT) __builtin_amdgcn_global_load_lds((const unsigned*)(vbase + (size_t)(T) * 8192), (LAS unsigned*)(vring + (SLOT) * 8192 + wave * 1024), 16, 0, 0)
#define AT_BAR() asm volatile("s_barrier" ::: "memory")
#define AT_PV(SLOT) do { LAS unsigned char* vl = vring + (SLOT) * 8192; _Pragma("unroll") for (int ks = 0; ks < 4; ++ks) { \
        const bf16x8 va0 = *(const LAS bf16x8*)(vl + ((ks * 2 + hh) * 64 + l31) * 16); const bf16x8 va1 = *(const LAS bf16x8*)(vl + ((ks * 2 + hh) * 64 + 32 + l31) * 16); \
        o0 = __builtin_amdgcn_mfma_f32_32x32x16_bf16(va0, pb[ks], o0, 0, 0, 0); o1 = __builtin_amdgcn_mfma_f32_32x32x16_bf16(va1, pb[ks], o1, 0, 0, 0); } } while (0)
    AT_DMA_K(0, 0);
    AT_DMA_K(1, 1); AT_DMA_V(0, 0);
    *(LAS u32x4*)(vring + 2 * 8192 + tid * 16) = zero4();
    asm volatile("s_waitcnt vmcnt(3) lgkmcnt(0)" ::: "memory"); AT_BAR();
    if (grp) AT_BAR();
    int i0 = 0, i1 = 1, i2 = 2;
    bf16x8 pb[4];
#pragma unroll
    for (int ks = 0; ks < 4; ++ks) pb[ks] = __builtin_bit_cast(bf16x8, zero4());
    const int lrow = (hh * 64 + l31) * 16;
    for (int t = 0; t < ntile; ++t) {
        { const int tk = (t + 2 < ntile) ? t + 2 : ntile - 1, tv = (t + 1 < ntile) ? t + 1 : ntile - 1; AT_DMA_K(tk, i2); AT_DMA_V(tv, i1); }
        const int jr = t - 4 * qb;
        f32x16 s0, s1;
#pragma unroll
        for (int r = 0; r < 16; ++r) { s0[r] = 0.f; s1[r] = 0.f; }
        {
            LAS unsigned char* kl = lds + i0 * 12288 + lrow; LAS unsigned char* vl = vring + i2 * 8192 + lrow;
            bf16x8 kf[12], vf[8];
#pragma unroll
            for (int s = 0; s < 2; ++s) { kf[2 * s] = *(const LAS bf16x8*)(kl + s * 2048); kf[2 * s + 1] = *(const LAS bf16x8*)(kl + s * 2048 + 512); }
            __builtin_amdgcn_sched_barrier(0);
            __builtin_amdgcn_s_setprio(1);
#pragma unroll
            for (int s = 0; s < 6; ++s) {
                s0 = __builtin_amdgcn_mfma_f32_32x32x16_bf16(kf[2 * s], qf[s], s0, 0, 0, 0);
                s1 = __builtin_amdgcn_mfma_f32_32x32x16_bf16(kf[2 * s + 1], qf[s], s1, 0, 0, 0);
                if (s < 4) { kf[2 * s + 4] = *(const LAS bf16x8*)(kl + (s + 2) * 2048); kf[2 * s + 5] = *(const LAS bf16x8*)(kl + (s + 2) * 2048 + 512); }
                else {
#pragma unroll
                    for (int q = 0; q < 2; ++q) { const int ks = (s - 4) * 2 + q; vf[2 * ks] = *(const LAS bf16x8*)(vl + ks * 2048); vf[2 * ks + 1] = *(const LAS bf16x8*)(vl + ks * 2048 + 512); } }
                __builtin_amdgcn_sched_barrier(0);
            }
#pragma unroll
            for (int ks = 0; ks < 4; ++ks) { o0 = __builtin_amdgcn_mfma_f32_32x32x16_bf16(vf[2 * ks], pb[ks], o0, 0, 0, 0); o1 = __builtin_amdgcn_mfma_f32_32x32x16_bf16(vf[2 * ks + 1], pb[ks], o1, 0, 0, 0); }
            __builtin_amdgcn_s_setprio(0);
        }
        asm volatile("s_waitcnt vmcnt(3)" ::: "memory"); AT_BAR();
        {
            if (jr >= 0 && (64 * jr + 63 > wave * 32)) {
                const float ninf = -__builtin_inff();
#pragma unroll
                for (int r = 0; r < 16; ++r) { const int key = 64 * jr + (r & 3) + 8 * (r >> 2) + 4 * hh;
                    if (key > qrel) s0[r] = ninf; if (key + 32 > qrel) s1[r] = ninf; }
            }
            float mx = s0[0];
#pragma unroll
            for (int r = 1; r < 16; ++r) mx = fmaxf(mx, s0[r]);
#pragma unroll
            for (int r = 0; r < 16; ++r) mx = fmaxf(mx, s1[r]);
            mx = fmaxf(mx, __shfl_xor(mx, 32));
            const float mnew = fmaxf(mrun, mx);
            const float alpha = exp2_(mrun - mnew);
            float rs = 0.f;
#pragma unroll
            for (int r = 0; r < 16; ++r) { s0[r] = exp2_(s0[r] - mnew); s1[r] = exp2_(s1[r] - mnew); rs += s0[r] + s1[r]; }
            lsum = lsum * alpha + rs;
            if (__builtin_amdgcn_ballot_w64(mnew > mrun) != 0ull) {
#pragma unroll
                for (int r = 0; r < 16; ++r) { o0[r] *= alpha; o1[r] *= alpha; } }
            mrun = mnew;
#pragma unroll
            for (int ks = 0; ks < 4; ++ks) { u32x4 w;
                if (ks < 2) { w.x = cvt_pk_bf16(s0[8 * ks + 0], s0[8 * ks + 1]); w.y = cvt_pk_bf16(s0[8 * ks + 2], s0[8 * ks + 3]); w.z = cvt_pk_bf16(s0[8 * ks + 4], s0[8 * ks + 5]); w.w = cvt_pk_bf16(s0[8 * ks + 6], s0[8 * ks + 7]); }
                else { const int k2 = ks - 2; w.x = cvt_pk_bf16(s1[8 * k2 + 0], s1[8 * k2 + 1]); w.y = cvt_pk_bf16(s1[8 * k2 + 2], s1[8 * k2 + 3]); w.z = cvt_pk_bf16(s1[8 * k2 + 4], s1[8 * k2 + 5]); w.w = cvt_pk_bf16(s1[8 * k2 + 6], s1[8 * k2 + 7]); }
                pb[ks] = __builtin_bit_cast(bf16x8, w); }
        }
        AT_BAR();
        { const int tmp = i0; i0 = i1; i1 = i2; i2 = tmp; }
    }
    AT_PV(i2);
    asm volatile("s_waitcnt vmcnt(0)" ::: "memory"); AT_BAR();
    if (!grp) AT_BAR();
#undef AT_DMA_K
#undef AT_DMA_V
#undef AT_BAR
#undef AT_PV
    const float ltot = lsum + __shfl_xor(lsum, 32);
    const float inv = 1.0f / ltot;
    bf16_t* orow = MIX + trow * 1024 + 512 + h * 64;
#pragma unroll
    for (int g = 0; g < 4; ++g) {
        u32x2 w0, w1;
        w0.x = cvt_pk_bf16(o0[4 * g] * inv, o0[4 * g + 1] * inv); w0.y = cvt_pk_bf16(o0[4 * g + 2] * inv, o0[4 * g + 3] * inv);
        w1.x = cvt_pk_bf16(o1[4 * g] * inv, o1[4 * g + 1] * inv); w1.y = cvt_pk_bf16(o1[4 * g + 2] * inv, o1[4 * g + 3] * inv);
        *(u32x2*)(orow + 8 * g + 4 * hh) = w0; *(u32x2*)(orow + 32 + 8 * g + 4 * hh) = w1;
    }
}
__device__ __forceinline__ void attn_queue(const Args& a, int l, LAS unsigned char* lds, volatile LAS unsigned* qw, unsigned* qctr, int tid, int wave, int lane) {
    const bf16_t* QB = (const bf16_t*)(a.ws + R_QB); const unsigned char* KT = a.ws + R_KT; const unsigned char* VT = a.ws + R_VT; bf16_t* MIX = (bf16_t*)(a.ws + R_MIX);
    for (;;) {
        if (tid == 0) *qw = __hip_atomic_fetch_add(qctr, 1u, __ATOMIC_RELAXED, __HIP_MEMORY_SCOPE_AGENT);
        __syncthreads();
        const int u = (int)__builtin_amdgcn_readfirstlane(*qw);
        __syncthreads();
        if (u >= 1536) break;
        if (u < 1024 && (u & 1)) { conv_expert_item(a, l, u >> 1, (LAS float*)(lds + 65536 + wave * 8704), wave, lane); continue; }
        const int au = u < 1024 ? (u >> 1) : u - 512;
        attn_unit(lds, QB, KT, VT, MIX, au & 31, 31 - (au >> 5), tid, wave, lane);
    }
}
__device__ __forceinline__ void attn_phase(const Args& a, LAS unsigned char* lds, int tid, int wave, int lane, int G) {
    const bf16_t* QB = (const bf16_t*)(a.ws + R_QB); const unsigned char* KT = a.ws + R_KT; const unsigned char* VT = a.ws + R_VT; bf16_t* MIX = (bf16_t*)(a.ws + R_MIX);
    for (int u = blockIdx.x; u < 512; u += G) {
        int bh, pq;
        if ((G & 7) == 0 && (512 % G) == 0) { const int x = blockIdx.x & 7, jj = (u / G) * (G / 8) + (blockIdx.x >> 3); bh = x + 8 * (jj >> 4); pq = jj & 15; }
        else { bh = u >> 4; pq = u & 15; }
        attn_unit(lds, QB, KT, VT, MIX, bh, 31 - pq, tid, wave, lane);
        attn_unit(lds, QB, KT, VT, MIX, bh, pq, tid, wave, lane);
    }
}

__device__ __forceinline__ void rwkv_scan(const Args& a, LAS unsigned char* lds, int tid, int wave, int lane, int G) {
    const float* SI = (const float*)(a.ws + R_SI); float* YR = (float*)(a.ws + R_YRAW);
    constexpr int CH = 16, NCH = SEQ / CH;
    LAS float* buf = (LAS float*)lds;
    const int lt = tid >> 5, lp = tid & 31;
    for (int blk = blockIdx.x; blk < 256; blk += G) {
        int bh, rg;
        if (G == 256) { const int x = blk & 7, j = blk >> 3; bh = x * 4 + (j >> 3); rg = j & 7; }
        else { bh = blk >> 3; rg = blk & 7; }
        const int row = rg * 8 + wave, b = bh >> 2, h = bh & 3;
        const f32x4* src = (const f32x4*)(SI + ((size_t)b * SEQ * 4 + h) * 384 + (size_t)lt * 1536) + lp;
        float* yo = YR + (size_t)b * SEQ * 256 + h * 64 + row;
        f32x4 g0 = src[0], g1 = src[32], g2 = src[64];
        { LAS f32x4* d = (LAS f32x4*)(buf + lt * 384) + lp; d[0] = g0; d[32] = g1; d[64] = g2; }
        __syncthreads();
        float s = 0.f;
        for (int c = 0; c < NCH; ++c) {
            const bool more = (c + 1 < NCH);
            if (more) { const f32x4* sn = src + (size_t)(c + 1) * CH * 384; g0 = sn[0]; g1 = sn[32]; g2 = sn[64]; }
            const LAS float* cb = buf + (c & 1) * CH * 384;
            float ykeep = 0.f;
#pragma unroll
            for (int i = 0; i < CH; ++i) {
                const LAS float* p = cb + i * 384;
                const float r = p[lane], w = p[64 + lane], k = p[128 + lane], kk = p[192 + lane], bb = p[256 + lane], v = p[320 + row];
                const float sa = -wave_sum_bc(s * kk);
                s = fmaf(sa, bb, fmaf(s, w, v * k));
                const float y = wave_sum_bc(s * r);
                ykeep = (lane == i) ? y : ykeep;
            }
            if (lane < CH) yo[(size_t)(c * CH + lane) * 256] = ykeep;
            if (more) { LAS f32x4* d = (LAS f32x4*)(buf + ((c + 1) & 1) * CH * 384 + lt * 384) + lp; d[0] = g0; d[32] = g1; d[64] = g2; }
            __syncthreads();
        }
    }
}
constexpr size_t RWP_CHUNK = 22 * 1024;
__device__ __forceinline__ u32x4 pack8(const float* x) { u32x4 w; w.x = cvt_pk_bf16(x[0], x[1]); w.y = cvt_pk_bf16(x[2], x[3]); w.z = cvt_pk_bf16(x[4], x[5]); w.w = cvt_pk_bf16(x[6], x[7]); return w; }
__device__ __forceinline__ bf16x8 frag2(const LAS bf16_t* p0, const LAS bf16_t* p1) { const u32x2 lo = *(const LAS u32x2*)p0, hi = *(const LAS u32x2*)p1; u32x4 w; w.x = lo.x; w.y = lo.y; w.z = hi.x; w.w = hi.y; return __builtin_bit_cast(bf16x8, w); }
__device__ __forceinline__ void rwkv_pre(const Args& a, int l, LAS unsigned char* lds, int wave, int lane, int G) {
    const bf16_t* PROJ = (const bf16_t*)(a.ws + R_PROJ); const bf16_t* LO = (const bf16_t*)(a.ws + R_LO); float* VF = (float*)(a.ws + WS_VF); bf16_t* BON = (bf16_t*)(a.ws + R_SI);
    unsigned char* RWP = a.ws + R_SI + 64 * MiB;
    LAS unsigned char* L = lds + wave * 16384;
    LAS bf16_t* AT = (LAS bf16_t*)L; LAS bf16_t* BH = (LAS bf16_t*)(L + 4096); LAS bf16_t* KH = (LAS bf16_t*)(L + 8192); LAS bf16_t* RT = (LAS bf16_t*)(L + 12288);
    LAS float* LT = (LAS float*)L; LAS float* TAL = (LAS float*)(L + 4096); LAS bf16_t* BB = (LAS bf16_t*)(L + 8192);
    LAS bf16_t* WL = (LAS bf16_t*)L; LAS bf16_t* GL = (LAS bf16_t*)(L + 4096);
    const int hh = lane >> 5, l31 = lane & 31;
    for (int ci = blockIdx.x * 8 + wave; ci < NB * 4 * 256; ci += G * 8) {
        const int bh = ci >> 8, c = ci & 255, b = bh >> 2, h = bh & 3;
        const size_t tok0 = (size_t)b * SEQ + (size_t)c * 32; const int jj = h * 64 + lane;
        unsigned char* out = RWP + (size_t)ci * RWP_CHUNK;
        float at[32], vv[32], bhv[32], khv[32];
        float pC;
        {
            const float* mu = FIN(I_RWMU) + l * 1024;
            const float mur = mu[jj], muk = mu[256 + jj], muv = mu[512 + jj];
            const float w0 = FIN(I_RWW0)[l * 256 + jj], a0 = FIN(I_RWA0)[l * 256 + jj], kkp = FIN(I_RWKK)[l * 256 + jj], kap = FIN(I_RWKA)[l * 256 + jj], rkp = FIN(I_RWRK)[l * 256 + jj];
            const float v0 = l > 0 ? FIN(I_RWV0)[(l - 1) * 256 + jj] : 0.f;
            float rp = 0.f, kp = 0.f, vp = 0.f;
            if (c != 0) { const bf16_t* pp = PROJ + (tok0 - 1) * INWP; rp = bf2f(pp[C_RWR + jj]); kp = bf2f(pp[C_RWK + jj]); vp = bf2f(pp[C_RWV + jj]); }
            float p = 1.f;
            unsigned raw[2][4][6]; float rvf[2][4];
#define RW_LOADG(buf_, g_) do { _Pragma("unroll") for (int q_ = 0; q_ < 4; ++q_) { const size_t tk_ = tok0 + 4 * (g_) + q_; const bf16_t* pc_ = PROJ + tk_ * INWP; const bf16_t* lo_ = LO + tk_ * 1024; \
                raw[buf_][q_][0] = pc_[C_RWR + jj]; raw[buf_][q_][1] = pc_[C_RWK + jj]; raw[buf_][q_][2] = pc_[C_RWV + jj]; raw[buf_][q_][3] = lo_[jj]; raw[buf_][q_][4] = lo_[256 + jj]; \
                raw[buf_][q_][5] = lo_[768 + jj]; rvf[buf_][q_] = VF[tk_ * 256 + jj]; } } while (0)
            RW_LOADG(0, 0);
#pragma unroll
            for (int t = 0; t < 32; ++t) { const size_t tok = tok0 + t; const int g_ = t >> 2, q = t & 3, bu = g_ & 1;
                if (q == 0 && g_ < 7) { RW_LOADG(bu ^ 1, g_ + 1); asm volatile("" ::: "memory"); }
                const float rc = bf2f(raw[bu][q][0]), kc = bf2f(raw[bu][q][1]), vc = bf2f(raw[bu][q][2]);
                const float r = rc + (rp - rc) * mur, k = kc + (kp - kc) * muk; float v = vc + (vp - vc) * muv; rp = rc; kp = kc; vp = vc;
                const float wl = w0 + bf2f(raw[bu][q][3]); const float w = __expf(-__expf(-__logf(1.0f + __expf(-wl)) - 0.5f));
                const float aa = sigmoidf_(a0 + bf2f(raw[bu][q][4]));
                if (l > 0) { const float vf = rvf[bu][q]; v += (vf - v) * sigmoidf_(v0 + bf2f(raw[bu][q][5])); } else VF[tok * 256 + jj] = v;
                const float kk0 = k * kkp; const float kk = kk0 * __builtin_amdgcn_rcpf(fmaxf(sqrtf(wave_sum_bc(kk0 * kk0)), 1e-12f));
                const float kx = k * (1.0f + (aa - 1.0f) * kap), bb = kk * aa;
                BON[tok * 256 + jj] = cvt1(wave_sum_bc(r * kx * rkp) * v);
                vv[t] = v;
                const float pprev = p; p *= w; at[t] = -kk * pprev; const float ip = __builtin_amdgcn_rcpf(p); bhv[t] = bb * ip; khv[t] = kx * ip;
                const int idx = ((lane >> 3) * 32 + t) * 8 + (lane & 7);
                AT[idx] = cvt1(at[t]); BH[idx] = cvt1(bhv[t]); KH[idx] = cvt1(khv[t]); RT[idx] = cvt1(r * p);
                if ((t & 3) == 3) asm volatile("" ::: "memory"); }
#undef RW_LOADG
            pC = p;
        }
        {
#pragma unroll
            for (int sh = 0; sh < 4; ++sh) { const int s2 = sh >> 1, h2 = sh & 1; float x[8];
#pragma unroll
                for (int j = 0; j < 8; ++j) x[j] = vv[16 * s2 + 8 * (j >> 2) + 4 * h2 + (j & 3)];
                *(u32x4*)(out + (size_t)(18 + sh) * 1024 + lane * 16) = pack8(x); }
        }
        LDS_WAIT();
        f32x16 lt, ta, abr, akr;
#pragma unroll
        for (int r = 0; r < 16; ++r) { lt[r] = 0.f; ta[r] = 0.f; abr[r] = 0.f; akr[r] = 0.f; }
#pragma unroll
        for (int s4 = 0; s4 < 4; ++s4) { const int fo = ((2 * s4 + hh) * 32 + l31) * 8;
            const bf16x8 fa = *(const LAS bf16x8*)(AT + fo), fb = *(const LAS bf16x8*)(BH + fo), fk = *(const LAS bf16x8*)(KH + fo), fr = *(const LAS bf16x8*)(RT + fo);
            lt = __builtin_amdgcn_mfma_f32_32x32x16_bf16(fa, fb, lt, 0, 0, 0); ta = __builtin_amdgcn_mfma_f32_32x32x16_bf16(fa, fk, ta, 0, 0, 0);
            abr = __builtin_amdgcn_mfma_f32_32x32x16_bf16(fb, fr, abr, 0, 0, 0); akr = __builtin_amdgcn_mfma_f32_32x32x16_bf16(fk, fr, akr, 0, 0, 0); }
#pragma unroll
        for (int r = 0; r < 16; ++r) { const int row = (r & 3) + 8 * (r >> 2) + 4 * hh;
            if (!(l31 < row)) { lt[r] = 0.f; ta[r] = 0.f; } if (!(row <= l31)) { abr[r] = 0.f; akr[r] = 0.f; } }
        LDS_WAIT();
#pragma unroll
        for (int r = 0; r < 16; ++r) { const int row = (r & 3) + 8 * (r >> 2) + 4 * hh; LT[row * 32 + l31] = lt[r]; TAL[row * 32 + l31] = ta[r]; }
#pragma unroll
        for (int ic = 0; ic < 4; ++ic) { float x[8];
#pragma unroll
            for (int j = 0; j < 8; ++j) { x[j] = bhv[8 * ic + j] * pC; khv[8 * ic + j] *= pC; }
            *(LAS u32x4*)(BB + (ic * 64 + lane) * 8) = pack8(x); }
        LDS_WAIT();
        {
            float g[32];
#pragma unroll
            for (int j = 0; j < 32; ++j) g[j] = TAL[j * 32 + l31];
#pragma unroll
            for (int j = 1; j < 32; ++j) {
#pragma unroll
                for (int i4 = 0; i4 * 4 < j; ++i4) { const f32x4 c4 = *(const LAS f32x4*)(LT + j * 32 + 4 * i4);
#pragma unroll
                    for (int ii = 0; ii < 4; ++ii) { const int i = 4 * i4 + ii; if (i < j) { at[j] = fmaf(at[i], c4[ii], at[j]); g[j] = fmaf(g[i], c4[ii], g[j]); } } }
                if ((j & 1) == 1) asm volatile("" ::: "memory"); }
            LDS_WAIT();
#pragma unroll
            for (int ic = 0; ic < 4; ++ic) { *(LAS u32x4*)(WL + (ic * 64 + lane) * 8) = pack8(at + 8 * ic); if (lane < 32) *(LAS u32x4*)(GL + (ic * 32 + lane) * 8) = pack8(g + 8 * ic); }
        }
        LDS_WAIT();
        bf16x8 ab[2];
#pragma unroll
        for (int s2 = 0; s2 < 2; ++s2) { float x[8];
#pragma unroll
            for (int j = 0; j < 8; ++j) x[j] = abr[8 * s2 + j];
            ab[s2] = __builtin_bit_cast(bf16x8, pack8(x)); }
        bf16x8 gf[2];
#pragma unroll
        for (int s2 = 0; s2 < 2; ++s2) gf[s2] = frag2(GL + ((2 * s2) * 32 + l31) * 8 + 4 * hh, GL + ((2 * s2 + 1) * 32 + l31) * 8 + 4 * hh);
#define RW_STORE_TILE(acc_, unit_) do { _Pragma("unroll") for (int s2_ = 0; s2_ < 2; ++s2_) { float x_[8]; _Pragma("unroll") for (int j_ = 0; j_ < 8; ++j_) x_[j_] = acc_[8 * s2_ + j_]; \
            *(u32x4*)(out + (size_t)((unit_) + s2_) * 1024 + lane * 16) = pack8(x_); } } while (0)
        {
            f32x16 acc = akr;
#pragma unroll
            for (int s2 = 0; s2 < 2; ++s2) acc = __builtin_amdgcn_mfma_f32_32x32x16_bf16(gf[s2], ab[s2], acc, 0, 0, 0);
            RW_STORE_TILE(acc, 16);
        }
        const float pcv0 = __shfl(pC, l31), pcv1 = __shfl(pC, 32 + l31);
#pragma unroll
        for (int kb = 0; kb < 2; ++kb) {
            bf16x8 wf[2];
#pragma unroll
            for (int s2 = 0; s2 < 2; ++s2) wf[s2] = frag2(WL + ((2 * s2) * 64 + 32 * kb + l31) * 8 + 4 * hh, WL + ((2 * s2 + 1) * 64 + 32 * kb + l31) * 8 + 4 * hh);
            {
                f32x16 acc;
#pragma unroll
                for (int g4 = 0; g4 < 4; ++g4) { const u32x2 w = *(const LAS u32x2*)(RT + ((4 * kb + g4) * 32 + l31) * 8 + 4 * hh);
                    acc[4 * g4] = bflo(w.x); acc[4 * g4 + 1] = bfhi(w.x); acc[4 * g4 + 2] = bflo(w.y); acc[4 * g4 + 3] = bfhi(w.y); }
#pragma unroll
                for (int s2 = 0; s2 < 2; ++s2) acc = __builtin_amdgcn_mfma_f32_32x32x16_bf16(wf[s2], ab[s2], acc, 0, 0, 0);
                RW_STORE_TILE(acc, 8 + kb * 2);
            }
#pragma unroll
            for (int q = 0; q < 2; ++q) {
                f32x16 acc;
#pragma unroll
                for (int r = 0; r < 16; ++r) acc[r] = 0.f;
#pragma unroll
                for (int s2 = 0; s2 < 2; ++s2) { const bf16x8 bf_ = frag2(BB + ((2 * s2) * 64 + 32 * q + l31) * 8 + 4 * hh, BB + ((2 * s2 + 1) * 64 + 32 * q + l31) * 8 + 4 * hh);
                    acc = __builtin_amdgcn_mfma_f32_32x32x16_bf16(wf[s2], bf_, acc, 0, 0, 0); }
                if (kb == q) { const float pcv = q ? pcv1 : pcv0;
#pragma unroll
                    for (int r = 0; r < 16; ++r) if ((r & 3) + 8 * (r >> 2) + 4 * hh == l31) acc[r] += pcv; }
                RW_STORE_TILE(acc, (kb * 2 + q) * 2);
            }
        }
#pragma unroll
        for (int q = 0; q < 2; ++q) {
            f32x16 acc;
#pragma unroll
            for (int g4 = 0; g4 < 4; ++g4)
#pragma unroll
                for (int jx = 0; jx < 4; ++jx) { const float va = __shfl(khv[8 * g4 + jx], 32 * q + l31), vb = __shfl(khv[8 * g4 + 4 + jx], 32 * q + l31); acc[4 * g4 + jx] = hh ? vb : va; }
#pragma unroll
            for (int s2 = 0; s2 < 2; ++s2) { const bf16x8 bf_ = frag2(BB + ((2 * s2) * 64 + 32 * q + l31) * 8 + 4 * hh, BB + ((2 * s2 + 1) * 64 + 32 * q + l31) * 8 + 4 * hh);
                acc = __builtin_amdgcn_mfma_f32_32x32x16_bf16(gf[s2], bf_, acc, 0, 0, 0); }
            RW_STORE_TILE(acc, 12 + q * 2);
        }
#undef RW_STORE_TILE
        LDS_WAIT();
    }
}
__device__ __forceinline__ void rwkv_main(const Args& a, int l, LAS unsigned char* lds, int bh, int tid, int wave, int lane) {
    const unsigned char* RWP = a.ws + R_SI + 64 * MiB + (size_t)bh * 256 * RWP_CHUNK;
    const bf16_t* BON = (const bf16_t*)(a.ws + R_SI); const bf16_t* LO = (const bf16_t*)(a.ws + R_LO); bf16_t* MIX = (bf16_t*)(a.ws + R_MIX);
    LAS float* YB = (LAS float*)(lds + 45056);
    const int hh = lane >> 5, l31 = lane & 31, vb = wave;
    f32x16 st[2];
#pragma unroll
    for (int r = 0; r < 16; ++r) { st[0][r] = 0.f; st[1][r] = 0.f; }
    u32x4 g0, g1, g2 = zero4();
    g0 = *(const u32x4*)(RWP + tid * 16); g1 = *(const u32x4*)(RWP + (512 + tid) * 16); if (tid < 384) g2 = *(const u32x4*)(RWP + (1024 + tid) * 16);
    *(LAS u32x4*)(lds + tid * 16) = g0; *(LAS u32x4*)(lds + (512 + tid) * 16) = g1; if (tid < 384) *(LAS u32x4*)(lds + (1024 + tid) * 16) = g2;
    __syncthreads();
    const int jj = (bh & 3) * 64 + lane;
    const float lng = FIN(I_RWLG)[l * 256 + jj], lnb = FIN(I_RWLB)[l * 256 + jj];
    float pb_[4], pg_[4];
#define RW_POST_LOAD(cc_) do { _Pragma("unroll") for (int q_ = 0; q_ < 4; ++q_) { const size_t tok_ = (size_t)(bh >> 2) * SEQ + (size_t)(cc_) * 32 + wave * 4 + q_; pb_[q_] = bf2f(BON[tok_ * 256 + jj]); pg_[q_] = bf2f(LO[tok_ * 1024 + 512 + jj]); } } while (0)
#define RW_POST(cc_) do { const LAS float* yb_ = YB + ((cc_) & 1) * 2048; _Pragma("unroll") for (int q_ = 0; q_ < 4; ++q_) { const int t_ = wave * 4 + q_; const size_t tok_ = (size_t)(bh >> 2) * SEQ + (size_t)(cc_) * 32 + t_; \
        const float y_ = yb_[t_ * 64 + lane]; const float mean_ = wave_sum(y_) * (1.0f / 64.0f); const float d_ = y_ - mean_; const float var_ = wave_sum(d_ * d_) * (1.0f / 64.0f); \
        const float yn_ = d_ * __builtin_amdgcn_rsqf(var_ + 64e-5f) * lng + lnb; \
        MIX[tok_ * 1024 + 256 + jj] = (bf16_t)f2bf((yn_ + pb_[q_]) * pg_[q_]); } } while (0)
    for (int c = 0; c < 256; ++c) {
        const bool more = (c + 1 < 256);
        if (c > 0) RW_POST_LOAD(c - 1);
        if (more) { const unsigned char* nx = RWP + (size_t)(c + 1) * RWP_CHUNK; g0 = *(const u32x4*)(nx + tid * 16); g1 = *(const u32x4*)(nx + (512 + tid) * 16); if (tid < 384) g2 = *(const u32x4*)(nx + (1024 + tid) * 16); }
        if (wave < 2) {
            const LAS unsigned char* in = lds + (c & 1) * 22528;
#define RW_F(unit_) (*(const LAS bf16x8*)(in + (unit_) * 1024 + lane * 16))
            const bf16x8 vf0 = *(const LAS bf16x8*)(in + (18 + hh) * 1024 + (32 * vb + l31) * 16), vf1 = *(const LAS bf16x8*)(in + (20 + hh) * 1024 + (32 * vb + l31) * 16);
            bf16x8 hi[2][2], lo[2][2];
#pragma unroll
            for (int kb = 0; kb < 2; ++kb)
#pragma unroll
                for (int s2 = 0; s2 < 2; ++s2) { float xh[8], xl[8];
#pragma unroll
                    for (int j = 0; j < 8; ++j) { const float x = st[kb][8 * s2 + j]; const float hf = bf2f(f2bf(x)); xh[j] = hf; xl[j] = x - hf; }
                    hi[kb][s2] = __builtin_bit_cast(bf16x8, pack8(xh)); lo[kb][s2] = __builtin_bit_cast(bf16x8, pack8(xl)); }
            f32x16 y, n0, n1;
#pragma unroll
            for (int r = 0; r < 16; ++r) { y[r] = 0.f; n0[r] = 0.f; n1[r] = 0.f; }
#pragma unroll
            for (int kb = 0; kb < 2; ++kb)
#pragma unroll
                for (int s2 = 0; s2 < 2; ++s2) {
                    y = __builtin_amdgcn_mfma_f32_32x32x16_bf16(RW_F(8 + kb * 2 + s2), hi[kb][s2], y, 0, 0, 0);
                    const bf16x8 m0 = RW_F((kb * 2 + 0) * 2 + s2), m1 = RW_F((kb * 2 + 1) * 2 + s2);
                    n0 = __builtin_amdgcn_mfma_f32_32x32x16_bf16(m0, hi[kb][s2], n0, 0, 0, 0); n0 = __builtin_amdgcn_mfma_f32_32x32x16_bf16(m0, lo[kb][s2], n0, 0, 0, 0);
                    n1 = __builtin_amdgcn_mfma_f32_32x32x16_bf16(m1, hi[kb][s2], n1, 0, 0, 0); n1 = __builtin_amdgcn_mfma_f32_32x32x16_bf16(m1, lo[kb][s2], n1, 0, 0, 0);
                }
            y = __builtin_amdgcn_mfma_f32_32x32x16_bf16(RW_F(16), vf0, y, 0, 0, 0); y = __builtin_amdgcn_mfma_f32_32x32x16_bf16(RW_F(17), vf1, y, 0, 0, 0);
            n0 = __builtin_amdgcn_mfma_f32_32x32x16_bf16(RW_F(12), vf0, n0, 0, 0, 0); n0 = __builtin_amdgcn_mfma_f32_32x32x16_bf16(RW_F(13), vf1, n0, 0, 0, 0);
            n1 = __builtin_amdgcn_mfma_f32_32x32x16_bf16(RW_F(14), vf0, n1, 0, 0, 0); n1 = __builtin_amdgcn_mfma_f32_32x32x16_bf16(RW_F(15), vf1, n1, 0, 0, 0);
#undef RW_F
            LAS float* yo = YB + (c & 1) * 2048 + 32 * vb + l31;
#pragma unroll
            for (int r = 0; r < 16; ++r) yo[((r & 3) + 8 * (r >> 2) + 4 * hh) * 64] = y[r];
            st[0] = n0; st[1] = n1;
        }
        if (c > 0) RW_POST(c - 1);
        if (more) { LAS unsigned char* d = lds + ((c + 1) & 1) * 22528; *(LAS u32x4*)(d + tid * 16) = g0; *(LAS u32x4*)(d + (512 + tid) * 16) = g1; if (tid < 384) *(LAS u32x4*)(d + (1024 + tid) * 16) = g2; }
        __syncthreads();
    }
    RW_POST_LOAD(255); RW_POST(255);
#undef RW_POST
#undef RW_POST_LOAD
    __syncthreads();
}

__device__ __forceinline__ void rwkv_post(const Args& a, int l, int wave, int lane, int G) {
    const float* SI = (const float*)(a.ws + R_SI); const float* YR = (const float*)(a.ws + R_YRAW); const bf16_t* LO = (const bf16_t*)(a.ws + R_LO); bf16_t* MIX = (bf16_t*)(a.ws + R_MIX);
#pragma unroll 4
    for (int idx = blockIdx.x * NWAVES + wave; idx < T * 4; idx += G * NWAVES) {
        const size_t t = idx >> 2; const int h = idx & 3, j = h * 64 + lane;
        const float y = YR[t * 256 + j];
        const float mean = wave_sum(y) * (1.0f / 64.0f); const float d = y - mean; const float var = wave_sum(d * d) * (1.0f / 64.0f);
        const float yn = d * __builtin_amdgcn_rsqf(var + 64e-5f) * FIN(I_RWLG)[l * 256 + j] + FIN(I_RWLB)[l * 256 + j];
        const float bonus = bf2f(((const bf16_t*)SI)[t * 256 + j]);
        const float g = bf2f(LO[t * 1024 + 512 + j]);
        MIX[t * 1024 + 256 + j] = (bf16_t)f2bf((yn + bonus) * g);
    }
}

__device__ __forceinline__ void phase_norm2(const Args& a, int l, LAS unsigned char* lds, int tid, int wave, int lane, int G) {
    LAS unsigned char* img_hi = lds; LAS unsigned char* img_lo = lds + 65536;
    LAS float* pbuf = (LAS float*)lds;
    LAS int* hist = (LAS int*)(lds + 135168);
    const float* rw = FIN(I_RTW) + (size_t)l * 1024 * 32;
    const float* MOD = (const float*)(a.ws + WS_MOD);
    int* tki = (int*)(a.ws + MO_IDX); float* tkw = (float*)(a.ws + MO_W); int* blkcnt = (int*)(a.ws + MO_BLKCNT);
    const float* gn = FIN(I_NFG) + l * D;
    const int hh = lane >> 5, l31 = lane & 31;
    bf16x8 whi[8], wlo[8];
#pragma unroll
    for (int s = 0; s < 8; ++s) { float xh[8], xl[8];
#pragma unroll
        for (int i = 0; i < 8; ++i) { const float w = rw[(size_t)(128 * wave + 16 * s + 8 * hh + i) * 32 + l31]; const float hf = bf2f(f2bf(w)); xh[i] = hf; xl[i] = w - hf; }
        whi[s] = __builtin_bit_cast(bf16x8, pack8(xh)); wlo[s] = __builtin_bit_cast(bf16x8, pack8(xl)); }
    const float rbias = FIN(I_RTB)[l * 32 + l31];
    for (int rb = blockIdx.x; rb < 256; rb += G) {
        if (tid < 32) hist[tid] = 0;
        f32x4 gsc[4], shv[4];
        { const int b0 = (rb * 256) >> 13; const float* sh = MOD + (size_t)(l * 8 + b0) * 6144 + 3072; const float* sc = sh + 1024;
#pragma unroll
          for (int j = 0; j < 4; ++j) { gsc[j] = ((const f32x4*)gn)[64 * j + lane] * (1.0f + ((const f32x4*)sc)[64 * j + lane]); shv[j] = ((const f32x4*)sh)[64 * j + lane]; } }
        f32x4 v[4][4];
#pragma unroll
        for (int q = 0; q < 4; ++q)
#pragma unroll
            for (int j = 0; j < 4; ++j) v[q][j] = ((const f32x4*)(a.out + (size_t)(rb * 256 + 4 * wave + q) * D))[64 * j + lane];
        for (int sbt = 0; sbt < 8; ++sbt) {
            const int mb = rb * 256 + sbt * 32;
#pragma unroll
            for (int q = 0; q < 4; ++q) { const int row = 4 * wave + q, m = mb + row; float ss = 0.f;
#pragma unroll
                for (int j = 0; j < 4; ++j) ss += (v[q][j].x * v[q][j].x + v[q][j].y * v[q][j].y) + (v[q][j].z * v[q][j].z + v[q][j].w * v[q][j].w);
                ss = wave_sum(ss);
                const float rstd = __builtin_amdgcn_rsqf(ss * (1.0f / D) + NORM_EPS);
#pragma unroll
                for (int j = 0; j < 4; ++j) { const f32x4 hq = v[q][j] * rstd * gsc[j] + shv[j]; ((unsigned*)(a.ws + WS_HN8 + (size_t)m * D))[64 * j + lane] = pk4_fp8(hq.x, hq.y, hq.z, hq.w);
                    u32x2 wh, wl; wh.x = cvt_pk_bf16(hq.x, hq.y); wh.y = cvt_pk_bf16(hq.z, hq.w);
                    wl.x = cvt_pk_bf16(hq.x - bflo(wh.x), hq.y - bfhi(wh.x)); wl.y = cvt_pk_bf16(hq.z - bflo(wh.y), hq.w - bfhi(wh.y));
                    const int off = row * 2048 + (((32 * j + (lane >> 1)) ^ (row & 15)) << 4) + ((lane & 1) << 3);
                    *(LAS u32x2*)(img_hi + off) = wh; *(LAS u32x2*)(img_lo + off) = wl; } }
            if (sbt < 7) {
#pragma unroll
                for (int q = 0; q < 4; ++q)
#pragma unroll
                    for (int j = 0; j < 4; ++j) v[q][j] = ((const f32x4*)(a.out + (size_t)(mb + 32 + 4 * wave + q) * D))[64 * j + lane];
            }
            LDS_BARRIER();
            f32x16 acc;
#pragma unroll
            for (int r = 0; r < 16; ++r) acc[r] = 0.f;
#pragma unroll
            for (int s = 0; s < 8; ++s) { const int off = l31 * 2048 + (((16 * wave + 2 * s + hh) ^ (l31 & 15)) << 4);
                const bf16x8 bh = *(const LAS bf16x8*)(img_hi + off), bl = *(const LAS bf16x8*)(img_lo + off);
                acc = __builtin_amdgcn_mfma_f32_32x32x16_bf16(whi[s], bh, acc, 0, 0, 0);
                acc = __builtin_amdgcn_mfma_f32_32x32x16_bf16(wlo[s], bh, acc, 0, 0, 0);
                acc = __builtin_amdgcn_mfma_f32_32x32x16_bf16(whi[s], bl, acc, 0, 0, 0); }
            LDS_BARRIER();
#pragma unroll
            for (int r = 0; r < 16; ++r) pbuf[wave * 1056 + ((r & 3) + 8 * (r >> 2) + 4 * hh) * 33 + l31] = acc[r];
            LDS_BARRIER();
            {
                float val[4]; float tv[4][4]; int ti[4][4];
#pragma unroll
                for (int q = 0; q < 4; ++q) { float sacc = 0.f;
#pragma unroll
                    for (int w2 = 0; w2 < 8; ++w2) sacc += pbuf[w2 * 1056 + l31 * 33 + 4 * wave + q];
                    val[q] = sacc + rbias; }
#pragma unroll
                for (int k = 0; k < 4; ++k) {
#pragma unroll
                    for (int q = 0; q < 4; ++q) { float mxv = val[q];
                        mxv = fmaxf(mxv, dpp_f<0xB1>(mxv)); mxv = fmaxf(mxv, dpp_f<0x4E>(mxv)); mxv = fmaxf(mxv, dpp_f<0x141>(mxv)); mxv = fmaxf(mxv, dpp_f<0x140>(mxv));
                        mxv = fmaxf(mxv, __builtin_bit_cast(float, __builtin_amdgcn_ds_swizzle(__builtin_bit_cast(int, mxv), 0x401F)));
                        const unsigned bal = (unsigned)__builtin_amdgcn_ballot_w64(val[q] == mxv);
                        const int idx = __builtin_ctz(bal);
                        tv[q][k] = mxv; ti[q][k] = idx; if ((lane & 31) == idx) val[q] = -__builtin_inff(); } }
#pragma unroll
                for (int q = 0; q < 4; ++q) { const int m = mb + 4 * wave + q;
                    const float e1 = __expf(tv[q][1] - tv[q][0]), e2 = __expf(tv[q][2] - tv[q][0]), e3 = __expf(tv[q][3] - tv[q][0]); const float inv = __builtin_amdgcn_rcpf(1.0f + e1 + e2 + e3);
                    if (lane == 0) {
                        tki[m * 4] = ti[q][0]; tki[m * 4 + 1] = ti[q][1]; tki[m * 4 + 2] = ti[q][2]; tki[m * 4 + 3] = ti[q][3];
                        tkw[m * 4] = inv; tkw[m * 4 + 1] = e1 * inv; tkw[m * 4 + 2] = e2 * inv; tkw[m * 4 + 3] = e3 * inv;
                        lds_add(&hist[ti[q][0]]); lds_add(&hist[ti[q][1]]); lds_add(&hist[ti[q][2]]); lds_add(&hist[ti[q][3]]); } }
            }
            LDS_BARRIER();
        }
        if (tid < 32) blkcnt[rb * 32 + tid] = hist[tid];
        __syncthreads();
    }
}
__device__ __forceinline__ void phase_plan(const Args& a, LAS unsigned char* lds, int tid, int G) {
    LAS int* tot = (LAS int*)lds; LAS int* base = tot + 32; LAS int* pstart = tot + 64; LAS int* cur = tot + 96;
    const int* blkcnt = (const int*)(a.ws + MO_BLKCNT); const int* tki = (const int*)(a.ws + MO_IDX);
    int* pos = (int*)(a.ws + MO_POS); int* rowtok = (int*)(a.ws + MO_ROWTOK); int* tile_e = (int*)(a.ws + MO_TILEE);
    unsigned* ctl = (unsigned*)(a.ws + WS_CTL);
    for (int rb = blockIdx.x; rb < 256; rb += G) {
        {
            LAS int* ptot = tot + 256; LAS int* pbase = tot + 768; const int e = tid & 31, part = tid >> 5; int c[16]; int t = 0, bs = 0;
#pragma unroll
            for (int j = 0; j < 16; ++j) c[j] = blkcnt[(part * 16 + j) * 32 + e];
#pragma unroll
            for (int j = 0; j < 16; ++j) { if (part * 16 + j < rb) bs += c[j]; t += c[j]; }
            ptot[part * 32 + e] = t; pbase[part * 32 + e] = bs;
            __syncthreads();
            if (tid < 32) { int tt = 0, bb = 0;
#pragma unroll
                for (int p = 0; p < 16; ++p) { tt += ptot[p * 32 + tid]; bb += pbase[p * 32 + tid]; }
                tot[tid] = tt; base[tid] = bb; cur[tid] = 0; }
        }
        __syncthreads();
        if (tid == 0) { int ps = 0; for (int e = 0; e < 32; ++e) { pstart[e] = ps; ps += (tot[e] + 255) & ~255; } if (rb == 0) ctl[CW_NTILES] = (unsigned)(ps >> 8); }
        __syncthreads();
        for (int q = tid; q < 1024; q += NTHR) { const int row = rb * 256 + (q >> 2), k = q & 3; const int e = tki[row * 4 + k];
            const int r = lds_add(&cur[e]); const int p = pstart[e] + base[e] + r; pos[row * 4 + k] = p; rowtok[p] = row; }
        if (rb < 32) { const int e = rb, pe = pstart[e] + ((tot[e] + 255) & ~255); for (int p = pstart[e] + tot[e] + tid; p < pe; p += NTHR) rowtok[p] = 0;
            for (int tl = (pstart[e] >> 8) + tid; tl < (pe >> 8); tl += NTHR) tile_e[tl] = e; }
        __syncthreads();
    }
}

constexpr int PH_PER_LAYER = 13, NPH = 2 + DEPTH * PH_PER_LAYER;
#ifndef MK_SPLIT
#define MK_SPLIT 0
#endif
struct KArgs { Args a; int li, pad; };

__global__ void __launch_bounds__(NTHR, 2) fwd(KArgs ka) {
    extern __shared__ __attribute__((aligned(16))) unsigned char lds_raw[];
    LAS unsigned char* lds = (LAS unsigned char*)lds_raw;
    const int tid0 = threadIdx.x, G = gridDim.x, wave0 = __builtin_amdgcn_readfirstlane(tid0 >> 6);
    volatile LAS unsigned* MISC = (volatile LAS unsigned*)(lds + MISC_OFF);
    if (tid0 < 32) MISC[tid0] = 0u;
    __syncthreads();
    unsigned* ctl0 = (unsigned*)(ka.a.ws + WS_CTL);
    const int lo = ka.a.ph_lo, hi = ka.a.ph_hi;
    XcdBarrier bar; bar.bar = ctl0 + CW_BAR + ka.li * XCD_BAR_WORDS; bar.x = 0; bar.st = MISC + 8;
    if (hi - lo > 1) bar = xcd_barrier_post(ctl0 + CW_BAR + ka.li * XCD_BAR_WORDS, MISC + 8);
#ifndef MK_PHMASK
#define MK_PHMASK 0xFFFF
#endif
#define PHM(j) ((MK_PHMASK >> (j)) & 1)
#ifndef PROBE_DUP
#define PROBE_DUP 0
#endif
#define REP(id) for (int rep_ = 0; rep_ < 1 + ((PROBE_DUP >> (id)) & 1); ++rep_)
#define IN(k) (lo <= (k) && (k) < hi)
#define SEAM(k) do { if (IN(k) && IN((k) + 1)) xcd_barrier(bar); } while (0)

#define FRESH() int lane; asm volatile("v_mbcnt_lo_u32_b32 %0, -1, 0\n\tv_mbcnt_hi_u32_b32 %0, -1, %0" : "=v"(lane)); int wave = wave0; asm volatile("" : "+s"(wave)); const int tid = wave * 64 + lane; (void)tid; \
    Args a = ka.a; { size_t z_ = 0; asm volatile("" : "+s"(z_)); a.ws = ka.a.ws + z_; a.out = ka.a.out + z_; } \
    bf16_t* PROJ = (bf16_t*)(a.ws + R_PROJ); bf16_t* MIX = (bf16_t*)(a.ws + R_MIX); bf16_t* HN = (bf16_t*)(a.ws + WS_HN); const bf16_t* SM = (const bf16_t*)(a.ws + WS_WSM); unsigned* ctl = (unsigned*)(a.ws + WS_CTL); (void)PROJ; (void)MIX; (void)HN; (void)SM; (void)ctl
    if (PHM(0) && IN(0)) { FRESH(); phase_init(a, lds, tid, G); SEAM(0); }

    for (int l = 0; l < DEPTH; ++l) {
        const int pb = 1 + l * PH_PER_LAYER;
        if (PHM(1) && IN(pb + 0)) { FRESH(); REP(0) phase_conv<0>(a, l, lds, tid, wave, lane, G); phase_norm1<0>(a, l, wave, lane, G); SEAM(pb + 0); }
        if (PHM(2) && IN(pb + 1)) { FRESH();
            pg8::Gemm g{HN, (const bf16_t*)(a.ws + WS_WIN), 1024, 1024, 1024, nullptr}; pg8::Order S; S.init(T / 256, INWP / 256, G, (int)blockIdx.x);
            pg8::EpiBf16 E{PROJ, INWP, nullptr, 0};
            REP(1) pg8::gemm_phase<pg8::EpiBf16, false>(lds, g, S, E, tid);
            SEAM(pb + 1);
        }
        if (PHM(3) && IN(pb + 2)) { FRESH(); REP(2) phase_pre(a, l, tid, G); s5_repack(a, tid, G); SEAM(pb + 2); }
        if (PHM(4) && IN(pb + 3)) { FRESH();
            const bf16_t* AP = (const bf16_t*)(a.ws + R_AP); bf16_t* QKV = (bf16_t*)(a.ws + R_QKV); bf16_t* LO = (bf16_t*)(a.ws + R_LO); bf16_t* BU = (bf16_t*)(a.ws + R_BU);
#define SMALL_GEMM(A_, LDA_, BOFF_, NN_, O_, LDC_) do { pg8::Gemm g{A_, SM + (BOFF_) / 2, LDA_, 256, 256, nullptr}; pg8::Order S; S.init(T / 256, NN_, G, (int)blockIdx.x); \
                pg8::EpiBf16 E{O_, LDC_, nullptr, 0}; pg8::gemm_phase<pg8::EpiBf16, false>(lds, g, S, E, tid); } while (0)
            REP(3) {
            SMALL_GEMM(PROJ + C_QC, INWP, SM_WQ, 2, QKV, 1024);
            SMALL_GEMM(PROJ + C_KVC, INWP, SM_WKV, 2, QKV + 512, 1024);
            SMALL_GEMM(AP, 512, SM_WLORA, 3, LO, 1024);
            if (l > 0) SMALL_GEMM(AP + 256, 512, SM_WVV, 1, LO + 768, 1024);
            { pg8::Gemm g{(const bf16_t*)(a.ws + R_UP), (const bf16_t*)(a.ws + R_WE), 768, 512, 512, nullptr}; pg8::Order S; S.init(128, 1, G, (int)blockIdx.x, (const int*)(a.ws + WS_S5TAB), (size_t)256 * 512);
              pg8::EpiS5E E{(float*)(a.ws + R_EB)}; pg8::gemm_phase<pg8::EpiS5E, false>(lds, g, S, E, tid); }
            }
#undef SMALL_GEMM
            SEAM(pb + 3);
        }
        if (PHM(5) && IN(pb + 4)) { FRESH();
            REP(4) mla_finish(a, lds, tid, G);
            REP(6) s5_chunk_scan(a, l, tid, G);
            __syncthreads();
            REP(7) ret_pass_a(a, lds, tid, wave, lane, G);
            SEAM(pb + 4);
        }
        if (PHM(6) && IN(pb + 5)) { FRESH();
            { pg8::Gemm g{(const bf16_t*)(a.ws + R_UP), (const bf16_t*)(a.ws + R_WY), 768, 768, 768, nullptr}; pg8::Order S; S.init(128, 2, G, (int)blockIdx.x, (const int*)(a.ws + WS_S5TAB), (size_t)512 * 768);
              pg8::EpiS5Y E{(bf16_t*)(a.ws + R_YG), PROJ, FIN(I_S5D) + l * 256}; pg8::gemm_phase<pg8::EpiS5Y, false>(lds, g, S, E, tid); }
            REP(9) { rwkv_pre(a, l, lds, wave, lane, G);
            __syncthreads(); }
            __syncthreads();
            REP(10) ret_pass_c(a, lds, tid, wave, lane, G);
            SEAM(pb + 5);
        }
        if (PHM(7) && IN(pb + 6)) { FRESH();
            pg8::Gemm g{(const bf16_t*)(a.ws + R_YG), SM + SM_WGLU / 2, 256, 256, 256, nullptr}; pg8::Order S; S.init(T / 256, 1, G > 64 ? G - 32 : G, G > 64 ? (int)blockIdx.x - 32 : (int)blockIdx.x);
            pg8::EpiGlu E{MIX, (const bf16_t*)(a.ws + R_YG), FIN(I_S5GB) + l * 256};
            if (G > 64) { if ((int)blockIdx.x < 32) rwkv_main(a, l, lds, (int)blockIdx.x, tid, wave, lane); else pg8::gemm_phase<pg8::EpiGlu, false>(lds, g, S, E, tid); }
            else { for (int bh = blockIdx.x; bh < 32; bh += G) rwkv_main(a, l, lds, bh, tid, wave, lane); pg8::gemm_phase<pg8::EpiGlu, false>(lds, g, S, E, tid); }
            __syncthreads();
            attn_queue(a, l, lds, (volatile LAS unsigned*)(lds + MISC_OFF + 64), ctl + CW_ATTQ + 64 * l, tid, wave, lane);
            SEAM(pb + 6);
        }
        if (PHM(8) && IN(pb + 7)) { FRESH();
        }
        if (PHM(9) && IN(pb + 8)) { FRESH();
            pg8::Gemm g{MIX, (const bf16_t*)(a.ws + WS_WOUT), 1024, 1024, 1024, nullptr}; pg8::Order S; S.init(T / 256, 4, G, (int)blockIdx.x);
            pg8::EpiResid E{l == 0 ? FIN(I_X) : a.out, a.out, (const float*)(a.ws + WS_MOD) + (size_t)(l * 8) * 6144 + 2048};
            const bool own = (G == T / 256) && IN(pb + 9);
            S.own = own ? 1 : 0;
            pg8::gemm_phase<pg8::EpiResid, false>(lds, g, S, E, tid);
            if (!own) SEAM(pb + 8);
        }
        if (PHM(10) && IN(pb + 9)) { FRESH(); REP(14) phase_norm2(a, l, lds, tid, wave, lane, G); SEAM(pb + 9); }
        if (PHM(11) && IN(pb + 10)) { FRESH(); REP(15) phase_plan(a, lds, tid, G); SEAM(pb + 10); }
        if (PHM(12) && IN(pb + 11)) { FRESH();
            const int ntiles = __builtin_amdgcn_readfirstlane((int)__hip_atomic_load(ctl + CW_NTILES, __ATOMIC_RELAXED, __HIP_MEMORY_SCOPE_AGENT));
            pg8::Gemm g{(const bf16_t*)(a.ws + WS_HN8), (const bf16_t*)(a.ws + WS_WGU), 512, 512, 512, (const int*)(a.ws + MO_ROWTOK)}; pg8::Order S; S.init(ntiles, 8, G, (int)blockIdx.x, (const int*)(a.ws + MO_TILEE), (size_t)2048 * 512);
            pg8::EpiSwiglu E{a.ws + R_H, FIN(I_EBG) + (size_t)l * 32 * 1024, FIN(I_EBU) + (size_t)l * 32 * 1024};
            REP(16) pg8::gemm_phase<pg8::EpiSwiglu, true, true>(lds, g, S, E, tid);
            SEAM(pb + 11);
        }
        if (PHM(13) && IN(pb + 12)) { FRESH();
            const int ntiles = __builtin_amdgcn_readfirstlane((int)__hip_atomic_load(ctl + CW_NTILES, __ATOMIC_RELAXED, __HIP_MEMORY_SCOPE_AGENT));
            pg8::Gemm g{(const bf16_t*)(a.ws + R_H), (const bf16_t*)(a.ws + WS_WDN), 512, 512, 512, nullptr}; pg8::Order S; S.init(ntiles, 4, G, (int)blockIdx.x, (const int*)(a.ws + MO_TILEE), (size_t)1024 * 512);
            pg8::EpiBf16 E{(bf16_t*)(a.ws + R_Y), 1024, FIN(I_EBD) + (size_t)l * 32 * 1024, 1024, 1};
            REP(17) pg8::gemm_phase<pg8::EpiBf16, false, true>(lds, g, S, E, tid);
            SEAM(pb + 12);
        }
    }
    if (PHM(14) && IN(NPH - 1)) { FRESH(); phase_norm1<1>(a, DEPTH, wave, lane, G); }
#undef IN
#undef SEAM
}

extern "C" void kernel_launch(void* const* d_in, const int* in_sizes, int n_in, void* d_out, int out_size, void* d_ws, size_t ws_size, hipStream_t stream) {
    static int grid = 0;
    if (grid == 0) {
        if (n_in != 46 || in_sizes[0] != T * D || out_size != T * D || ws_size < WS_END) {
            fprintf(stderr, "kernel_launch: unexpected problem: n_in %d in0 %d out %d ws %zu (need %zu)\n", n_in, n_in > 0 ? in_sizes[0] : -1, out_size, ws_size, (size_t)WS_END); grid = -1; return; }
        int dev = 0, cus = 0;
        if (hipGetDevice(&dev) != hipSuccess || hipDeviceGetAttribute(&cus, hipDeviceAttributeMultiprocessorCount, dev) != hipSuccess) { fprintf(stderr, "kernel_launch: device query failed\n"); grid = -1; return; }
        if (hipFuncSetAttribute((const void*)fwd, hipFuncAttributeMaxDynamicSharedMemorySize, LDS_BYTES) != hipSuccess) { fprintf(stderr, "kernel_launch: hipFuncSetAttribute failed\n"); grid = -1; return; }
        int per_cu = 0;
        if (hipOccupancyMaxActiveBlocksPerMultiprocessor(&per_cu, (const void*)fwd, NTHR, LDS_BYTES) != hipSuccess || per_cu < 1) fprintf(stderr, "kernel_launch: occupancy query reports %d\n", per_cu);
        (void)hipGetLastError();
        grid = cus;
    }
    if (grid < 0) return;
    if (hipMemsetAsync((char*)d_ws + WS_CTL, 0, CTL_ZERO_BYTES, stream) != hipSuccess) { fprintf(stderr, "kernel_launch: memset failed\n"); return; }
    KArgs ka{};
    for (int i = 0; i < 46; ++i) ka.a.in[i] = d_in[i];
    ka.a.out = (float*)d_out; ka.a.ws = (unsigned char*)d_ws;
#if MK_SPLIT
    for (int p = 0; p < NPH; ++p) { ka.a.ph_lo = p; ka.a.ph_hi = p + 1; ka.li = p; ka.pad = 0;
        hipLaunchKernelGGL(fwd, dim3(grid), dim3(NTHR), LDS_BYTES, stream, ka);
        const hipError_t le = hipPeekAtLastError(); if (le != hipSuccess) { fprintf(stderr, "kernel_launch: launch %d failed: %s\n", p, hipGetErrorName(le)); break; } }
#else
    ka.a.ph_lo = 0; ka.a.ph_hi = NPH; ka.li = 0; ka.pad = 0;
    hipLaunchKernelGGL(fwd, dim3(grid), dim3(NTHR), LDS_BYTES, stream, ka);
    const hipError_t le = hipPeekAtLastError(); if (le != hipSuccess) fprintf(stderr, "kernel_launch: launch failed: %s\n", hipGetErrorName(le));
#endif
}
```

```cpp
#include <hip/hip_runtime.h>
#include <cstdint>
#include <cstdio>

#define LAS __attribute__((address_space(3)))
#define GAS __attribute__((address_space(1)))
typedef unsigned short bf16_t;
typedef short bf16x8 __attribute__((ext_vector_type(8)));
typedef float f32x2 __attribute__((ext_vector_type(2)));
typedef float f32x4 __attribute__((ext_vector_type(4)));
typedef float f32x16 __attribute__((ext_vector_type(16)));
typedef unsigned u32x2 __attribute__((ext_vector_type(2)));
typedef unsigned u32x4 __attribute__((ext_vector_type(4)));

constexpr int NB = 8, SEQ = 8192, T = NB * SEQ, D = 1024, DEPTH = 4;
constexpr int INW = 2464, INWP = 2560;
constexpr int C_S5 = 0, C_RWR = 256, C_RWK = 512, C_RWV = 768, C_RWWD = 1024, C_QC = 1280, C_KVC = 1536, C_KPE = 1664;
constexpr int C_RQ = 1696, C_RK = 1824, C_RV = 1952, C_RG = 2208;
constexpr int NE = 32, TOPK = 4, PMAX = 270336  , MAXTILES = 1056;
constexpr float NORM_EPS = 1e-5f;

constexpr size_t MiB = 1u << 20;
constexpr size_t WS_CTL = 0, CTL_ZERO_BYTES = 1 * MiB;
constexpr size_t WS_MOD = 1 * MiB;
constexpr size_t WS_ROPE = 2 * MiB;
constexpr size_t WS_WIN = 10 * MiB;
constexpr size_t WS_WOUT = 15 * MiB;
constexpr size_t WS_WSM = 17 * MiB;
constexpr size_t WS_WGU = 21 * MiB;
constexpr size_t WS_WDN = 149 * MiB;
constexpr size_t WS_HN8 = 85 * MiB;
constexpr size_t WS_HN = 213 * MiB;
constexpr size_t WS_VF = 341 * MiB;
constexpr size_t WS_MOE = 405 * MiB;
constexpr size_t WS_REG = 413 * MiB;
constexpr size_t R_PROJ = WS_REG;
constexpr size_t R_MIX = R_PROJ + 320 * MiB;
constexpr size_t R_AP = R_MIX + 128 * MiB;
constexpr size_t R_E = R_AP;
constexpr size_t R_CKV = R_AP + 8 * MiB;
constexpr size_t R_YG = R_AP + 24 * MiB;
constexpr size_t R_LO = R_AP + 64 * MiB;
constexpr size_t R_SI = R_LO + 128 * MiB;
constexpr size_t R_QKV = R_SI + 384 * MiB;
constexpr size_t R_YRAW = R_QKV;
constexpr size_t R_BU = R_QKV + 128 * MiB;
constexpr size_t R_UP = R_BU;
constexpr size_t R_EB = R_BU + 64 * MiB;
constexpr size_t R_WE = R_BU + 96 * MiB;
constexpr size_t R_WY = R_BU + 104 * MiB;
constexpr size_t WS_KD = R_BU + 120 * MiB;
constexpr size_t WS_S5TAB = R_BU + 124 * MiB;
constexpr size_t R_QB = R_BU + 256 * MiB;
constexpr size_t R_KT = R_QB + 48 * MiB;
constexpr size_t R_VT = R_KT + 48 * MiB;
constexpr size_t R_END = R_VT + 32 * MiB;
constexpr size_t R_H = WS_REG;
constexpr size_t R_Y = WS_REG + 528 * MiB;
constexpr size_t WS_END = R_END;
static_assert(R_Y + 528 * MiB <= R_END, "MoE overlay fits the region");
constexpr size_t SM_WQ = 0;
constexpr size_t SM_WKV = 256 * 1024;
constexpr size_t SM_WLORA = 512 * 1024;
constexpr size_t SM_WVV = 896 * 1024;
constexpr size_t SM_WGLU = 1024 * 1024;
constexpr size_t SM_WBU = 1152 * 1024;
constexpr size_t SM_WC = 2176 * 1024;
constexpr size_t MO_IDX = WS_MOE, MO_W = WS_MOE + 1 * MiB, MO_POS = WS_MOE + 2 * MiB, MO_ROWTOK = WS_MOE + 3 * MiB, MO_BLKCNT = WS_MOE + 5 * MiB, MO_TILEE = WS_MOE + 5 * MiB + 64 * 1024;
constexpr int CW_NTILES = 16, CW_ATTQ = 64  , CW_BAR = 4096;

constexpr int NWAVES = 8, NTHR = 512;
constexpr int LDS_BYTES = 147456;
constexpr int MISC_OFF = 131072 + 8192;


__device__ __forceinline__ float bf2f(unsigned h) { return __builtin_bit_cast(float, h << 16); }
__device__ __forceinline__ float bflo(unsigned w) { return __builtin_bit_cast(float, w << 16); }
__device__ __forceinline__ float bfhi(unsigned w) { return __builtin_bit_cast(float, w & 0xffff0000u); }
typedef __bf16 bf16x2_t __attribute__((ext_vector_type(2)));
__device__ __forceinline__ unsigned cvt_pk_bf16(float lo, float hi) { const f32x2 v = {lo, hi}; const bf16x2_t b = __builtin_convertvector(v, bf16x2_t); return __builtin_bit_cast(unsigned, b); }
__device__ __forceinline__ u32x4 zero4() { unsigned z = 0u; asm volatile("" : "+v"(z)); u32x4 w; w.x = z; w.y = z; w.z = z; w.w = z; return w; }
__device__ __forceinline__ unsigned pk2(float lo, float hi) { return cvt_pk_bf16(lo, hi); }
__device__ __forceinline__ unsigned f2bf(float f) { return cvt_pk_bf16(f, f) & 0xffffu; }
__device__ __forceinline__ unsigned pk4_fp8(float a0, float a1, float a2, float a3) { int w = 0; w = __builtin_amdgcn_cvt_pk_fp8_f32(a0, a1, w, false); w = __builtin_amdgcn_cvt_pk_fp8_f32(a2, a3, w, true); return (unsigned)w; }
__device__ __forceinline__ bf16_t cvt1(float x) { return (bf16_t)(cvt_pk_bf16(x, x) & 0xffffu); }
__device__ __forceinline__ float sigmoidf_(float x) { return __builtin_amdgcn_rcpf(1.0f + __expf(-x)); }
template <int CTRL> __device__ __forceinline__ float dpp_f(float v) { return __builtin_bit_cast(float, __builtin_amdgcn_update_dpp(0, __builtin_bit_cast(int, v), CTRL, 0xF, 0xF, true)); }
__device__ __forceinline__ float wave_sum(float v) {
    v += dpp_f<0xB1>(v);
    v += dpp_f<0x4E>(v);
    v += dpp_f<0x141>(v);
    v += dpp_f<0x140>(v);
    const float a = __builtin_bit_cast(float, __builtin_amdgcn_readlane(__builtin_bit_cast(int, v), 0));
    const float b = __builtin_bit_cast(float, __builtin_amdgcn_readlane(__builtin_bit_cast(int, v), 16));
    const float c = __builtin_bit_cast(float, __builtin_amdgcn_readlane(__builtin_bit_cast(int, v), 32));
    const float d = __builtin_bit_cast(float, __builtin_amdgcn_readlane(__builtin_bit_cast(int, v), 48));
    return (a + b) + (c + d);
}
template <int CTRL, int RM> __device__ __forceinline__ float dpp_fm(float v) { return __builtin_bit_cast(float, __builtin_amdgcn_update_dpp(0, __builtin_bit_cast(int, v), CTRL, RM, 0xF, false)); }
__device__ __forceinline__ float wave_sum_bc(float v) {
    v += dpp_f<0xB1>(v); v += dpp_f<0x4E>(v); v += dpp_f<0x141>(v); v += dpp_f<0x140>(v);
    v += dpp_fm<0x142, 0xA>(v);
    v += dpp_fm<0x143, 0xC>(v);
    return __builtin_bit_cast(float, __builtin_amdgcn_readlane(__builtin_bit_cast(int, v), 63));
}
__device__ __forceinline__ int lds_add(LAS int* p) { return __hip_atomic_fetch_add(p, 1, __ATOMIC_RELAXED, __HIP_MEMORY_SCOPE_WORKGROUP); }
__device__ __forceinline__ float wave_sum_shfl(float v) {
#pragma unroll
    for (int o = 1; o < 64; o <<= 1) v += __shfl_xor(v, o);
    return v;
}

namespace pg8 {
constexpr int BM = 256, BK = 64, HALF = 128, HTB = HALF * BK * 2, STAGE_BYTES = 8 * HTB, NXCD = 8, WGM = 8;
__host__ __device__ __forceinline__ int lds_byte(int r, int c) { const int st = (r >> 4) * 2 + (c >> 5), rr = r & 15, cc = c & 31, ob = rr * 64 + cc * 2; return st * 1024 + (ob ^ (((ob >> 9) & 1) << 5)); }
__host__ __device__ __forceinline__ void stage_rc(int b, int& R, int& C) { const int st = b / 1024, sb = b % 1024, swz = sb ^ (((sb >> 9) & 1) << 5); R = (st >> 1) * 16 + swz / 64; C = (st & 1) * 32 + (swz % 64) / 2; }
__host__ __device__ __forceinline__ int perm32(int rho) { const int n = rho >> 4, i = rho & 15; return 8 * (i >> 2) + 4 * n + (i & 3); }

struct Unit { int pm, pn; };
struct Gemm { const bf16_t* A; const bf16_t* Bt; int lda, ldb, K; const int* rowtok; };

struct Order {
    int nM, nN, nwg, G, c; const int* tile_e; size_t bstride;
    int own = 0;
    __device__ void init(int nM_, int nN_, int G_, int c_, const int* te = nullptr, size_t bs = 0) { nM = nM_; nN = nN_; nwg = nM * nN; G = G_; c = c_; tile_e = te; bstride = bs; }
    __device__ bool next(int i, Unit& u) const {
        if (own) { if (i >= nN) return false; u.pm = c; u.pn = i; return true; }
        const long L = (long)i * G + c; if (L >= nwg) return false;
        int wgid = (int)L; { const int q = nwg / NXCD, r = nwg % NXCD, xcd = wgid % NXCD, off = wgid / NXCD; wgid = (xcd < r ? xcd * (q + 1) : r * (q + 1) + (xcd - r) * q) + off; }
        const int nig = WGM * nN, gid = wgid / nig, fm = gid * WGM, gsz = (nM - fm) < WGM ? (nM - fm) : WGM;
        u.pm = fm + ((wgid % nig) % gsz); u.pn = (wgid % nig) / gsz; return true;
    }
    __device__ __forceinline__ int expert(const Unit& u) const { return tile_e ? __builtin_amdgcn_readfirstlane(tile_e[u.pm]) : 0; }
};

typedef int v8i_t __attribute__((ext_vector_type(8)));
template <class Epi, bool GATHER, bool FP8 = false>
__device__ __forceinline__ void gemm_phase(LAS unsigned char* lds, const Gemm g, const Order& S, const Epi& E, int tid_in) {
    int tid = tid_in; asm volatile("" : "+v"(tid));
    const int wid = __builtin_amdgcn_readfirstlane(tid >> 6), lane = tid & 63, wr = wid >> 2, wc = wid & 3, fr = lane & 15, fq = lane >> 4;
    const int K = g.K, nt = K / BK;
    int Rst[2], Cst[2];
    unsigned voffB[2], vAc[2][2], vAn[2][2];
#pragma unroll
    for (int i = 0; i < 2; ++i) { int R, C; stage_rc(tid * 16 + i * 8192, R, C); Rst[i] = R; Cst[i] = C; const int Rb = Epi::PERM ? ((R & ~31) + perm32(R & 31)) : R;
        voffB[i] = (unsigned)(Rb * g.ldb + C) * 2u; }
    const size_t kstep = (size_t)(BK * 2);
    const size_t hstepB = (size_t)HALF * g.ldb * 2;
    const unsigned ldsw = (unsigned)wid * 1024u;
    const int aoff = lds_byte(wr * 64 + fr, fq * 8), boff = lds_byte(wc * 32 + fr, fq * 8);
    const int aoff1 = aoff + 1024, boff1 = boff + 1024;
#define PG8_SA(b, h) (((b) * 2 + (h)) * HTB)
#define PG8_SB(b, h) ((4 + (b) * 2 + (h)) * HTB)
#define PG8_STAGE(bufoff, gbase, voff) do { _Pragma("unroll") for (int _i = 0; _i < 2; ++_i) \
        __builtin_amdgcn_global_load_lds((const unsigned*)((const char*)(gbase) + (voff)[_i]), (LAS unsigned*)(lds + (bufoff) + ldsw + _i * 8192), 16, 0, 0); } while (0)
#define PG8_LD8(p0, p1) __builtin_bit_cast(v8i_t, __builtin_shufflevector(*(const LAS u32x4*)(p0), *(const LAS u32x4*)(p1), 0, 1, 2, 3, 4, 5, 6, 7))
#define PG8_LDA(dst, b, h) do { _Pragma("unroll") for (int m = 0; m < 4; ++m) { if (FP8) { dst##8[m] = PG8_LD8(lds + PG8_SA(b, h) + aoff + m * 2048, lds + PG8_SA(b, h) + aoff1 + m * 2048); } \
        else { _Pragma("unroll") for (int k = 0; k < 2; ++k) dst[m][k] = *(const LAS bf16x8*)(lds + PG8_SA(b, h) + aoff + m * 2048 + k * 1024); } } } while (0)
#define PG8_LDB(dst, b, h) do { _Pragma("unroll") for (int n = 0; n < 2; ++n) { if (FP8) { dst##8[n] = PG8_LD8(lds + PG8_SB(b, h) + boff + n * 2048, lds + PG8_SB(b, h) + boff1 + n * 2048); } \
        else { _Pragma("unroll") for (int k = 0; k < 2; ++k) dst[n][k] = *(const LAS bf16x8*)(lds + PG8_SB(b, h) + boff + n * 2048 + k * 1024); } } } while (0)
#define PG8_V8(x) __builtin_bit_cast(v8i_t, __builtin_shufflevector(__builtin_bit_cast(u32x4, x[0]), __builtin_bit_cast(u32x4, x[1]), 0, 1, 2, 3, 4, 5, 6, 7))
#define PG8_MMA(ai, bj, At, Bt) do { __builtin_amdgcn_s_setprio(1); _Pragma("unroll") for (int m = 0; m < 4; ++m) _Pragma("unroll") for (int n = 0; n < 2; ++n) { \
        if (FP8) asm volatile("v_mfma_scale_f32_16x16x128_f8f6f4 %0, %1, %2, %0, %3, %4 op_sel_hi:[0,0,0]" : "+v"(acc[ai][bj][m][n]) : "v"(Bt##8[n]), "v"(At##8[m]), "v"(scB), "v"(scA)); \
        else { _Pragma("unroll") for (int k = 0; k < 2; ++k) acc[ai][bj][m][n] = __builtin_amdgcn_mfma_f32_16x16x32_bf16(Bt[n][k], At[m][k], acc[ai][bj][m][n], 0, 0, 0); } } __builtin_amdgcn_s_setprio(0); } while (0)
#define PG8_WAIT_V(n) asm volatile("s_waitcnt vmcnt(" #n ")" ::: "memory")
#define PG8_WAIT_L(n) asm volatile("s_waitcnt lgkmcnt(" #n ")" ::: "memory")
#define PG8_BAR __builtin_amdgcn_s_barrier()
#define PG8_SCHED __builtin_amdgcn_sched_barrier(0)
#define PG8_AOFFS(dst, unit) do { int _t = tid; if (GATHER) asm volatile("" : "+v"(_t)); _Pragma("unroll") for (int _h = 0; _h < 2; ++_h) _Pragma("unroll") for (int _i = 0; _i < 2; ++_i) { \
        if (GATHER) { int _R, _C; stage_rc(_t * 16 + _i * 8192, _R, _C);        \
            const int _tok = g.rowtok[(unit).pm * BM + _h * HALF + _R]; dst[_h][_i] = (unsigned)(_tok * g.lda + _C) * 2u; } \
        else dst[_h][_i] = (unsigned)((_h * HALF + Rst[_i]) * g.lda + Cst[_i]) * 2u; } } while (0)
    Unit cur, nxt; int ui = 0;
    if (!S.next(0, cur)) return;
    f32x4 acc[2][2][4][2];
#pragma unroll
    for (int a = 0; a < 2; ++a)
#pragma unroll
        for (int b = 0; b < 2; ++b)
#pragma unroll
            for (int m = 0; m < 4; ++m)
#pragma unroll
                for (int n = 0; n < 2; ++n) acc[a][b][m][n] = (f32x4){0.f, 0.f, 0.f, 0.f};
    bf16x8 At[4][2], B0[2][2], B1[2][2];
    v8i_t At8[4], B08[2], B18[2];
    const int scB = 0x7a7a7a7a, scA = 0x7f7f7f7f;
    const size_t tstepA = GATHER ? 0 : (size_t)BM * g.lda * 2, tstepB = (size_t)BM * g.ldb * 2;
    const char* cA = (const char*)g.A + (size_t)cur.pm * tstepA;
    const char* cB = (const char*)g.Bt + ((size_t)S.expert(cur) * S.bstride) * 2 + (size_t)cur.pn * tstepB;
    PG8_AOFFS(vAc, cur);
    if (GATHER) { asm volatile("s_waitcnt vmcnt(0)" ::: "memory"); }
    PG8_STAGE(PG8_SB(0, 0), cB, voffB); PG8_STAGE(PG8_SB(0, 1), cB + hstepB, voffB); PG8_STAGE(PG8_SA(0, 0), cA, vAc[0]); PG8_STAGE(PG8_SA(0, 1), cA, vAc[1]);
    if (wr == 1) PG8_BAR;
    PG8_WAIT_V(2); PG8_BAR;
    PG8_STAGE(PG8_SB(1, 0), cB + kstep, voffB); PG8_STAGE(PG8_SA(1, 0), cA + kstep, vAc[0]); PG8_STAGE(PG8_SB(1, 1), cB + hstepB + kstep, voffB);
    PG8_WAIT_V(6); PG8_BAR;
    for (;;) {
        if constexpr (Epi::PRE && FP8) { if (wid == 0) E.pre_dma(lds + 131072 + (ui & 1) * 1024, cur, S.expert(cur), fq * 16 + fr); }
        const bool has_next = S.next(ui + 1, nxt);
        const char* nA = cA; const char* nB = cB;
        if (has_next) { nA = (const char*)g.A + (size_t)nxt.pm * tstepA; nB = (const char*)g.Bt + ((size_t)S.expert(nxt) * S.bstride) * 2 + (size_t)nxt.pn * tstepB; PG8_AOFFS(vAn, nxt); }
        else {
#pragma unroll
            for (int h = 0; h < 2; ++h)
#pragma unroll
                for (int i = 0; i < 2; ++i) vAn[h][i] = vAc[h][i];
        }
        if (GATHER) { asm volatile("" : "+v"(vAn[0][0]), "+v"(vAn[0][1]), "+v"(vAn[1][0]), "+v"(vAn[1][1])); }
#pragma nounroll
        for (int t = 0; t < nt; t += 2) {
            const bool last = (t == nt - 2);
            const char* a1 = cA + (size_t)(t + 1) * kstep;
            const char* a2 = last ? nA : cA + (size_t)(t + 2) * kstep; const char* b2 = last ? nB : cB + (size_t)(t + 2) * kstep;
            const char* a3 = a2 + kstep; const char* b3 = b2 + kstep;
            unsigned v2[2][2];
#pragma unroll
            for (int h = 0; h < 2; ++h)
#pragma unroll
                for (int i = 0; i < 2; ++i) v2[h][i] = (GATHER && last) ? vAn[h][i] : vAc[h][i];
            PG8_LDB(B0, 0, 0); PG8_LDB(B1, 0, 1); PG8_SCHED; PG8_LDA(At, 0, 0); PG8_STAGE(PG8_SA(1, 1), a1, vAc[1]);
            PG8_WAIT_V(8); PG8_WAIT_L(0); PG8_BAR; PG8_MMA(0, 0, At, B0); PG8_MMA(0, 1, At, B1); PG8_BAR; PG8_SCHED;
            PG8_LDA(At, 0, 1); PG8_STAGE(PG8_SB(0, 0), b2, voffB); PG8_STAGE(PG8_SB(0, 1), b2 + hstepB, voffB); PG8_STAGE(PG8_SA(0, 0), a2, v2[0]);
            PG8_WAIT_V(8); PG8_WAIT_L(0); PG8_BAR; PG8_MMA(1, 0, At, B0); PG8_MMA(1, 1, At, B1); PG8_BAR; PG8_SCHED;
            PG8_LDB(B0, 1, 0); PG8_LDB(B1, 1, 1); PG8_SCHED; PG8_LDA(At, 1, 0); PG8_STAGE(PG8_SA(0, 1), a2, v2[1]);
            PG8_WAIT_V(8); PG8_WAIT_L(0); PG8_BAR; PG8_MMA(0, 0, At, B0); PG8_MMA(0, 1, At, B1); PG8_BAR; PG8_SCHED;
            PG8_LDA(At, 1, 1); PG8_STAGE(PG8_SB(1, 0), b3, voffB); PG8_STAGE(PG8_SB(1, 1), b3 + hstepB, voffB); PG8_STAGE(PG8_SA(1, 0), a3, v2[0]);
            PG8_WAIT_V(8); PG8_WAIT_L(0); PG8_BAR; PG8_MMA(1, 0, At, B0); PG8_MMA(1, 1, At, B1); PG8_BAR; PG8_SCHED;
        }
        if (wr == 0) PG8_BAR;
        if (FP8) asm volatile("s_nop 15\n\ts_nop 15" ::: "memory");
        if constexpr (Epi::PRE && FP8) E(acc, cur, S.expert(cur), wr, wc, fr, fq, (const LAS float*)(lds + 131072 + (ui & 1) * 1024)); else E(acc, cur, S.expert(cur), wr, wc, fr, fq);
        if (!has_next) break;
#pragma unroll
        for (int a = 0; a < 2; ++a)
#pragma unroll
            for (int b = 0; b < 2; ++b)
#pragma unroll
                for (int m = 0; m < 4; ++m)
#pragma unroll
                    for (int n = 0; n < 2; ++n) acc[a][b][m][n] = (f32x4){0.f, 0.f, 0.f, 0.f};
        cur = nxt; cA = nA; cB = nB; ++ui;
#pragma unroll
        for (int h = 0; h < 2; ++h)
#pragma unroll
            for (int i = 0; i < 2; ++i) vAc[h][i] = vAn[h][i];
        if (wr == 1) PG8_BAR;
    }
    PG8_WAIT_V(0);
    PG8_BAR;
#undef PG8_SA
#undef PG8_SB
#undef PG8_STAGE
#undef PG8_LDA
#undef PG8_LDB
#undef PG8_MMA
#undef PG8_V8
#undef PG8_LD8
#undef PG8_WAIT_V
#undef PG8_WAIT_L
#undef PG8_BAR
#undef PG8_SCHED
#undef PG8_AOFFS
}

struct EpiBf16 {
    static constexpr bool PERM = true; static constexpr bool PRE = true;
    bf16_t* O; int ldc; const float* bias; int bias_estride; int nt;
    __device__ __forceinline__ void pre_dma(LAS unsigned char* dst, const Unit& u, int e, int lane) const {
        __builtin_amdgcn_global_load_lds((const unsigned*)(bias + (size_t)e * bias_estride + u.pn * BM + 4 * lane), (LAS unsigned*)dst, 16, 0, 0); }
    __device__ __forceinline__ void operator()(const f32x4 (&acc)[2][2][4][2], const Unit& u, int e, int wr, int wc, int fr, int fq, const LAS float* pb = nullptr) const {
        asm volatile("" : "+v"(fq), "+v"(fr));
        const int row0 = u.pm * BM + wr * 64 + fr, col0 = u.pn * BM + wc * 32 + 8 * fq;
        f32x4 bv[2][2];
#pragma unroll
        for (int bj = 0; bj < 2; ++bj)
#pragma unroll
            for (int n = 0; n < 2; ++n) bv[bj][n] = pb ? *(const LAS f32x4*)(pb + wc * 32 + 8 * fq + bj * HALF + 4 * n) : (bias ? *(const f32x4*)(bias + (size_t)e * bias_estride + col0 + bj * HALF + 4 * n) : (f32x4){0.f, 0.f, 0.f, 0.f});
#pragma unroll
        for (int ai = 0; ai < 2; ++ai)
#pragma unroll
            for (int m = 0; m < 4; ++m) { bf16_t* rowp = O + (size_t)(row0 + ai * HALF + m * 16) * ldc + col0;
#pragma unroll
                for (int bj = 0; bj < 2; ++bj) { const f32x4 v0 = acc[ai][bj][m][0] + bv[bj][0], v1 = acc[ai][bj][m][1] + bv[bj][1];
                    u32x4 w; w.x = cvt_pk_bf16(v0[0], v0[1]); w.y = cvt_pk_bf16(v0[2], v0[3]); w.z = cvt_pk_bf16(v1[0], v1[1]); w.w = cvt_pk_bf16(v1[2], v1[3]);
                    if (nt) __builtin_nontemporal_store(w, (u32x4*)(rowp + bj * HALF)); else *(u32x4*)(rowp + bj * HALF) = w; } }
    }
};
struct EpiResid {
    static constexpr bool PERM = false; static constexpr bool PRE = false;
    const float* R; float* X; const float* gate;
    __device__ __forceinline__ void operator()(const f32x4 (&acc)[2][2][4][2], const Unit& u, int, int wr, int wc, int fr, int fq) const {
        asm volatile("" : "+v"(fq), "+v"(fr));
        const int col0 = u.pn * BM + wc * 32 + 4 * fq; const int b = (u.pm * BM) / SEQ;
        f32x4 gv[2][2];
#pragma unroll
        for (int bj = 0; bj < 2; ++bj)
#pragma unroll
            for (int n = 0; n < 2; ++n) gv[bj][n] = *(const f32x4*)(gate + (size_t)b * 6144 + col0 + bj * HALF + n * 16);
#pragma unroll
        for (int ai = 0; ai < 2; ++ai)
#pragma unroll
            for (int m = 0; m < 4; ++m) { const size_t off = (size_t)(u.pm * BM + ai * HALF + wr * 64 + m * 16 + fr) * D + col0;
#pragma unroll
                for (int bj = 0; bj < 2; ++bj)
#pragma unroll
                    for (int n = 0; n < 2; ++n) { const f32x4 r = *(const f32x4*)(R + off + bj * HALF + n * 16); *(f32x4*)(X + off + bj * HALF + n * 16) = r + gv[bj][n] * acc[ai][bj][m][n]; } }
    }
};
struct EpiSwiglu {
    static constexpr bool PERM = true; static constexpr bool PRE = true;
    unsigned char* H; const float* bg; const float* bu;
    __device__ __forceinline__ void pre_dma(LAS unsigned char* dst, const Unit& u, int e, int lane) const {
        const float* src = (lane < 32 ? bg : bu) + (size_t)e * 1024 + u.pn * HALF + 4 * (lane & 31);
        __builtin_amdgcn_global_load_lds((const unsigned*)src, (LAS unsigned*)dst, 16, 0, 0); }
    __device__ __forceinline__ void operator()(const f32x4 (&acc)[2][2][4][2], const Unit& u, int e, int wr, int wc, int fr, int fq, const LAS float* pb) const {
        asm volatile("" : "+v"(fq), "+v"(fr));
        const int row0 = u.pm * BM + wr * 64 + fr, col0 = u.pn * HALF + wc * 32 + 8 * fq;
        const int cl = wc * 32 + 8 * fq;
        f32x4 g0 = *(const LAS f32x4*)(pb + cl), g1 = *(const LAS f32x4*)(pb + cl + 4);
        f32x4 u0 = *(const LAS f32x4*)(pb + 128 + cl), u1 = *(const LAS f32x4*)(pb + 128 + cl + 4);
#pragma unroll
        for (int ai = 0; ai < 2; ++ai)
#pragma unroll
            for (int m = 0; m < 4; ++m) {
                float o[8];
#pragma unroll
                for (int n = 0; n < 2; ++n)
#pragma unroll
                    for (int j = 0; j < 4; ++j) {
                        float gt = acc[ai][0][m][n][j] + (n ? g1[j] : g0[j]); gt = fminf(gt, 7.0f);
                        float up = acc[ai][1][m][n][j] + (n ? u1[j] : u0[j]); up = fminf(fmaxf(up, -7.0f), 7.0f);
                        o[n * 4 + j] = gt * sigmoidf_(1.702f * gt) * (up + 1.0f);
                    }
                u32x2 w; w.x = pk4_fp8(o[0], o[1], o[2], o[3]); w.y = pk4_fp8(o[4], o[5], o[6], o[7]);
                *(u32x2*)(H + (size_t)(row0 + ai * HALF + m * 16) * 1024 + col0) = w;
            }
    }
};
struct EpiS5C {
    static constexpr bool PERM = true; static constexpr bool PRE = false;
    bf16_t* YG; const bf16_t* PROJ; const float* dskip;
    __device__ __forceinline__ void operator()(const f32x4 (&acc)[2][2][4][2], const Unit& u, int, int wr, int wc, int fr, int fq) const {
        asm volatile("" : "+v"(fq), "+v"(fr));
        const int row0 = u.pm * BM + wr * 64 + fr, col0 = wc * 32 + 8 * fq;
#pragma unroll
        for (int ai = 0; ai < 2; ++ai)
#pragma unroll
            for (int m = 0; m < 4; ++m) { const size_t row = (size_t)(row0 + ai * HALF + m * 16);
#pragma unroll
                for (int bj = 0; bj < 2; ++bj) { const int c = col0 + bj * HALF;
                    const u32x4 uu = *(const u32x4*)(PROJ + row * INWP + C_S5 + c);
                    const f32x4 d0 = *(const f32x4*)(dskip + c), d1 = *(const f32x4*)(dskip + c + 4);
                    float y[8]; const unsigned uw[4] = {uu.x, uu.y, uu.z, uu.w};
#pragma unroll
                    for (int j = 0; j < 8; ++j) { const float uj = (j & 1) ? bfhi(uw[j >> 1]) : bflo(uw[j >> 1]); const float dj = j < 4 ? d0[j & 3] : d1[j & 3];
                        const float v = acc[ai][bj][m][j >> 2][j & 3] + dj * uj;
                        const float tt = 0.7978845608028654f * (v + 0.044715f * v * v * v);
                        const float th = 1.0f - 2.0f * __builtin_amdgcn_rcpf(1.0f + __expf(2.0f * tt));
                        y[j] = 0.5f * v * (1.0f + th); }
                    u32x4 w; w.x = cvt_pk_bf16(y[0], y[1]); w.y = cvt_pk_bf16(y[2], y[3]); w.z = cvt_pk_bf16(y[4], y[5]); w.w = cvt_pk_bf16(y[6], y[7]);
                    *(u32x4*)(YG + row * 256 + c) = w; asm volatile("" ::: "memory"); } }
    }
};
struct EpiS5E {
    static constexpr bool PERM = false; static constexpr bool PRE = false;
    float* EB;
    __device__ __forceinline__ void operator()(const f32x4 (&acc)[2][2][4][2], const Unit& u, int, int wr, int wc, int fr, int fq) const {
        asm volatile("" : "+v"(fq), "+v"(fr));
#pragma unroll
        for (int ai = 0; ai < 2; ++ai)
#pragma unroll
            for (int m = 0; m < 4; ++m) { float* rp = EB + (size_t)(u.pm * BM + ai * HALF + wr * 64 + m * 16 + fr) * 128 + wc * 32 + 4 * fq;
#pragma unroll
                for (int n = 0; n < 2; ++n) *(f32x4*)(rp + n * 16) = acc[ai][0][m][n]; }
    }
};
struct EpiS5Y {
    static constexpr bool PERM = true; static constexpr bool PRE = false;
    bf16_t* YG; const bf16_t* PROJ; const float* dskip;
    __device__ __forceinline__ void operator()(const f32x4 (&acc)[2][2][4][2], const Unit& u, int, int wr, int wc, int fr, int fq) const {
        asm volatile("" : "+v"(fq), "+v"(fr));
        const int g = u.pm >> 3;
#pragma unroll
        for (int ai = 0; ai < 2; ++ai)
#pragma unroll
            for (int m = 0; m < 4; ++m) { const int chunk = (u.pm & 7) * BM + ai * HALF + wr * 64 + m * 16 + fr;
#pragma unroll
                for (int bj = 0; bj < 2; ++bj) { const int col = u.pn * BM + bj * HALF + wc * 32 + 8 * fq, tau = col >> 4, c = g * 16 + (col & 15); const size_t tok = (size_t)chunk * 32 + tau;
                    const u32x4 uu = *(const u32x4*)(PROJ + tok * INWP + C_S5 + c);
                    const f32x4 d0 = *(const f32x4*)(dskip + c), d1 = *(const f32x4*)(dskip + c + 4);
                    float y[8]; const unsigned uw[4] = {uu.x, uu.y, uu.z, uu.w};
#pragma unroll
                    for (int j = 0; j < 8; ++j) { const float uj = (j & 1) ? bfhi(uw[j >> 1]) : bflo(uw[j >> 1]); const float dj = j < 4 ? d0[j & 3] : d1[j & 3];
                        const float v = acc[ai][bj][m][j >> 2][j & 3] + dj * uj;
                        const float tt = 0.7978845608028654f * (v + 0.044715f * v * v * v);
                        const float th = 1.0f - 2.0f * __builtin_amdgcn_rcpf(1.0f + __expf(2.0f * tt));
                        y[j] = 0.5f * v * (1.0f + th); }
                    u32x4 w; w.x = cvt_pk_bf16(y[0], y[1]); w.y = cvt_pk_bf16(y[2], y[3]); w.z = cvt_pk_bf16(y[4], y[5]); w.w = cvt_pk_bf16(y[6], y[7]);
                    *(u32x4*)(YG + tok * 256 + c) = w; asm volatile("" ::: "memory"); } }
    }
};
struct EpiGlu {
    static constexpr bool PERM = true; static constexpr bool PRE = false;
    bf16_t* MIX; const bf16_t* YG; const float* gb;
    __device__ __forceinline__ void operator()(const f32x4 (&acc)[2][2][4][2], const Unit& u, int, int wr, int wc, int fr, int fq) const {
        asm volatile("" : "+v"(fq), "+v"(fr));
        const int row0 = u.pm * BM + wr * 64 + fr, col0 = wc * 32 + 8 * fq;
#pragma unroll
        for (int ai = 0; ai < 2; ++ai)
#pragma unroll
            for (int m = 0; m < 4; ++m) { const size_t row = (size_t)(row0 + ai * HALF + m * 16);
#pragma unroll
                for (int bj = 0; bj < 2; ++bj) { const int c = col0 + bj * HALF;
                    const u32x4 yy = *(const u32x4*)(YG + row * 256 + c);
                    const f32x4 b0 = *(const f32x4*)(gb + c), b1 = *(const f32x4*)(gb + c + 4);
                    float o[8]; const unsigned yw[4] = {yy.x, yy.y, yy.z, yy.w};
#pragma unroll
                    for (int j = 0; j < 8; ++j) { const float yj = (j & 1) ? bfhi(yw[j >> 1]) : bflo(yw[j >> 1]); const float bj_ = j < 4 ? b0[j & 3] : b1[j & 3];
                        o[j] = yj * sigmoidf_(acc[ai][bj][m][j >> 2][j & 3] + bj_); }
                    u32x4 w; w.x = cvt_pk_bf16(o[0], o[1]); w.y = cvt_pk_bf16(o[2], o[3]); w.z = cvt_pk_bf16(o[4], o[5]); w.w = cvt_pk_bf16(o[6], o[7]);
                    *(u32x4*)(MIX + row * 1024 + c) = w; asm volatile("" ::: "memory"); } }
    }
};
}

#define XB_TMO      128
#define XB_XCNT(j)  (256  + 64 * (j))
#define XB_XSUB(j)  (1280 + 64 * (j))
#define XB_XGEN(j)  (2304 + 64 * (j))
#define XB_TOP      3328
#define XB_TOPGEN   3392
#define XCD_BAR_WORDS 3456
#define XB_SPIN_CAP (1u << 23)
__device__ __forceinline__ unsigned xb_ld(unsigned* p)              { return __hip_atomic_load(p, __ATOMIC_RELAXED, __HIP_MEMORY_SCOPE_AGENT); }
__device__ __forceinline__ unsigned xb_add(unsigned* p, unsigned v) { return __hip_atomic_fetch_add(p, v, __ATOMIC_RELAXED, __HIP_MEMORY_SCOPE_AGENT); }
__device__ __forceinline__ unsigned xb_xcc_id() { return (unsigned)__builtin_amdgcn_s_getreg((3 << 11) | 20) & 0xFu; }
#define XB_SPIN(cond, bar) do { unsigned _sp = 0; while (cond) { __builtin_amdgcn_s_sleep(1); \
    if ((++_sp & 255u) == 0u) { if (xb_ld(&(bar)[XB_TMO])) break; if (_sp > XB_SPIN_CAP) { atomicAdd(&(bar)[XB_TMO], 1u); break; } } } } while (0)
struct XcdBarrier { unsigned* bar; unsigned x; volatile LAS unsigned* st; };
__device__ __forceinline__ XcdBarrier xcd_barrier_post(unsigned* bar, volatile LAS unsigned* st) {
    XcdBarrier b; b.bar = bar; b.x = xb_xcc_id(); b.st = st;
    if (threadIdx.x == 0) (void)xb_add(&bar[XB_XCNT(b.x)], 1u);
    return b;
}
__device__ __forceinline__ void xcd_barrier_complete(unsigned* bar, unsigned x, unsigned& nloc, unsigned& nx) {
    const unsigned G = gridDim.x * gridDim.y * gridDim.z;
    unsigned sum, cnt, mine, sp = 0u;
    for (;;) {
        sum = 0u; cnt = 0u; mine = 0u;
#pragma unroll
        for (unsigned j = 0; j < 16; ++j) { const unsigned c = xb_ld(&bar[XB_XCNT(j)]); sum += c; cnt += (c > 0u) ? 1u : 0u; mine = (j == x) ? c : mine; }
        if (sum == G) break;
        __builtin_amdgcn_s_sleep(1);
        if ((++sp & 255u) == 0u) { if (xb_ld(&bar[XB_TMO])) break; if (sp > XB_SPIN_CAP) { atomicAdd(&bar[XB_TMO], 1u); break; } }
    }
    nloc = mine > 0u ? mine : 1u; nx = cnt > 0u ? cnt : 1u;
}
__device__ __forceinline__ void xcd_barrier(const XcdBarrier& b) {
    asm volatile("s_waitcnt vmcnt(0)" ::: "memory");
    __syncthreads();
    if (threadIdx.x == 0) {
        unsigned* bar = b.bar;
        __builtin_amdgcn_s_waitcnt(0);
        unsigned nloc = b.st[0], nx = b.st[1];
        if (nloc == 0u) { xcd_barrier_complete(bar, b.x, nloc, nx); b.st[0] = nloc; b.st[1] = nx; }
        const unsigned old = xb_add(&bar[XB_XSUB(b.x)], 1u);
        const unsigned gen = old / nloc;
        if (old + 1u == (gen + 1u) * nloc) {
            __builtin_amdgcn_fence(__ATOMIC_RELEASE, "agent");
            asm volatile("s_waitcnt vmcnt(0)" ::: "memory");
            const unsigned og = xb_add(&bar[XB_TOP], 1u);
            const unsigned tg = og / nx;
            if (og + 1u == (tg + 1u) * nx) xb_add(&bar[XB_TOPGEN], 1u);
            else XB_SPIN(xb_ld(&bar[XB_TOPGEN]) == tg, bar);
            __builtin_amdgcn_fence(__ATOMIC_ACQUIRE, "agent");
            xb_add(&bar[XB_XGEN(b.x)], 1u);
            asm volatile("s_waitcnt vmcnt(0)" ::: "memory");
        } else {
            XB_SPIN(xb_ld(&bar[XB_XGEN(b.x)]) == gen, bar);
            __builtin_amdgcn_fence(__ATOMIC_ACQUIRE, "agent");
            asm volatile("s_waitcnt vmcnt(0)" ::: "memory");
        }
    }
    __syncthreads();
}

struct Args { const void* in[46]; float* out; unsigned char* ws; int ph_lo, ph_hi; };
enum { I_X = 0, I_C, I_POS, I_ADAW, I_ADAB, I_NMG, I_NFG, I_WIN, I_WOUT, I_S5LR, I_S5LI, I_S5LS, I_S5BR, I_S5BI, I_S5CR, I_S5CI, I_S5D, I_S5GW, I_S5GB,
       I_RWMU, I_RWW0, I_RWW2, I_RWA0, I_RWA2, I_RWG2, I_RWKK, I_RWKA, I_RWRK, I_RWLG, I_RWLB, I_RWV0, I_RWV1, I_RWV2,
       I_MQG, I_MKVG, I_MWQ, I_MWKV, I_RTW, I_RTB, I_EWG, I_EBG, I_EWU, I_EBU, I_EWD, I_EBD, I_FNG };
#define FIN(k) ((const float*)a.in[k])
__constant__ float ROPE_INV[16] = {1.000000000e+00f, 5.623413324e-01f, 3.162277639e-01f, 1.778279394e-01f, 1.000000015e-01f, 5.623413250e-02f, 3.162277490e-02f, 1.778279431e-02f,
                                   9.999999776e-03f, 5.623413250e-03f, 3.162277630e-03f, 1.778279431e-03f, 1.000000047e-03f, 5.623413017e-04f, 3.162277571e-04f, 1.778279402e-04f};
#define LDS_BARRIER() asm volatile("s_waitcnt lgkmcnt(0)\n\ts_barrier" ::: "memory")
#define LDS_WAIT() asm volatile("s_waitcnt lgkmcnt(0)" ::: "memory")

__device__ __forceinline__ void transpose_item_fp8(const float* W, int N, unsigned char* WT, int ldo, int k0, int n0, int drow0, LAS float* scr, int lane) {
#pragma unroll 8
    for (int i = 0; i < 32; ++i) { const int kk = 2 * i + (lane >> 5); scr[kk * 33 + (lane & 31)] = W[(size_t)(k0 + kk) * N + n0 + (lane & 31)]; }
    LDS_WAIT();
    const int c = lane & 7;
#pragma unroll
    for (int j = 0; j < 4; ++j) { const int n = (lane >> 3) + 8 * j; const LAS float* sp = scr + (8 * c) * 33 + n;
        u32x2 o; o.x = pk4_fp8(sp[0 * 33] * 32.f, sp[1 * 33] * 32.f, sp[2 * 33] * 32.f, sp[3 * 33] * 32.f); o.y = pk4_fp8(sp[4 * 33] * 32.f, sp[5 * 33] * 32.f, sp[6 * 33] * 32.f, sp[7 * 33] * 32.f);
        *(u32x2*)(WT + (size_t)(drow0 + n) * ldo + k0 + 8 * c) = o; }
    LDS_WAIT();
}
__device__ __forceinline__ void s5_lambda_bar(const Args& a, int l, int g, int p, float& lbr, float& lbi, float& fre, float& fim) {
    const float dt = __expf(FIN(I_S5LS)[l * 16 + g]);
    const float lr = FIN(I_S5LR)[(l * 16 + g) * 64 + p], li = FIN(I_S5LI)[(l * 16 + g) * 64 + p];
    const float mag = __expf(lr * dt);
    const float ang = li * dt;
    double x = (double)ang * 0.15915494309189535; x -= __builtin_rint(x);
    const float fr = (float)x;
    lbr = mag * __builtin_amdgcn_cosf(fr); lbi = mag * __builtin_amdgcn_sinf(fr);
    const float den = lr * lr + li * li, nre = lbr - 1.0f;
    fre = (nre * lr + lbi * li) / den; fim = (lbi * lr - nre * li) / den;
}
__device__ __forceinline__ void phase_init(const Args& a, LAS unsigned char* lds, int tid, int G) {
    LAS float* sc = (LAS float*)lds;
    const float* c = FIN(I_C);
    for (int i = tid; i < 8192; i += NTHR) { const float v = c[i]; sc[i] = v / (1.0f + __expf(-v)); }
    __syncthreads();
    float* MOD = (float*)(a.ws + WS_MOD);
    {
        LAS float* red = (LAS float*)(lds + 65536);
        const bool wide = (G >= 256);
        int item0 = (int)blockIdx.x; if (wide) item0 = (int)blockIdx.x < 64 ? (int)blockIdx.x : ((int)blockIdx.x >= 128 ? (int)blockIdx.x - 64 : 1 << 20);
        for (int item = item0; item < 192; item += (wide ? (1 << 20) : G)) {
            const int l = item / 48, cl = tid & 127, kq = tid >> 7, col = (item % 48) * 128 + cl;
            float acc[8];
#pragma unroll
            for (int b = 0; b < 8; ++b) acc[b] = 0.f;
            const float* w = FIN(I_ADAW) + (size_t)l * 1024 * 6144 + col;
#pragma unroll 8
            for (int k = kq * 256; k < kq * 256 + 256; ++k) { const float wv = w[(size_t)k * 6144];
#pragma unroll
                for (int b = 0; b < 8; ++b) acc[b] += sc[b * 1024 + k] * wv; }
#pragma unroll
            for (int b = 0; b < 8; ++b) red[(kq * 8 + b) * 128 + cl] = acc[b];
            __syncthreads();
            if (kq == 0) {
                const float bias = FIN(I_ADAB)[l * 6144 + col];
#pragma unroll
                for (int b = 0; b < 8; ++b) MOD[(size_t)(l * 8 + b) * 6144 + col] = bias + ((red[b * 128 + cl] + red[(8 + b) * 128 + cl]) + (red[(16 + b) * 128 + cl] + red[(24 + b) * 128 + cl])); }
            __syncthreads();
        }
    }
    {
        float* KD = (float*)(a.ws + WS_KD); int* tab = (int*)(a.ws + WS_S5TAB);
        if (blockIdx.x == 0 && tid < 128) tab[tid] = tid >> 3;
        LAS float* PW = (LAS float*)(lds + 32768);
        LAS float* BBl = PW + 32 * 64 * 2;
        LAS float* CCl = BBl + 64 * 16 * 2;
        for (int lg = (G >= 128 ? (int)blockIdx.x - 64 : (int)blockIdx.x); lg >= 0 && lg < DEPTH * 16; lg += G) {
            const int l = lg >> 4, g = lg & 15;
            __syncthreads();
            for (int i = tid; i < 32 * 64; i += NTHR) { const int p = i & 63, d = i >> 6;
                const float dt = __expf(FIN(I_S5LS)[l * 16 + g]), lr = FIN(I_S5LR)[(l * 16 + g) * 64 + p], li = FIN(I_S5LI)[(l * 16 + g) * 64 + p];
                const float mag = __expf((float)d * lr * dt); double x = (double)((float)d * (li * dt)) * 0.15915494309189535; x -= __builtin_rint(x);
                PW[i * 2] = mag * __builtin_amdgcn_cosf((float)x); PW[i * 2 + 1] = mag * __builtin_amdgcn_sinf((float)x); }
            for (int i = tid; i < 64 * 16; i += NTHR) { const int hq = i & 15, p = i >> 4; float lbr, lbi, fre, fim; s5_lambda_bar(a, l, g, p, lbr, lbi, fre, fim);
                const float bre = FIN(I_S5BR)[(((size_t)l * 16 + g) * 64 + p) * 16 + hq], bim = FIN(I_S5BI)[(((size_t)l * 16 + g) * 64 + p) * 16 + hq];
                BBl[i * 2] = fre * bre - fim * bim; BBl[i * 2 + 1] = fre * bim + fim * bre;
                const int hp = i >> 6, pp = i & 63;
                CCl[i * 2] = FIN(I_S5CR)[(((size_t)l * 16 + g) * 16 + hp) * 64 + pp]; CCl[i * 2 + 1] = FIN(I_S5CI)[(((size_t)l * 16 + g) * 16 + hp) * 64 + pp]; }
            __syncthreads();
            for (int i = tid; i < 32 * 256; i += NTHR) { const int hk = i & 255, d = i >> 8, hp = hk >> 4, hq = hk & 15; float acc = 0.f;
                for (int p = 0; p < 64; ++p) { const float pr = PW[(d * 64 + p) * 2], pi_ = PW[(d * 64 + p) * 2 + 1], bbr = BBl[(p * 16 + hq) * 2], bbi = BBl[(p * 16 + hq) * 2 + 1];
                    const float cr = CCl[(hp * 64 + p) * 2], ci = CCl[(hp * 64 + p) * 2 + 1];
                    const float tr = pr * bbr - pi_ * bbi, ti = pr * bbi + pi_ * bbr; acc += cr * tr - ci * ti; }
                KD[((size_t)lg * 32 + d) * 256 + hk] = acc; }
        }
        __syncthreads();
    }
    float* rope = (float*)(a.ws + WS_ROPE);
    const int* pos = (const int*)a.in[I_POS];
    for (int idx = blockIdx.x * NTHR + tid; idx < T * 16; idx += G * NTHR) {
        const int t = idx >> 4, i = idx & 15;
        const float ang = (float)pos[t] * ROPE_INV[i];
        double x = (double)ang * 0.15915494309189535; x -= __builtin_rint(x);
        const float fr = (float)x;
        rope[(size_t)idx * 2] = __builtin_amdgcn_cosf(fr); rope[(size_t)idx * 2 + 1] = __builtin_amdgcn_sinf(fr);
    }
    __syncthreads();
}

__device__ __forceinline__ void transpose_item(const float* W, int N, bf16_t* WT, int ldo, int k0, int n0, int drow0, LAS float* scr, int lane) {
#pragma unroll 8
    for (int i = 0; i < 32; ++i) { const int kk = 2 * i + (lane >> 5); scr[kk * 33 + (lane & 31)] = W[(size_t)(k0 + kk) * N + n0 + (lane & 31)]; }
    LDS_WAIT();
    const int c = lane & 7;
#pragma unroll
    for (int j = 0; j < 4; ++j) { const int n = (lane >> 3) + 8 * j; const LAS float* s = scr + (8 * c) * 33 + n;
        u32x4 o; o.x = pk2(s[0 * 33], s[1 * 33]); o.y = pk2(s[2 * 33], s[3 * 33]); o.z = pk2(s[4 * 33], s[5 * 33]); o.w = pk2(s[6 * 33], s[7 * 33]);
        *(u32x4*)(WT + (size_t)(drow0 + n) * ldo + k0 + 8 * c) = o; }
    LDS_WAIT();
}
__device__ __forceinline__ void conv_expert_item(const Args& a, int l, int bi, LAS float* scr, int wave, int lane) {
    unsigned char* WGU = a.ws + WS_WGU; unsigned char* WDN = a.ws + WS_WDN;
    for (int k = 0; k < 12; ++k) {
        const int r = bi * 96 + k * 8 + wave;
        const int e = r / 1536, mm = (r % 1536) / 512, q = r % 512, kb = q / 32, nb = q % 32, n0 = 32 * nb;
        const size_t eoff = ((size_t)l * 32 + e) * 1024 * 1024;
        if (mm == 0) transpose_item_fp8(FIN(I_EWG) + eoff, 1024, WGU + (size_t)e * 2048 * 1024, 1024, 64 * kb, n0, (n0 >> 7) * 256 + (n0 & 127), scr, lane);
        else if (mm == 1) transpose_item_fp8(FIN(I_EWU) + eoff, 1024, WGU + (size_t)e * 2048 * 1024, 1024, 64 * kb, n0, (n0 >> 7) * 256 + 128 + (n0 & 127), scr, lane);
        else transpose_item_fp8(FIN(I_EWD) + eoff, 1024, WDN + (size_t)e * 1024 * 1024, 1024, 64 * kb, n0, n0, scr, lane);
    }
}
template <int PART> __device__ __forceinline__ void phase_conv(const Args& a, int l, LAS unsigned char* lds, int tid, int wave, int lane, int G) {
    LAS float* scr = (LAS float*)(lds + wave * 8704);
    const int gw = blockIdx.x * NWAVES + wave, NGW = G * NWAVES;
    bf16_t* WIN = (bf16_t*)(a.ws + WS_WIN); bf16_t* WOUT = (bf16_t*)(a.ws + WS_WOUT); bf16_t* WGU = (bf16_t*)(a.ws + WS_WGU); bf16_t* WDN = (bf16_t*)(a.ws + WS_WDN);
    constexpr int I_A = 16 * 77, I_Z = 96, I_O = 512, I_E = 32 * 1536;
    for (int it = (PART == 0 ? gw : gw + I_A + I_Z + I_O); it < (PART == 0 ? I_A + I_Z + I_O : I_A + I_Z + I_O + I_E); it += NGW) {
        int r = it;
        if (r < I_A) { const int kb = r / 77, nb = r % 77; transpose_item(FIN(I_WIN) + (size_t)l * 1024 * INW, INW, WIN, 1024, 64 * kb, 32 * nb, 32 * nb, scr, lane); continue; } r -= I_A;
        if (r < I_Z) { u32x4 z = zero4(); u32x4* d = (u32x4*)(WIN + (size_t)(INW + r) * 1024);
#pragma unroll
            for (int j = 0; j < 2; ++j) d[j * 64 + lane] = z; continue; } r -= I_Z;
        if (r < I_O) { const int kb = r / 32, nb = r % 32; transpose_item(FIN(I_WOUT) + (size_t)l * 1024 * 1024, 1024, WOUT, 1024, 64 * kb, 32 * nb, 32 * nb, scr, lane); continue; } r -= I_O;
        const int e = r / 1536, mm = (r % 1536) / 512, q = r % 512, kb = q / 32, nb = q % 32, n0 = 32 * nb;
        const size_t eoff = ((size_t)l * 32 + e) * 1024 * 1024;
        if (mm == 0) transpose_item(FIN(I_EWG) + eoff, 1024, WGU + (size_t)e * 2048 * 1024, 1024, 64 * kb, n0, (n0 >> 7) * 256 + (n0 & 127), scr, lane);
        else if (mm == 1) transpose_item(FIN(I_EWU) + eoff, 1024, WGU + (size_t)e * 2048 * 1024, 1024, 64 * kb, n0, (n0 >> 7) * 256 + 128 + (n0 & 127), scr, lane);
        else transpose_item(FIN(I_EWD) + eoff, 1024, WDN + (size_t)e * 1024 * 1024, 1024, 64 * kb, n0, n0, scr, lane);
    }
    if (PART == 1) return;
    bf16_t* SM = (bf16_t*)(a.ws + WS_WSM);
    const int gt = blockIdx.x * NTHR + tid, NGT = G * NTHR;
    for (int i = gt; i < 512 * 256; i += NGT) { const int n = i >> 8, k = i & 255;
        const float vq = n < 384 ? FIN(I_MQG)[l * 256 + k] * FIN(I_MWQ)[((size_t)l * 256 + k) * 384 + n] : 0.f;
        const float vk = k < 128 ? FIN(I_MKVG)[l * 128 + k] * FIN(I_MWKV)[((size_t)l * 128 + k) * 512 + n] : 0.f;
        SM[SM_WQ / 2 + i] = (bf16_t)f2bf(vq); SM[SM_WKV / 2 + i] = (bf16_t)f2bf(vk); }
    for (int i = gt; i < 768 * 256; i += NGT) { const int n = i >> 8, k = i & 255; float v = 0.f;
        if (n < 256) { if (k < 64) v = FIN(I_RWW2)[((size_t)l * 64 + k) * 256 + n]; }
        else if (n < 512) { if (k >= 64 && k < 128) v = FIN(I_RWA2)[((size_t)l * 64 + (k - 64)) * 256 + (n - 256)]; }
        else { if (k >= 128) v = FIN(I_RWG2)[((size_t)l * 128 + (k - 128)) * 256 + (n - 512)]; }
        SM[SM_WLORA / 2 + i] = (bf16_t)f2bf(v); }
    for (int i = gt; i < 256 * 256; i += NGT) { const int n = i >> 8, k = i & 255; float v = 0.f;
        if (l > 0) { const float* v1 = FIN(I_RWV1) + (size_t)(l - 1) * 256 * 32 + k * 32; const float* v2 = FIN(I_RWV2) + (size_t)(l - 1) * 32 * 256 + n;
#pragma unroll 8
            for (int m = 0; m < 32; ++m) v += v1[m] * v2[m * 256]; }
        SM[SM_WVV / 2 + i] = (bf16_t)f2bf(v);
        SM[SM_WGLU / 2 + i] = (bf16_t)f2bf(FIN(I_S5GW)[((size_t)l * 256 + k) * 256 + n]); }
    {
        bf16_t* WE = (bf16_t*)(a.ws + R_WE); bf16_t* WY = (bf16_t*)(a.ws + R_WY); const float* KD = (const float*)(a.ws + WS_KD) + (size_t)l * 16 * 32 * 256;
        for (int i0 = gt; i0 < 16 * 256 * 512; i0 += 4 * NGT) { float v4[4];
#pragma unroll
          for (int u = 0; u < 4; ++u) { const int i = i0 + u * NGT; const int k = i & 511, q = (i >> 9) & 255, g = i >> 17; float v = 0.f;
            if (q < 128 && i < 16 * 256 * 512) { const int p = q & 63, tau = k >> 4, h = k & 15; float lbr, lbi, fre, fim; s5_lambda_bar(a, l, g, p, lbr, lbi, fre, fim);
                const float bre = FIN(I_S5BR)[(((size_t)l * 16 + g) * 64 + p) * 16 + h], bim = FIN(I_S5BI)[(((size_t)l * 16 + g) * 64 + p) * 16 + h];
                const float bbr = fre * bre - fim * bim, bbi = fre * bim + fim * bre;
                const float dt = __expf(FIN(I_S5LS)[l * 16 + g]), lr = FIN(I_S5LR)[(l * 16 + g) * 64 + p], li = FIN(I_S5LI)[(l * 16 + g) * 64 + p]; const float d = (float)(31 - tau);
                const float mag = __expf(d * lr * dt); double x = (double)(d * (li * dt)) * 0.15915494309189535; x -= __builtin_rint(x);
                const float pr = mag * __builtin_amdgcn_cosf((float)x), pi_ = mag * __builtin_amdgcn_sinf((float)x);
                v = (q < 64) ? (pr * bbr - pi_ * bbi) : (pr * bbi + pi_ * bbr); }
            v4[u] = v; }
#pragma unroll
          for (int u = 0; u < 4; ++u) if (i0 + u * NGT < 16 * 256 * 512) WE[i0 + u * NGT] = (bf16_t)f2bf(v4[u]); }
        for (int i0 = gt; i0 < 16 * 512 * 768; i0 += 4 * NGT) { float v4[4];
#pragma unroll
          for (int u = 0; u < 4; ++u) { const int i = i0 + u * NGT; const int k = i % 768, n = (i / 768) & 511, g = i / (768 * 512), tau = n >> 4, hp = n & 15; float v = 0.f;
            if (i >= 16 * 512 * 768) { } else if (k < 512) { const int j = k >> 4, h = k & 15; if (j <= tau) v = KD[((g * 32 + (tau - j)) * 16 + hp) * 16 + h]; }
            else if (k < 640) { const int q = k - 512, p = q & 63;
                const float dt = __expf(FIN(I_S5LS)[l * 16 + g]), lr = FIN(I_S5LR)[(l * 16 + g) * 64 + p], li = FIN(I_S5LI)[(l * 16 + g) * 64 + p]; const float d = (float)(tau + 1);
                const float mag = __expf(d * lr * dt); double x = (double)(d * (li * dt)) * 0.15915494309189535; x -= __builtin_rint(x);
                const float pr = mag * __builtin_amdgcn_cosf((float)x), pi_ = mag * __builtin_amdgcn_sinf((float)x);
                const float cr = FIN(I_S5CR)[(((size_t)l * 16 + g) * 16 + hp) * 64 + p], ci = FIN(I_S5CI)[(((size_t)l * 16 + g) * 16 + hp) * 64 + p];
                v = (q < 64) ? (cr * pr - ci * pi_) : -(cr * pi_ + ci * pr); }
            v4[u] = v; }
#pragma unroll
          for (int u = 0; u < 4; ++u) if (i0 + u * NGT < 16 * 512 * 768) WY[i0 + u * NGT] = (bf16_t)f2bf(v4[u]); }
    }
}

template <int MODE>
__device__ __forceinline__ void phase_norm1(const Args& a, int l, int wave, int lane, int G, bool own = false) {
    const int gw = blockIdx.x * NWAVES + wave, NGW = G * NWAVES;
    const int m0 = own ? (int)blockIdx.x * 256 + wave : gw, ms = own ? NWAVES : NGW, mend = own ? (int)blockIdx.x * 256 + 256 : T;
    const float* MOD = (const float*)(a.ws + WS_MOD);
    const int* pos = (const int*)(a.ws + MO_POS); const float* tw = (const float*)(a.ws + MO_W);
    const bf16_t* Y = (const bf16_t*)(a.ws + R_Y);
    bf16_t* HN = (bf16_t*)(a.ws + WS_HN);
#pragma unroll 2
    for (int m = m0; m < mend; m += ms) {
        const int b = m >> 13;
        const float* xr = (l == 0 ? FIN(I_X) : a.out) + (size_t)m * D;
        f32x4 v[4];
#pragma unroll
        for (int j = 0; j < 4; ++j) v[j] = ((const f32x4*)xr)[64 * j + lane];
        if (l > 0) {
            f32x4 acc[4];
#pragma unroll
            for (int j = 0; j < 4; ++j) acc[j] = (f32x4){0.f, 0.f, 0.f, 0.f};
#pragma unroll
            for (int k = 0; k < 4; ++k) { const int p = pos[m * 4 + k]; const float w = tw[m * 4 + k]; const u32x2* yr = (const u32x2*)(Y + (size_t)p * 1024);
#pragma unroll
                for (int j = 0; j < 4; ++j) { const u32x2 yy = __builtin_nontemporal_load(yr + 64 * j + lane); acc[j] += w * (f32x4){bflo(yy.x), bfhi(yy.x), bflo(yy.y), bfhi(yy.y)}; } }
            const float* g2 = MOD + (size_t)((l - 1) * 8 + b) * 6144 + 5120;
#pragma unroll
            for (int j = 0; j < 4; ++j) { v[j] += ((const f32x4*)g2)[64 * j + lane] * acc[j]; ((f32x4*)(a.out + (size_t)m * D))[64 * j + lane] = v[j]; }
        }
        float ss = 0.f;
#pragma unroll
        for (int j = 0; j < 4; ++j) ss += (v[j].x * v[j].x + v[j].y * v[j].y) + (v[j].z * v[j].z + v[j].w * v[j].w);
        ss = wave_sum(ss);
        const float rstd = __builtin_amdgcn_rsqf(ss * (1.0f / D) + NORM_EPS);
        if (MODE == 0) {
            const float* gn = FIN(I_NMG) + l * D; const float* sh = MOD + (size_t)(l * 8 + b) * 6144; const float* sc = sh + 1024;
            u32x2* o = (u32x2*)(HN + (size_t)m * D);
#pragma unroll
            for (int j = 0; j < 4; ++j) { const f32x4 g = ((const f32x4*)gn)[64 * j + lane], s1 = ((const f32x4*)sc)[64 * j + lane], s0 = ((const f32x4*)sh)[64 * j + lane];
                const f32x4 h = v[j] * rstd * g * (1.0f + s1) + s0; u32x2 w; w.x = pk2(h.x, h.y); w.y = pk2(h.z, h.w); o[64 * j + lane] = w; }
        } else {
            const float* gn = FIN(I_FNG);
#pragma unroll
            for (int j = 0; j < 4; ++j) { const f32x4 g = ((const f32x4*)gn)[64 * j + lane]; ((f32x4*)(a.out + (size_t)m * D))[64 * j + lane] = v[j] * rstd * g; }
        }
    }
}

__device__ __forceinline__ void phase_pre(const Args& a, int l, int tid, int G) {
    const bf16_t* PROJ = (const bf16_t*)(a.ws + R_PROJ); bf16_t* AP = (bf16_t*)(a.ws + R_AP);
    const float* mu = FIN(I_RWMU) + l * 1024;
    const int stride = G * NTHR;
    float muv[8];
    { const int ch0 = tid & 63, mi0 = ch0 < 32 ? (768 + ch0 * 8) : (512 + (ch0 - 32) * 8);
#pragma unroll
      for (int j = 0; j < 8; ++j) muv[j] = mu[mi0 + j]; }
    for (int idx0 = blockIdx.x * NTHR + tid; idx0 < T * 64; idx0 += 4 * stride) {
        u32x4 cu[4], pv[4];
#pragma unroll
        for (int u = 0; u < 4; ++u) { const int idx = idx0 + u * stride; cu[u] = zero4(); pv[u] = zero4();
            if (idx < T * 64) { const int t = idx >> 6, ch = idx & 63; const int pc = ch < 32 ? (C_RWWD + ch * 8) : (C_RWV + (ch - 32) * 8);
                cu[u] = *(const u32x4*)(PROJ + (size_t)t * INWP + pc); if ((t & (SEQ - 1)) != 0) pv[u] = *(const u32x4*)(PROJ + (size_t)(t - 1) * INWP + pc); } }
#pragma unroll
        for (int u = 0; u < 4; ++u) { const int idx = idx0 + u * stride; if (idx >= T * 64) break;
            const int t = idx >> 6, ch = idx & 63;
            const unsigned cw[4] = {cu[u].x, cu[u].y, cu[u].z, cu[u].w}, pw[4] = {pv[u].x, pv[u].y, pv[u].z, pv[u].w};
            float o[8];
#pragma unroll
            for (int j = 0; j < 8; ++j) { const float c = (j & 1) ? bfhi(cw[j >> 1]) : bflo(cw[j >> 1]), p = (j & 1) ? bfhi(pw[j >> 1]) : bflo(pw[j >> 1]);
                float x = c + (p - c) * muv[j];
                if (ch < 8) x = 1.0f - 2.0f * __builtin_amdgcn_rcpf(1.0f + __expf(2.0f * x)); else if (ch >= 16 && ch < 32) x = sigmoidf_(x);
                o[j] = x; }
            u32x4 w; w.x = pk2(o[0], o[1]); w.y = pk2(o[2], o[3]); w.z = pk2(o[4], o[5]); w.w = pk2(o[6], o[7]);
            *(u32x4*)(AP + (size_t)t * 512 + ch * 8) = w;
        }
    }
}

constexpr float QSCALE = 0.14724444602590306f;
__device__ __forceinline__ void mla_finish(const Args& a, LAS unsigned char* lds, int tid, int G) {
    const bf16_t* PROJ = (const bf16_t*)(a.ws + R_PROJ); const bf16_t* RAW = (const bf16_t*)(a.ws + R_QKV);
    bf16_t* QB = (bf16_t*)(a.ws + R_QB); unsigned char* KT = a.ws + R_KT; unsigned char* VT = a.ws + R_VT;
    const float* rope = (const float*)(a.ws + WS_ROPE);
    LAS float* rs = (LAS float*)lds;
    for (int tile = blockIdx.x; tile < T / 64; tile += G) {
        const int t0 = tile * 64, b = t0 >> 13, tidx = (t0 & (SEQ - 1)) >> 6;
        {
            const int tk = tid >> 3, part = tid & 7; const bf16_t* pr = PROJ + (size_t)(t0 + tk) * INWP;
            float sq = 0.f, sk = 0.f;
#pragma unroll
            for (int i = 0; i < 4; ++i) { const u32x4 w = *(const u32x4*)(pr + C_QC + part * 32 + i * 8); const unsigned ww[4] = {w.x, w.y, w.z, w.w};
#pragma unroll
                for (int j = 0; j < 4; ++j) { const float x0 = bflo(ww[j]), x1 = bfhi(ww[j]); sq += x0 * x0 + x1 * x1; } }
#pragma unroll
            for (int i = 0; i < 2; ++i) { const u32x4 w = *(const u32x4*)(pr + C_KVC + part * 16 + i * 8); const unsigned ww[4] = {w.x, w.y, w.z, w.w};
#pragma unroll
                for (int j = 0; j < 4; ++j) { const float x0 = bflo(ww[j]), x1 = bfhi(ww[j]); sk += x0 * x0 + x1 * x1; } }
            sq += __shfl_xor(sq, 1); sq += __shfl_xor(sq, 2); sq += __shfl_xor(sq, 4);
            sk += __shfl_xor(sk, 1); sk += __shfl_xor(sk, 2); sk += __shfl_xor(sk, 4);
            if (part == 0) { rs[tk * 2] = __builtin_amdgcn_rsqf(sq * (1.0f / 256.0f) + NORM_EPS); rs[tk * 2 + 1] = __builtin_amdgcn_rsqf(sk * (1.0f / 128.0f) + NORM_EPS); }
        }
        __syncthreads();
#pragma nounroll
        for (int c0 = 0; c0 < 6; c0 += 3) {
            asm volatile("" ::: "memory");
            u32x4 w_[3], wp_[3]; f32x4 rp_[3][4];
#pragma unroll
            for (int u = 0; u < 3; ++u) { const int ci = tid + (c0 + u) * NTHR; const int tk = ci / 48, rem = ci % 48, h = rem / 12, c = rem % 12; const size_t t = (size_t)t0 + tk;
                w_[u] = *(const u32x4*)(RAW + t * 1024 + h * 96 + c * 8); wp_[u] = zero4();
#pragma unroll
                for (int q = 0; q < 4; ++q) rp_[u][q] = (f32x4){0.f, 0.f, 0.f, 0.f};
                if (c >= 8) { const int cp = (c < 10) ? c + 2 : c - 2; wp_[u] = *(const u32x4*)(RAW + t * 1024 + h * 96 + cp * 8); const f32x4* rr = (const f32x4*)(rope + (t * 16 + ((c - 8) & 1) * 8) * 2);
#pragma unroll
                    for (int q = 0; q < 4; ++q) rp_[u][q] = rr[q]; } }
#pragma unroll
            for (int u = 0; u < 3; ++u) { const int ci = tid + (c0 + u) * NTHR; const int tk = ci / 48, rem = ci % 48, h = rem / 12, c = rem % 12; const size_t t = (size_t)t0 + tk;
                const float sc = rs[tk * 2] * QSCALE;
                const unsigned ww[4] = {w_[u].x, w_[u].y, w_[u].z, w_[u].w}, pp[4] = {wp_[u].x, wp_[u].y, wp_[u].z, wp_[u].w};
                float o[8];
#pragma unroll
                for (int j = 0; j < 8; ++j) { const float xo = (j & 1) ? bfhi(ww[j >> 1]) : bflo(ww[j >> 1]), xp = (j & 1) ? bfhi(pp[j >> 1]) : bflo(pp[j >> 1]);
                    const float cs = rp_[u][j >> 1][(j & 1) * 2], sn = rp_[u][j >> 1][(j & 1) * 2 + 1];
                    o[j] = (c < 8) ? xo * sc : ((c < 10) ? (xo * cs - xp * sn) : (xp * sn + xo * cs)) * sc; }
                u32x4 ow; ow.x = pk2(o[0], o[1]); ow.y = pk2(o[2], o[3]); ow.z = pk2(o[4], o[5]); ow.w = pk2(o[6], o[7]);
                *(u32x4*)(QB + t * 384 + h * 96 + c * 8) = ow; }
        }
#pragma nounroll
        for (int c0 = 0; c0 < 6; c0 += 3) {
            asm volatile("" ::: "memory");
            u32x4 w_[3], wp_[3]; f32x4 rp_[3][4];
#pragma unroll
            for (int u = 0; u < 3; ++u) { const int ci = tid + (c0 + u) * NTHR; const int h = ci / 768, rem = ci % 768, c = rem >> 6, key = rem & 63; const size_t t = (size_t)t0 + key;
                wp_[u] = zero4();
#pragma unroll
                for (int q = 0; q < 4; ++q) rp_[u][q] = (f32x4){0.f, 0.f, 0.f, 0.f};
                if (c < 8) w_[u] = *(const u32x4*)(RAW + t * 1024 + 512 + h * 128 + c * 8);
                else { const int cp = (c < 10) ? c + 2 : c - 2; w_[u] = *(const u32x4*)(PROJ + t * INWP + C_KPE + (c - 8) * 8); wp_[u] = *(const u32x4*)(PROJ + t * INWP + C_KPE + (cp - 8) * 8);
                    const f32x4* rr = (const f32x4*)(rope + (t * 16 + ((c - 8) & 1) * 8) * 2);
#pragma unroll
                    for (int q = 0; q < 4; ++q) rp_[u][q] = rr[q]; } }
#pragma unroll
            for (int u = 0; u < 3; ++u) { const int ci = tid + (c0 + u) * NTHR; const int h = ci / 768, rem = ci % 768, c = rem >> 6, key = rem & 63;
                const float sc = rs[key * 2 + 1];
                const unsigned ww[4] = {w_[u].x, w_[u].y, w_[u].z, w_[u].w}, pp[4] = {wp_[u].x, wp_[u].y, wp_[u].z, wp_[u].w};
                float o[8];
#pragma unroll
                for (int j = 0; j < 8; ++j) { const float xo = (j & 1) ? bfhi(ww[j >> 1]) : bflo(ww[j >> 1]), xp = (j & 1) ? bfhi(pp[j >> 1]) : bflo(pp[j >> 1]);
                    const float cs = rp_[u][j >> 1][(j & 1) * 2], sn = rp_[u][j >> 1][(j & 1) * 2 + 1];
                    o[j] = (c < 8) ? xo * sc : ((c < 10) ? (xo * cs - xp * sn) : (xp * sn + xo * cs)); }
                u32x4 ow; ow.x = pk2(o[0], o[1]); ow.y = pk2(o[2], o[3]); ow.z = pk2(o[4], o[5]); ow.w = pk2(o[6], o[7]);
                *(u32x4*)(KT + ((size_t)((b * 4 + h) * 128 + tidx)) * 12288 + (size_t)(c * 64 + key) * 16) = ow; }
        }
        {
            asm volatile("" ::: "memory");
            unsigned rv[4][8];
#pragma unroll
            for (int u = 0; u < 4; ++u) { const int ci = tid + u * NTHR; const int h = ci >> 9, rem = ci & 511, kh = rem >> 6, dv = rem & 63, ks = kh >> 1, hh = kh & 1;
#pragma unroll
                for (int j = 0; j < 8; ++j) { const int key = 16 * ks + 8 * (j >> 2) + 4 * hh + (j & 3); rv[u][j] = RAW[((size_t)t0 + key) * 1024 + 512 + h * 128 + 64 + dv]; } }
#pragma unroll
            for (int u = 0; u < 4; ++u) { const int ci = tid + u * NTHR; const int h = ci >> 9, rem = ci & 511, kh = rem >> 6, dv = rem & 63, ks = kh >> 1, hh = kh & 1;
                float o[8];
#pragma unroll
                for (int j = 0; j < 8; ++j) { const int key = 16 * ks + 8 * (j >> 2) + 4 * hh + (j & 3); o[j] = bf2f(rv[u][j]) * rs[key * 2 + 1]; }
                u32x4 ow; ow.x = pk2(o[0], o[1]); ow.y = pk2(o[2], o[3]); ow.z = pk2(o[4], o[5]); ow.w = pk2(o[6], o[7]);
                *(u32x4*)(VT + ((size_t)((b * 4 + h) * 128 + tidx)) * 8192 + (size_t)(kh * 64 + dv) * 16) = ow; }
        }
        __syncthreads();
    }
}
__device__ __forceinline__ void rwkv_finish(const Args& a, int l, int wave, int lane, int G) {
    const bf16_t* PROJ = (const bf16_t*)(a.ws + R_PROJ); const bf16_t* LO = (const bf16_t*)(a.ws + R_LO);
    float* SI = (float*)(a.ws + R_SI); float* VF = (float*)(a.ws + WS_VF);
    const float* mu = FIN(I_RWMU) + l * 1024;
    const int h = wave & 3, j = h * 64 + lane;
    const float mur = mu[j], muk = mu[256 + j], muv = mu[512 + j];
    const float w0 = FIN(I_RWW0)[l * 256 + j], a0 = FIN(I_RWA0)[l * 256 + j], kkp = FIN(I_RWKK)[l * 256 + j], kap = FIN(I_RWKA)[l * 256 + j];
    const float v0 = l > 0 ? FIN(I_RWV0)[(l - 1) * 256 + j] : 0.f;
#pragma unroll 4
    for (int tp = blockIdx.x; tp < T / 2; tp += G) {
        const size_t t = (size_t)tp * 2 + (wave >> 2); const bool first = (t & (SEQ - 1)) == 0;
        const bf16_t* pc = PROJ + t * INWP; const bf16_t* pp = pc - INWP;
        float r = bf2f(pc[C_RWR + j]), k = bf2f(pc[C_RWK + j]), v = bf2f(pc[C_RWV + j]);
        const float rp = first ? 0.f : bf2f(pp[C_RWR + j]), kp = first ? 0.f : bf2f(pp[C_RWK + j]), vp = first ? 0.f : bf2f(pp[C_RWV + j]);
        r += (rp - r) * mur; k += (kp - k) * muk; v += (vp - v) * muv;
        const float wl = w0 + bf2f(LO[t * 1024 + j]);
        const float sp = log1pf(__expf(-wl));
        const float wraw = -sp - 0.5f;
        const float decay = __expf(-__expf(wraw));
        const float aa = sigmoidf_(a0 + bf2f(LO[t * 1024 + 256 + j]));
        if (l > 0) { const float vf = VF[t * 256 + j]; v += (vf - v) * sigmoidf_(v0 + bf2f(LO[t * 1024 + 768 + j])); }
        else VF[t * 256 + j] = v;
        const float kk0 = k * kkp;
        const float nrm = sqrtf(wave_sum(kk0 * kk0));
        const float kk = kk0 / fmaxf(nrm, 1e-12f);
        const float k2 = k * (1.0f + (aa - 1.0f) * kap);
        float* o = SI + (t * 4 + h) * 384;
        o[lane] = r; o[64 + lane] = decay; o[128 + lane] = k2; o[192 + lane] = kk; o[256 + lane] = kk * aa; o[320 + lane] = v;
    }
}
struct S5State { float lbr, lbi; int cre, cim; };
__device__ __forceinline__ S5State s5_state(const Args& a, int l, int s) { S5State st; const int g = s >> 6, p = s & 63; float fre, fim; s5_lambda_bar(a, l, g, p, st.lbr, st.lbi, fre, fim); st.cre = g * 128 + p; st.cim = st.cre + 64; return st; }
__device__ __forceinline__ void s5_repack(const Args& a, int tid, int G) {
    const bf16_t* PROJ = (const bf16_t*)(a.ws + R_PROJ); bf16_t* UP = (bf16_t*)(a.ws + R_UP);
    for (int i = blockIdx.x * NTHR + tid; i < T * 32; i += G * NTHR) { const int p8 = i & 31, t = i >> 5, g = p8 >> 1, h0 = (p8 & 1) * 8;
        *(u32x4*)(UP + ((size_t)g * 2048 + (t >> 5)) * 768 + (t & 31) * 16 + h0) = *(const u32x4*)(PROJ + (size_t)t * INWP + C_S5 + p8 * 8); }
    for (int i = blockIdx.x * NTHR + tid; i < 16 * 2048 * 16; i += G * NTHR) { const int r = i >> 4, c8 = i & 15; *(u32x4*)(UP + (size_t)r * 768 + 640 + c8 * 8) = zero4(); }
}
__device__ __forceinline__ void s5_chunk_scan(const Args& a, int l, int tid, int G) {
    bf16_t* UP = (bf16_t*)(a.ws + R_UP); const float* EB = (const float*)(a.ws + R_EB);
    if (tid < 64)
    for (int i = blockIdx.x * 64 + tid; i < NB * 16 * 64; i += G * 64) { const int p = i & 63, g = (i >> 6) & 15, b = i >> 10;
        float lbr, lbi, fre, fim; s5_lambda_bar(a, l, g, p, lbr, lbi, fre, fim);
        float pr = lbr, pi_ = lbi;
#pragma unroll
        for (int k = 0; k < 5; ++k) { const float tr = pr * pr - pi_ * pi_, ti = 2.f * pr * pi_; pr = tr; pi_ = ti; }
        float sr = 0.f, si = 0.f;
        for (int c0 = 0; c0 < 256; c0 += 32) { float er[32], ei[32];
#pragma unroll
            for (int c = 0; c < 32; ++c) { const size_t row = (size_t)g * 2048 + b * 256 + c0 + c; er[c] = EB[row * 128 + p]; ei[c] = EB[row * 128 + 64 + p]; }
#pragma unroll
            for (int c = 0; c < 32; ++c) { const size_t row = (size_t)g * 2048 + b * 256 + c0 + c;
                UP[row * 768 + 512 + p] = (bf16_t)f2bf(sr); UP[row * 768 + 576 + p] = (bf16_t)f2bf(si);
                const float nr = pr * sr - pi_ * si + er[c], ni = pr * si + pi_ * sr + ei[c]; sr = nr; si = ni; }
        }
    }
}
__device__ __forceinline__ void s5_pass_a(const Args& a, int l, int tid, int G) {
    const bf16_t* BU = (const bf16_t*)(a.ws + R_BU); float* E = (float*)(a.ws + R_E);
    const S5State s0 = s5_state(a, l, tid), s1 = s5_state(a, l, tid + 512);
    for (int u = blockIdx.x; u < NB * 64; u += G) {
        const size_t t0 = (size_t)(u >> 6) * SEQ + (size_t)(u & 63) * 128;
        float ar = 0.f, ai = 0.f, br = 0.f, bi = 0.f;
#pragma unroll 4
        for (int tk = 0; tk < 128; ++tk) { const bf16_t* row = BU + (t0 + tk) * 2048;
            const float x0 = bf2f(row[s0.cre]), y0 = bf2f(row[s0.cim]), x1 = bf2f(row[s1.cre]), y1 = bf2f(row[s1.cim]);
            const float nar = s0.lbr * ar - s0.lbi * ai + x0, nai = s0.lbr * ai + s0.lbi * ar + y0; ar = nar; ai = nai;
            const float nbr = s1.lbr * br - s1.lbi * bi + x1, nbi = s1.lbr * bi + s1.lbi * br + y1; br = nbr; bi = nbi; }
        float* e = E + (size_t)u * 2048;
        e[tid * 2] = ar; e[tid * 2 + 1] = ai; e[(tid + 512) * 2] = br; e[(tid + 512) * 2 + 1] = bi;
    }
}
__device__ __forceinline__ void s5_pass_c(const Args& a, int l, int tid, int G) {
    bf16_t* BU = (bf16_t*)(a.ws + R_BU); const float* E = (const float*)(a.ws + R_E);
    const S5State s0 = s5_state(a, l, tid), s1 = s5_state(a, l, tid + 512);
    float p0r = s0.lbr, p0i = s0.lbi, p1r = s1.lbr, p1i = s1.lbi;
#pragma unroll
    for (int i = 0; i < 7; ++i) { const float t0r = p0r * p0r - p0i * p0i, t0i = 2.f * p0r * p0i; p0r = t0r; p0i = t0i; const float t1r = p1r * p1r - p1i * p1i, t1i = 2.f * p1r * p1i; p1r = t1r; p1i = t1i; }
    for (int u = blockIdx.x; u < NB * 64; u += G) {
        const int b = u >> 6, c = u & 63; const size_t t0 = (size_t)b * SEQ + (size_t)c * 128;
        float ar = 0.f, ai = 0.f, br = 0.f, bi = 0.f;
        for (int cc = 0; cc < c; ++cc) { const float* e = E + (size_t)(b * 64 + cc) * 2048;
            const float e0r = e[tid * 2], e0i = e[tid * 2 + 1], e1r = e[(tid + 512) * 2], e1i = e[(tid + 512) * 2 + 1];
            const float nar = p0r * ar - p0i * ai + e0r, nai = p0r * ai + p0i * ar + e0i; ar = nar; ai = nai;
            const float nbr = p1r * br - p1i * bi + e1r, nbi = p1r * bi + p1i * br + e1i; br = nbr; bi = nbi; }
#pragma unroll 4
        for (int tk = 0; tk < 128; ++tk) { bf16_t* row = BU + (t0 + tk) * 2048;
            const float x0 = bf2f(row[s0.cre]), y0 = bf2f(row[s0.cim]), x1 = bf2f(row[s1.cre]), y1 = bf2f(row[s1.cim]);
            const float nar = s0.lbr * ar - s0.lbi * ai + x0, nai = s0.lbr * ai + s0.lbi * ar + y0; ar = nar; ai = nai;
            const float nbr = s1.lbr * br - s1.lbi * bi + x1, nbi = s1.lbr * bi + s1.lbi * br + y1; br = nbr; bi = nbi;
            row[s0.cre] = (bf16_t)f2bf(ar); row[s0.cim] = (bf16_t)f2bf(ai); row[s1.cre] = (bf16_t)f2bf(br); row[s1.cim] = (bf16_t)f2bf(bi); }
    }
}
__device__ __forceinline__ float ret_rope(const bf16_t* PROJ, const float* rope, size_t t, int colbase, int h, int d) {
    const bf16_t* p = PROJ + t * INWP + colbase + h * 32; const int i = d & 15;
    const float x1 = bf2f(p[i]), x2 = bf2f(p[i + 16]); const float cs = rope[(t * 16 + i) * 2], sn = rope[(t * 16 + i) * 2 + 1];
    return d < 16 ? (x1 * cs - x2 * sn) : (x1 * sn + x2 * cs);
}
__device__ __forceinline__ void ret_rope8(const bf16_t* PROJ, const float* rope, size_t t, int colbase, int h, int ch, float (&o)[8]) {
    const bf16_t* p = PROJ + t * INWP + colbase + h * 32;
    const u32x4 wo = *(const u32x4*)(p + 8 * ch), wp = *(const u32x4*)(p + 8 * (ch ^ 2));
    const unsigned ow[4] = {wo.x, wo.y, wo.z, wo.w}, pw[4] = {wp.x, wp.y, wp.z, wp.w};
    const f32x4* cs = (const f32x4*)(rope + (t * 16 + (ch & 1) * 8) * 2);
    const f32x4 c0 = cs[0], c1 = cs[1], c2 = cs[2], c3 = cs[3];
    const float cc[8] = {c0.x, c0.z, c1.x, c1.z, c2.x, c2.z, c3.x, c3.z}, sn[8] = {c0.y, c0.w, c1.y, c1.w, c2.y, c2.w, c3.y, c3.w};
#pragma unroll
    for (int j = 0; j < 8; ++j) { const float xo = (j & 1) ? bfhi(ow[j >> 1]) : bflo(ow[j >> 1]), xp = (j & 1) ? bfhi(pw[j >> 1]) : bflo(pw[j >> 1]);
        o[j] = (ch < 2) ? (xo * cc[j] - xp * sn[j]) : (xp * sn[j] + xo * cc[j]); }
}
__device__ __forceinline__ void ret_stage_vt(const bf16_t* PROJ, LAS bf16_t* VT, size_t t0, int h, int tid) {
    const int m = tid >> 2, eg = tid & 3, ks = m >> 4, w = m & 15, hh = (w >> 2) & 1, j = 4 * (w >> 3) + (w & 3);
    const u32x4 v0 = *(const u32x4*)(PROJ + (t0 + m) * INWP + C_RV + h * 64 + eg * 16), v1 = *(const u32x4*)(PROJ + (t0 + m) * INWP + C_RV + h * 64 + eg * 16 + 8);
    const unsigned vw[8] = {v0.x, v0.y, v0.z, v0.w, v1.x, v1.y, v1.z, v1.w};
    LAS bf16_t* d = VT + ((ks * 2 + hh) * 64 + eg * 16) * 8 + j;
#pragma unroll
    for (int i = 0; i < 16; ++i) d[i * 8] = (bf16_t)((i & 1) ? (vw[i >> 1] >> 16) : (vw[i >> 1] & 0xffffu));
}
__device__ __forceinline__ void ret_pass_a(const Args& a, LAS unsigned char* lds, int tid, int wave, int lane, int G) {
    const bf16_t* PROJ = (const bf16_t*)(a.ws + R_PROJ); const float* rope = (const float*)(a.ws + WS_ROPE); float* CKV = (float*)(a.ws + R_CKV);
    LAS bf16_t* VT = (LAS bf16_t*)lds; LAS bf16_t* KW = (LAS bf16_t*)(lds + 16384);
    const int hh = lane >> 5, l31 = lane & 31;
    for (int u = blockIdx.x; u < NB * 64 * 4; u += G) {
        const int h = u & 3, n = (u >> 2) & 63, b = u >> 8; const size_t t0 = (size_t)b * SEQ + (size_t)n * 128;
        const float lg2 = log2f(1.0f - exp2f(-5.0f - (float)h));
        ret_stage_vt(PROJ, VT, t0, h, tid);
        {
            const int d = tid & 31, kh = tid >> 5, ks = kh >> 1, khh = kh & 1, i = d & 15; float o[8];
#pragma unroll
            for (int j = 0; j < 8; ++j) { const int m = 16 * ks + 8 * (j >> 2) + 4 * khh + (j & 3); const size_t t = t0 + m;
                const bf16_t* p = PROJ + t * INWP + C_RK + h * 32; const float x1 = bf2f(p[i]), x2 = bf2f(p[i + 16]);
                const float cs = rope[(t * 16 + i) * 2], sn = rope[(t * 16 + i) * 2 + 1];
                o[j] = (d < 16 ? (x1 * cs - x2 * sn) : (x1 * sn + x2 * cs)) * 0.17677669529663687f * exp2f((float)(127 - m) * lg2); }
            u32x4 w; w.x = pk2(o[0], o[1]); w.y = pk2(o[2], o[3]); w.z = pk2(o[4], o[5]); w.w = pk2(o[6], o[7]);
            *(LAS u32x4*)(KW + (kh * 32 + d) * 8) = w;
        }
        __syncthreads();
        if (wave < 2) {
            f32x16 acc;
#pragma unroll
            for (int r = 0; r < 16; ++r) acc[r] = 0.f;
#pragma unroll
            for (int ks = 0; ks < 8; ++ks) {
                const bf16x8 va = *(const LAS bf16x8*)(VT + ((ks * 2 + hh) * 64 + 32 * wave + l31) * 8);
                const bf16x8 kb = *(const LAS bf16x8*)(KW + ((ks * 2 + hh) * 32 + l31) * 8);
                acc = __builtin_amdgcn_mfma_f32_32x32x16_bf16(va, kb, acc, 0, 0, 0);
            }
            float* o = CKV + (size_t)u * 2048;
#pragma unroll
            for (int r = 0; r < 16; ++r) { const int e = 32 * wave + (r & 3) + 8 * (r >> 2) + 4 * hh; o[e * 32 + l31] = acc[r]; }
        }
        __syncthreads();
    }
}
__device__ __forceinline__ void ret_pass_c(const Args& a, LAS unsigned char* lds, int tid, int wave, int lane, int G) {
    const bf16_t* PROJ = (const bf16_t*)(a.ws + R_PROJ); const float* rope = (const float*)(a.ws + WS_ROPE); const float* CKV = (const float*)(a.ws + R_CKV);
    bf16_t* MIX = (bf16_t*)(a.ws + R_MIX);
    LAS bf16_t* VT = (LAS bf16_t*)lds; LAS bf16_t* QS = (LAS bf16_t*)(lds + 16384); LAS bf16_t* KS = (LAS bf16_t*)(lds + 24576); LAS bf16_t* RT = (LAS bf16_t*)(lds + 32768);
    LAS float* SSQ = (LAS float*)(lds + 36864);
    const int hh = lane >> 5, l31 = lane & 31, cb = wave & 3, eb = wave >> 2;
    const int vm = tid >> 2, veg = tid & 3;
    const int row = tid & 127, ch = tid >> 7;
    const int re = tid >> 3, rd0 = (tid & 7) * 4;
    for (int su = blockIdx.x; su < NB * 4 * 8; su += G) {
        const int bh = su >> 3, h = bh & 3, b = bh >> 2, n0 = (su & 7) * 8;
        const float gam = 1.0f - exp2f(-5.0f - (float)h), lg2 = log2f(gam), cd = exp2f(128.0f * lg2);
        const float* ck = CKV + ((size_t)((b * 64) * 4 + h)) * 2048 + re * 32 + rd0;
        f32x4 Rc = (f32x4){0.f, 0.f, 0.f, 0.f};
        for (int nn = 0; nn + 1 < n0; nn += 8) { f32x4 c8[8];
#pragma unroll
            for (int i = 0; i < 8; ++i) c8[i] = (nn + i < n0 - 1) ? *(const f32x4*)(ck + (size_t)(nn + i) * 4 * 2048) : (f32x4){0.f, 0.f, 0.f, 0.f};
#pragma unroll
            for (int i = 0; i < 8; ++i) if (nn + i < n0 - 1) Rc = Rc * cd + c8[i]; }
        u32x4 sv0, sv1, sqo, sqp, sko, skp; f32x4 sc0, sc1, sc2, sc3, sck;
#define RC_LOAD(n_) do { const size_t t0_ = (size_t)b * SEQ + (size_t)(n_) * 128; \
            const bf16_t* pv_ = PROJ + (t0_ + vm) * INWP + C_RV + h * 64 + veg * 16; sv0 = *(const u32x4*)pv_; sv1 = *(const u32x4*)(pv_ + 8); \
            const bf16_t* pq_ = PROJ + (t0_ + row) * INWP + C_RQ + h * 32; sqo = *(const u32x4*)(pq_ + 8 * ch); sqp = *(const u32x4*)(pq_ + 8 * (ch ^ 2)); \
            const bf16_t* pk_ = PROJ + (t0_ + row) * INWP + C_RK + h * 32; sko = *(const u32x4*)(pk_ + 8 * ch); skp = *(const u32x4*)(pk_ + 8 * (ch ^ 2)); \
            const f32x4* cs_ = (const f32x4*)(rope + ((t0_ + row) * 16 + (ch & 1) * 8) * 2); sc0 = cs_[0]; sc1 = cs_[1]; sc2 = cs_[2]; sc3 = cs_[3]; \
            sck = (n_) > 0 ? *(const f32x4*)(ck + (size_t)((n_) - 1) * 4 * 2048) : (f32x4){0.f, 0.f, 0.f, 0.f}; } while (0)
        RC_LOAD(n0);
        for (int kq = 0; kq < 8; ++kq) {
            const int n = n0 + kq; const size_t t0 = (size_t)b * SEQ + (size_t)n * 128;
            {
                const int ks = vm >> 4, w = vm & 15, vh = (w >> 2) & 1, j = 4 * (w >> 3) + (w & 3);
                const unsigned vw[8] = {sv0.x, sv0.y, sv0.z, sv0.w, sv1.x, sv1.y, sv1.z, sv1.w};
                LAS bf16_t* d = VT + ((ks * 2 + vh) * 64 + veg * 16) * 8 + j;
#pragma unroll
                for (int i = 0; i < 16; ++i) d[i * 8] = (bf16_t)((i & 1) ? (vw[i >> 1] >> 16) : (vw[i >> 1] & 0xffffu));
            }
            {
                const float cc[8] = {sc0.x, sc0.z, sc1.x, sc1.z, sc2.x, sc2.z, sc3.x, sc3.z}, sn[8] = {sc0.y, sc0.w, sc1.y, sc1.w, sc2.y, sc2.w, sc3.y, sc3.w};
                const unsigned qo[4] = {sqo.x, sqo.y, sqo.z, sqo.w}, qp[4] = {sqp.x, sqp.y, sqp.z, sqp.w}, ko[4] = {sko.x, sko.y, sko.z, sko.w}, kp[4] = {skp.x, skp.y, skp.z, skp.w};
                float oq[8], ok[8];
#pragma unroll
                for (int j = 0; j < 8; ++j) { const float xo = (j & 1) ? bfhi(qo[j >> 1]) : bflo(qo[j >> 1]), xp = (j & 1) ? bfhi(qp[j >> 1]) : bflo(qp[j >> 1]);
                    oq[j] = (ch < 2) ? (xo * cc[j] - xp * sn[j]) : (xp * sn[j] + xo * cc[j]);
                    const float yo = (j & 1) ? bfhi(ko[j >> 1]) : bflo(ko[j >> 1]), yp = (j & 1) ? bfhi(kp[j >> 1]) : bflo(kp[j >> 1]);
                    ok[j] = (ch < 2) ? (yo * cc[j] - yp * sn[j]) : (yp * sn[j] + yo * cc[j]); }
                const float qs = exp2f((float)row * lg2);
                u32x4 w; w.x = pk2(oq[0] * qs, oq[1] * qs); w.y = pk2(oq[2] * qs, oq[3] * qs); w.z = pk2(oq[4] * qs, oq[5] * qs); w.w = pk2(oq[6] * qs, oq[7] * qs);
                *(LAS u32x4*)(QS + (ch * 128 + row) * 8) = w;
                const float ks_ = 0.17677669529663687f * exp2f(-(float)row * lg2);
                w.x = pk2(ok[0] * ks_, ok[1] * ks_); w.y = pk2(ok[2] * ks_, ok[3] * ks_); w.z = pk2(ok[4] * ks_, ok[5] * ks_); w.w = pk2(ok[6] * ks_, ok[7] * ks_);
                *(LAS u32x4*)(KS + (ch * 128 + row) * 8) = w;
            }
            {
                if (n > 0) Rc = Rc * cd + sck;
                const f32x4 R = Rc;
                u32x2 w; w.x = pk2(R.x * gam, R.y * gam); w.y = pk2(R.z * gam, R.w * gam);
                *(LAS u32x2*)(RT + ((rd0 >> 3) * 64 + re) * 8 + (rd0 & 7)) = w;
            }
            LDS_BARRIER();
            if (kq < 7) RC_LOAD(n + 1);
            const size_t t = t0 + 32 * cb + l31;
            u32x2 gwv[4];
#pragma unroll
            for (int g = 0; g < 4; ++g) gwv[g] = *(const u32x2*)(PROJ + t * INWP + C_RG + h * 64 + 32 * eb + 8 * g + 4 * hh);
            f32x16 o;
#pragma unroll
            for (int r = 0; r < 16; ++r) o[r] = 0.f;
            bf16x8 qf[2];
#pragma unroll
            for (int s2 = 0; s2 < 2; ++s2) qf[s2] = *(const LAS bf16x8*)(QS + ((2 * s2 + hh) * 128 + 32 * cb + l31) * 8);
#pragma unroll
            for (int s2 = 0; s2 < 2; ++s2) { const bf16x8 ra = *(const LAS bf16x8*)(RT + ((2 * s2 + hh) * 64 + 32 * eb + l31) * 8); o = __builtin_amdgcn_mfma_f32_32x32x16_bf16(ra, qf[s2], o, 0, 0, 0); }
            for (int mb = 0; mb <= cb; ++mb) {
                f32x16 sc;
#pragma unroll
                for (int r = 0; r < 16; ++r) sc[r] = 0.f;
#pragma unroll
                for (int s2 = 0; s2 < 2; ++s2) { const bf16x8 ka = *(const LAS bf16x8*)(KS + ((2 * s2 + hh) * 128 + 32 * mb + l31) * 8); sc = __builtin_amdgcn_mfma_f32_32x32x16_bf16(ka, qf[s2], sc, 0, 0, 0); }
                if (mb == cb) {
#pragma unroll
                    for (int r = 0; r < 16; ++r) if ((r & 3) + 8 * (r >> 2) + 4 * hh > l31) sc[r] = 0.f;
                }
#pragma unroll
                for (int sb = 0; sb < 2; ++sb) { u32x4 w; w.x = cvt_pk_bf16(sc[8 * sb], sc[8 * sb + 1]); w.y = cvt_pk_bf16(sc[8 * sb + 2], sc[8 * sb + 3]); w.z = cvt_pk_bf16(sc[8 * sb + 4], sc[8 * sb + 5]); w.w = cvt_pk_bf16(sc[8 * sb + 6], sc[8 * sb + 7]);
                    const bf16x8 pb = __builtin_bit_cast(bf16x8, w);
                    const bf16x8 va = *(const LAS bf16x8*)(VT + (((2 * mb + sb) * 2 + hh) * 64 + 32 * eb + l31) * 8);
                    o = __builtin_amdgcn_mfma_f32_32x32x16_bf16(va, pb, o, 0, 0, 0); }
            }
            float ss = 0.f;
#pragma unroll
            for (int r = 0; r < 16; ++r) ss += o[r] * o[r];
            ss += __shfl_xor(ss, 32);
            if (hh == 0) SSQ[(cb * 2 + eb) * 32 + l31] = ss;
            LDS_BARRIER();
            const float tot = SSQ[(cb * 2) * 32 + l31] + SSQ[(cb * 2 + 1) * 32 + l31];
            const float rstd = __builtin_amdgcn_rsqf(tot * (1.0f / 64.0f) + NORM_EPS);
#pragma unroll
            for (int g = 0; g < 4; ++g) { const int e0 = 32 * eb + 8 * g + 4 * hh;
                const float g0 = bflo(gwv[g].x), g1 = bfhi(gwv[g].x), g2 = bflo(gwv[g].y), g3 = bfhi(gwv[g].y);
                u32x2 w; w.x = cvt_pk_bf16(o[4 * g] * rstd * g0 * sigmoidf_(g0), o[4 * g + 1] * rstd * g1 * sigmoidf_(g1)); w.y = cvt_pk_bf16(o[4 * g + 2] * rstd * g2 * sigmoidf_(g2), o[4 * g + 3] * rstd * g3 * sigmoidf_(g3));
                *(u32x2*)(MIX + t * 1024 + 768 + h * 64 + e0) = w; }
        }
#undef RC_LOAD
        __syncthreads();
    }
}
__device__ __forceinline__ float exp2_(float x) { return __builtin_amdgcn_exp2f(x); }
__device__ __forceinline__ void attn_unit(LAS unsigned char* lds, const bf16_t* QB, const unsigned char* KT, const unsigned char* VT, bf16_t* MIX, int bh, int qb, int tid, int wave, int lane) {
    const int b = bh >> 2, h = bh & 3, hh = lane >> 5, l31 = lane & 31, grp = wave >> 2;
    const int qrel = wave * 32 + l31;
    const size_t trow = (size_t)b * SEQ + (size_t)qb * 256 + qrel;
    bf16x8 qf[6];
#pragma unroll
    for (int s = 0; s < 6; ++s) qf[s] = *(const bf16x8*)(QB + trow * 384 + h * 96 + 16 * s + 8 * hh);
    f32x16 o0, o1;
#pragma unroll
    for (int r = 0; r < 16; ++r) { o0[r] = 0.f; o1[r] = 0.f; }
    float mrun = -1e30f, lsum = 0.f;
    const int ntile = 4 * (qb + 1);
    const unsigned char* kbase = KT + (size_t)bh * 128 * 12288 + lane * 16; const unsigned char* vbase = VT + (size_t)bh * 128 * 8192 + wave * 1024 + lane * 16;
    const int kp0 = wave * 1024, kp1 = (wave < 4 ? wave + 8 : wave) * 1024;
    LAS unsigned char* vring = lds + 36864;
#define AT_DMA_K(T, SLOT) do { const unsigned char* kp_ = kbase + (size_t)(T) * 12288; LAS unsigned char* kd_ = lds + (SLOT) * 12288; \
        __builtin_amdgcn_global_load_lds((const unsigned*)(kp_ + kp0), (LAS unsigned*)(kd_ + kp0), 16, 0, 0); \
        __builtin_amdgcn_global_load_lds((const unsigned*)(kp_ + kp1), (LAS unsigned*)(kd_ + kp1), 16, 0, 0); } while (0)
#define AT_DMA_V(T, SLOT) __builtin_amdgcn_global_load_lds((const unsigned*)(vbase + (size_t)(T) * 8192), (LAS unsigned*)(vring + (SLOT) * 8192 + wave * 1024), 16, 0, 0)
#define AT_BAR() asm volatile("s_barrier" ::: "memory")
#define AT_PV(SLOT) do { LAS unsigned char* vl = vring + (SLOT) * 8192; _Pragma("unroll") for (int ks = 0; ks < 4; ++ks) { \
        const bf16x8 va0 = *(const LAS bf16x8*)(vl + ((ks * 2 + hh) * 64 + l31) * 16); const bf16x8 va1 = *(const LAS bf16x8*)(vl + ((ks * 2 + hh) * 64 + 32 + l31) * 16); \
        o0 = __builtin_amdgcn_mfma_f32_32x32x16_bf16(va0, pb[ks], o0, 0, 0, 0); o1 = __builtin_amdgcn_mfma_f32_32x32x16_bf16(va1, pb[ks], o1, 0, 0, 0); } } while (0)
    AT_DMA_K(0, 0);
    AT_DMA_K(1, 1); AT_DMA_V(0, 0);
    *(LAS u32x4*)(vring + 2 * 8192 + tid * 16) = zero4();
    asm volatile("s_waitcnt vmcnt(3) lgkmcnt(0)" ::: "memory"); AT_BAR();
    if (grp) AT_BAR();
    int i0 = 0, i1 = 1, i2 = 2;
    bf16x8 pb[4];
#pragma unroll
    for (int ks = 0; ks < 4; ++ks) pb[ks] = __builtin_bit_cast(bf16x8, zero4());
    const int lrow = (hh * 64 + l31) * 16;
    for (int t = 0; t < ntile; ++t) {
        { const int tk = (t + 2 < ntile) ? t + 2 : ntile - 1, tv = (t + 1 < ntile) ? t + 1 : ntile - 1; AT_DMA_K(tk, i2); AT_DMA_V(tv, i1); }
        const int jr = t - 4 * qb;
        f32x16 s0, s1;
#pragma unroll
        for (int r = 0; r < 16; ++r) { s0[r] = 0.f; s1[r] = 0.f; }
        {
            LAS unsigned char* kl = lds + i0 * 12288 + lrow; LAS unsigned char* vl = vring + i2 * 8192 + lrow;
            bf16x8 kf[12], vf[8];
#pragma unroll
            for (int s = 0; s < 2; ++s) { kf[2 * s] = *(const LAS bf16x8*)(kl + s * 2048); kf[2 * s + 1] = *(const LAS bf16x8*)(kl + s * 2048 + 512); }
            __builtin_amdgcn_sched_barrier(0);
            __builtin_amdgcn_s_setprio(1);
#pragma unroll
            for (int s = 0; s < 6; ++s) {
                s0 = __builtin_amdgcn_mfma_f32_32x32x16_bf16(kf[2 * s], qf[s], s0, 0, 0, 0);
                s1 = __builtin_amdgcn_mfma_f32_32x32x16_bf16(kf[2 * s + 1], qf[s], s1, 0, 0, 0);
                if (s < 4) { kf[2 * s + 4] = *(const LAS bf16x8*)(kl + (s + 2) * 2048); kf[2 * s + 5] = *(const LAS bf16x8*)(kl + (s + 2) * 2048 + 512); }
                else {
#pragma unroll
                    for (int q = 0; q < 2; ++q) { const int ks = (s - 4) * 2 + q; vf[2 * ks] = *(const LAS bf16x8*)(vl + ks * 2048); vf[2 * ks + 1] = *(const LAS bf16x8*)(vl + ks * 2048 + 512); } }
                __builtin_amdgcn_sched_barrier(0);
            }
#pragma unroll
            for (int ks = 0; ks < 4; ++ks) { o0 = __builtin_amdgcn_mfma_f32_32x32x16_bf16(vf[2 * ks], pb[ks], o0, 0, 0, 0); o1 = __builtin_amdgcn_mfma_f32_32x32x16_bf16(vf[2 * ks + 1], pb[ks], o1, 0, 0, 0); }
            __builtin_amdgcn_s_setprio(0);
        }
        asm volatile("s_waitcnt vmcnt(3)" ::: "memory"); AT_BAR();
        {
            if (jr >= 0 && (64 * jr + 63 > wave * 32)) {
                const float ninf = -__builtin_inff();
#pragma unroll
                for (int r = 0; r < 16; ++r) { const int key = 64 * jr + (r & 3) + 8 * (r >> 2) + 4 * hh;
                    if (key > qrel) s0[r] = ninf; if (key + 32 > qrel) s1[r] = ninf; }
            }
            float mx = s0[0];
#pragma unroll
            for (int r = 1; r < 16; ++r) mx = fmaxf(mx, s0[r]);
#pragma unroll
            for (int r = 0; r < 16; ++r) mx = fmaxf(mx, s1[r]);
            mx = fmaxf(mx, __shfl_xor(mx, 32));
            const float mnew = fmaxf(mrun, mx);
            const float alpha = exp2_(mrun - mnew);
            float rs = 0.f;
#pragma unroll
            for (int r = 0; r < 16; ++r) { s0[r] = exp2_(s0[r] - mnew); s1[r] = exp2_(s1[r] - mnew); rs += s0[r] + s1[r]; }
            lsum = lsum * alpha + rs;
            if (__builtin_amdgcn_ballot_w64(mnew > mrun) != 0ull) {
#pragma unroll
                for (int r = 0; r < 16; ++r) { o0[r] *= alpha; o1[r] *= alpha; } }
            mrun = mnew;
#pragma unroll
            for (int ks = 0; ks < 4; ++ks) { u32x4 w;
                if (ks < 2) { w.x = cvt_pk_bf16(s0[8 * ks + 0], s0[8 * ks + 1]); w.y = cvt_pk_bf16(s0[8 * ks + 2], s0[8 * ks + 3]); w.z = cvt_pk_bf16(s0[8 * ks + 4], s0[8 * ks + 5]); w.w = cvt_pk_bf16(s0[8 * ks + 6], s0[8 * ks + 7]); }
                else { const int k2 = ks - 2; w.x = cvt_pk_bf16(s1[8 * k2 + 0], s1[8 * k2 + 1]); w.y = cvt_pk_bf16(s1[8 * k2 + 2], s1[8 * k2 + 3]); w.z = cvt_pk_bf16(s1[8 * k2 + 4], s1[8 * k2 + 5]); w.w = cvt_pk_bf16(s1[8 * k2 + 6], s1[8 * k2 + 7]); }
                pb[ks] = __builtin_bit_cast(bf16x8, w); }
        }
        AT_BAR();
        { const int tmp = i0; i0 = i1; i1 = i2; i2 = tmp; }
    }
    AT_PV(i2);
    asm volatile("s_waitcnt vmcnt(0)" ::: "memory"); AT_BAR();
    if (!grp) AT_BAR();
#undef AT_DMA_K
#undef AT_DMA_V
#undef AT_BAR
#undef AT_PV
    const float ltot = lsum + __shfl_xor(lsum, 32);
    const float inv = 1.0f / ltot;
    bf16_t* orow = MIX + trow * 1024 + 512 + h * 64;
#pragma unroll
    for (int g = 0; g < 4; ++g) {
        u32x2 w0, w1;
        w0.x = cvt_pk_bf16(o0[4 * g] * inv, o0[4 * g + 1] * inv); w0.y = cvt_pk_bf16(o0[4 * g + 2] * inv, o0[4 * g + 3] * inv);
        w1.x = cvt_pk_bf16(o1[4 * g] * inv, o1[4 * g + 1] * inv); w1.y = cvt_pk_bf16(o1[4 * g + 2] * inv, o1[4 * g + 3] * inv);
        *(u32x2*)(orow + 8 * g + 4 * hh) = w0; *(u32x2*)(orow + 32 + 8 * g + 4 * hh) = w1;
    }
}
__device__ __forceinline__ void attn_queue(const Args& a, int l, LAS unsigned char* lds, volatile LAS unsigned* qw, unsigned* qctr, int tid, int wave, int lane) {
    const bf16_t* QB = (const bf16_t*)(a.ws + R_QB); const unsigned char* KT = a.ws + R_KT; const unsigned char* VT = a.ws + R_VT; bf16_t* MIX = (bf16_t*)(a.ws + R_MIX);
    for (;;) {
        if (tid == 0) *qw = __hip_atomic_fetch_add(qctr, 1u, __ATOMIC_RELAXED, __HIP_MEMORY_SCOPE_AGENT);
        __syncthreads();
        const int u = (int)__builtin_amdgcn_readfirstlane(*qw);
        __syncthreads();
        if (u >= 1536) break;
        if (u < 1024 && (u & 1)) { conv_expert_item(a, l, u >> 1, (LAS float*)(lds + 65536 + wave * 8704), wave, lane); continue; }
        const int au = u < 1024 ? (u >> 1) : u - 512;
        attn_unit(lds, QB, KT, VT, MIX, au & 31, 31 - (au >> 5), tid, wave, lane);
    }
}
__device__ __forceinline__ void attn_phase(const Args& a, LAS unsigned char* lds, int tid, int wave, int lane, int G) {
    const bf16_t* QB = (const bf16_t*)(a.ws + R_QB); const unsigned char* KT = a.ws + R_KT; const unsigned char* VT = a.ws + R_VT; bf16_t* MIX = (bf16_t*)(a.ws + R_MIX);
    for (int u = blockIdx.x; u < 512; u += G) {
        int bh, pq;
        if ((G & 7) == 0 && (512 % G) == 0) { const int x = blockIdx.x & 7, jj = (u / G) * (G / 8) + (blockIdx.x >> 3); bh = x + 8 * (jj >> 4); pq = jj & 15; }
        else { bh = u >> 4; pq = u & 15; }
        attn_unit(lds, QB, KT, VT, MIX, bh, 31 - pq, tid, wave, lane);
        attn_unit(lds, QB, KT, VT, MIX, bh, pq, tid, wave, lane);
    }
}

__device__ __forceinline__ void rwkv_scan(const Args& a, LAS unsigned char* lds, int tid, int wave, int lane, int G) {
    const float* SI = (const float*)(a.ws + R_SI); float* YR = (float*)(a.ws + R_YRAW);
    constexpr int CH = 16, NCH = SEQ / CH;
    LAS float* buf = (LAS float*)lds;
    const int lt = tid >> 5, lp = tid & 31;
    for (int blk = blockIdx.x; blk < 256; blk += G) {
        int bh, rg;
        if (G == 256) { const int x = blk & 7, j = blk >> 3; bh = x * 4 + (j >> 3); rg = j & 7; }
        else { bh = blk >> 3; rg = blk & 7; }
        const int row = rg * 8 + wave, b = bh >> 2, h = bh & 3;
        const f32x4* src = (const f32x4*)(SI + ((size_t)b * SEQ * 4 + h) * 384 + (size_t)lt * 1536) + lp;
        float* yo = YR + (size_t)b * SEQ * 256 + h * 64 + row;
        f32x4 g0 = src[0], g1 = src[32], g2 = src[64];
        { LAS f32x4* d = (LAS f32x4*)(buf + lt * 384) + lp; d[0] = g0; d[32] = g1; d[64] = g2; }
        __syncthreads();
        float s = 0.f;
        for (int c = 0; c < NCH; ++c) {
            const bool more = (c + 1 < NCH);
            if (more) { const f32x4* sn = src + (size_t)(c + 1) * CH * 384; g0 = sn[0]; g1 = sn[32]; g2 = sn[64]; }
            const LAS float* cb = buf + (c & 1) * CH * 384;
            float ykeep = 0.f;
#pragma unroll
            for (int i = 0; i < CH; ++i) {
                const LAS float* p = cb + i * 384;
                const float r = p[lane], w = p[64 + lane], k = p[128 + lane], kk = p[192 + lane], bb = p[256 + lane], v = p[320 + row];
                const float sa = -wave_sum_bc(s * kk);
                s = fmaf(sa, bb, fmaf(s, w, v * k));
                const float y = wave_sum_bc(s * r);
                ykeep = (lane == i) ? y : ykeep;
            }
            if (lane < CH) yo[(size_t)(c * CH + lane) * 256] = ykeep;
            if (more) { LAS f32x4* d = (LAS f32x4*)(buf + ((c + 1) & 1) * CH * 384 + lt * 384) + lp; d[0] = g0; d[32] = g1; d[64] = g2; }
            __syncthreads();
        }
    }
}
constexpr size_t RWP_CHUNK = 22 * 1024;
__device__ __forceinline__ u32x4 pack8(const float* x) { u32x4 w; w.x = cvt_pk_bf16(x[0], x[1]); w.y = cvt_pk_bf16(x[2], x[3]); w.z = cvt_pk_bf16(x[4], x[5]); w.w = cvt_pk_bf16(x[6], x[7]); return w; }
__device__ __forceinline__ bf16x8 frag2(const LAS bf16_t* p0, const LAS bf16_t* p1) { const u32x2 lo = *(const LAS u32x2*)p0, hi = *(const LAS u32x2*)p1; u32x4 w; w.x = lo.x; w.y = lo.y; w.z = hi.x; w.w = hi.y; return __builtin_bit_cast(bf16x8, w); }
__device__ __forceinline__ void rwkv_pre(const Args& a, int l, LAS unsigned char* lds, int wave, int lane, int G) {
    const bf16_t* PROJ = (const bf16_t*)(a.ws + R_PROJ); const bf16_t* LO = (const bf16_t*)(a.ws + R_LO); float* VF = (float*)(a.ws + WS_VF); bf16_t* BON = (bf16_t*)(a.ws + R_SI);
    unsigned char* RWP = a.ws + R_SI + 64 * MiB;
    LAS unsigned char* L = lds + wave * 16384;
    LAS bf16_t* AT = (LAS bf16_t*)L; LAS bf16_t* BH = (LAS bf16_t*)(L + 4096); LAS bf16_t* KH = (LAS bf16_t*)(L + 8192); LAS bf16_t* RT = (LAS bf16_t*)(L + 12288);
    LAS float* LT = (LAS float*)L; LAS float* TAL = (LAS float*)(L + 4096); LAS bf16_t* BB = (LAS bf16_t*)(L + 8192);
    LAS bf16_t* WL = (LAS bf16_t*)L; LAS bf16_t* GL = (LAS bf16_t*)(L + 4096);
    const int hh = lane >> 5, l31 = lane & 31;
    for (int ci = blockIdx.x * 8 + wave; ci < NB * 4 * 256; ci += G * 8) {
        const int bh = ci >> 8, c = ci & 255, b = bh >> 2, h = bh & 3;
        const size_t tok0 = (size_t)b * SEQ + (size_t)c * 32; const int jj = h * 64 + lane;
        unsigned char* out = RWP + (size_t)ci * RWP_CHUNK;
        float at[32], vv[32], bhv[32], khv[32];
        float pC;
        {
            const float* mu = FIN(I_RWMU) + l * 1024;
            const float mur = mu[jj], muk = mu[256 + jj], muv = mu[512 + jj];
            const float w0 = FIN(I_RWW0)[l * 256 + jj], a0 = FIN(I_RWA0)[l * 256 + jj], kkp = FIN(I_RWKK)[l * 256 + jj], kap = FIN(I_RWKA)[l * 256 + jj], rkp = FIN(I_RWRK)[l * 256 + jj];
            const float v0 = l > 0 ? FIN(I_RWV0)[(l - 1) * 256 + jj] : 0.f;
            float rp = 0.f, kp = 0.f, vp = 0.f;
            if (c != 0) { const bf16_t* pp = PROJ + (tok0 - 1) * INWP; rp = bf2f(pp[C_RWR + jj]); kp = bf2f(pp[C_RWK + jj]); vp = bf2f(pp[C_RWV + jj]); }
            float p = 1.f;
            unsigned raw[2][4][6]; float rvf[2][4];
#define RW_LOADG(buf_, g_) do { _Pragma("unroll") for (int q_ = 0; q_ < 4; ++q_) { const size_t tk_ = tok0 + 4 * (g_) + q_; const bf16_t* pc_ = PROJ + tk_ * INWP; const bf16_t* lo_ = LO + tk_ * 1024; \
                raw[buf_][q_][0] = pc_[C_RWR + jj]; raw[buf_][q_][1] = pc_[C_RWK + jj]; raw[buf_][q_][2] = pc_[C_RWV + jj]; raw[buf_][q_][3] = lo_[jj]; raw[buf_][q_][4] = lo_[256 + jj]; \
                raw[buf_][q_][5] = lo_[768 + jj]; rvf[buf_][q_] = VF[tk_ * 256 + jj]; } } while (0)
            RW_LOADG(0, 0);
#pragma unroll
            for (int t = 0; t < 32; ++t) { const size_t tok = tok0 + t; const int g_ = t >> 2, q = t & 3, bu = g_ & 1;
                if (q == 0 && g_ < 7) { RW_LOADG(bu ^ 1, g_ + 1); asm volatile("" ::: "memory"); }
                const float rc = bf2f(raw[bu][q][0]), kc = bf2f(raw[bu][q][1]), vc = bf2f(raw[bu][q][2]);
                const float r = rc + (rp - rc) * mur, k = kc + (kp - kc) * muk; float v = vc + (vp - vc) * muv; rp = rc; kp = kc; vp = vc;
                const float wl = w0 + bf2f(raw[bu][q][3]); const float w = __expf(-__expf(-__logf(1.0f + __expf(-wl)) - 0.5f));
                const float aa = sigmoidf_(a0 + bf2f(raw[bu][q][4]));
                if (l > 0) { const float vf = rvf[bu][q]; v += (vf - v) * sigmoidf_(v0 + bf2f(raw[bu][q][5])); } else VF[tok * 256 + jj] = v;
                const float kk0 = k * kkp; const float kk = kk0 * __builtin_amdgcn_rcpf(fmaxf(sqrtf(wave_sum_bc(kk0 * kk0)), 1e-12f));
                const float kx = k * (1.0f + (aa - 1.0f) * kap), bb = kk * aa;
                BON[tok * 256 + jj] = cvt1(wave_sum_bc(r * kx * rkp) * v);
                vv[t] = v;
                const float pprev = p; p *= w; at[t] = -kk * pprev; const float ip = __builtin_amdgcn_rcpf(p); bhv[t] = bb * ip; khv[t] = kx * ip;
                const int idx = ((lane >> 3) * 32 + t) * 8 + (lane & 7);
                AT[idx] = cvt1(at[t]); BH[idx] = cvt1(bhv[t]); KH[idx] = cvt1(khv[t]); RT[idx] = cvt1(r * p);
                if ((t & 3) == 3) asm volatile("" ::: "memory"); }
#undef RW_LOADG
            pC = p;
        }
        {
#pragma unroll
            for (int sh = 0; sh < 4; ++sh) { const int s2 = sh >> 1, h2 = sh & 1; float x[8];
#pragma unroll
                for (int j = 0; j < 8; ++j) x[j] = vv[16 * s2 + 8 * (j >> 2) + 4 * h2 + (j & 3)];
                *(u32x4*)(out + (size_t)(18 + sh) * 1024 + lane * 16) = pack8(x); }
        }
        LDS_WAIT();
        f32x16 lt, ta, abr, akr;
#pragma unroll
        for (int r = 0; r < 16; ++r) { lt[r] = 0.f; ta[r] = 0.f; abr[r] = 0.f; akr[r] = 0.f; }
#pragma unroll
        for (int s4 = 0; s4 < 4; ++s4) { const int fo = ((2 * s4 + hh) * 32 + l31) * 8;
            const bf16x8 fa = *(const LAS bf16x8*)(AT + fo), fb = *(const LAS bf16x8*)(BH + fo), fk = *(const LAS bf16x8*)(KH + fo), fr = *(const LAS bf16x8*)(RT + fo);
            lt = __builtin_amdgcn_mfma_f32_32x32x16_bf16(fa, fb, lt, 0, 0, 0); ta = __builtin_amdgcn_mfma_f32_32x32x16_bf16(fa, fk, ta, 0, 0, 0);
            abr = __builtin_amdgcn_mfma_f32_32x32x16_bf16(fb, fr, abr, 0, 0, 0); akr = __builtin_amdgcn_mfma_f32_32x32x16_bf16(fk, fr, akr, 0, 0, 0); }
#pragma unroll
        for (int r = 0; r < 16; ++r) { const int row = (r & 3) + 8 * (r >> 2) + 4 * hh;
            if (!(l31 < row)) { lt[r] = 0.f; ta[r] = 0.f; } if (!(row <= l31)) { abr[r] = 0.f; akr[r] = 0.f; } }
        LDS_WAIT();
#pragma unroll
        for (int r = 0; r < 16; ++r) { const int row = (r & 3) + 8 * (r >> 2) + 4 * hh; LT[row * 32 + l31] = lt[r]; TAL[row * 32 + l31] = ta[r]; }
#pragma unroll
        for (int ic = 0; ic < 4; ++ic) { float x[8];
#pragma unroll
            for (int j = 0; j < 8; ++j) { x[j] = bhv[8 * ic + j] * pC; khv[8 * ic + j] *= pC; }
            *(LAS u32x4*)(BB + (ic * 64 + lane) * 8) = pack8(x); }
        LDS_WAIT();
        {
            float g[32];
#pragma unroll
            for (int j = 0; j < 32; ++j) g[j] = TAL[j * 32 + l31];
#pragma unroll
            for (int j = 1; j < 32; ++j) {
#pragma unroll
                for (int i4 = 0; i4 * 4 < j; ++i4) { const f32x4 c4 = *(const LAS f32x4*)(LT + j * 32 + 4 * i4);
#pragma unroll
                    for (int ii = 0; ii < 4; ++ii) { const int i = 4 * i4 + ii; if (i < j) { at[j] = fmaf(at[i], c4[ii], at[j]); g[j] = fmaf(g[i], c4[ii], g[j]); } } }
                if ((j & 1) == 1) asm volatile("" ::: "memory"); }
            LDS_WAIT();
#pragma unroll
            for (int ic = 0; ic < 4; ++ic) { *(LAS u32x4*)(WL + (ic * 64 + lane) * 8) = pack8(at + 8 * ic); if (lane < 32) *(LAS u32x4*)(GL + (ic * 32 + lane) * 8) = pack8(g + 8 * ic); }
        }
        LDS_WAIT();
        bf16x8 ab[2];
#pragma unroll
        for (int s2 = 0; s2 < 2; ++s2) { float x[8];
#pragma unroll
            for (int j = 0; j < 8; ++j) x[j] = abr[8 * s2 + j];
            ab[s2] = __builtin_bit_cast(bf16x8, pack8(x)); }
        bf16x8 gf[2];
#pragma unroll
        for (int s2 = 0; s2 < 2; ++s2) gf[s2] = frag2(GL + ((2 * s2) * 32 + l31) * 8 + 4 * hh, GL + ((2 * s2 + 1) * 32 + l31) * 8 + 4 * hh);
#define RW_STORE_TILE(acc_, unit_) do { _Pragma("unroll") for (int s2_ = 0; s2_ < 2; ++s2_) { float x_[8]; _Pragma("unroll") for (int j_ = 0; j_ < 8; ++j_) x_[j_] = acc_[8 * s2_ + j_]; \
            *(u32x4*)(out + (size_t)((unit_) + s2_) * 1024 + lane * 16) = pack8(x_); } } while (0)
        {
            f32x16 acc = akr;
#pragma unroll
            for (int s2 = 0; s2 < 2; ++s2) acc = __builtin_amdgcn_mfma_f32_32x32x16_bf16(gf[s2], ab[s2], acc, 0, 0, 0);
            RW_STORE_TILE(acc, 16);
        }
        const float pcv0 = __shfl(pC, l31), pcv1 = __shfl(pC, 32 + l31);
#pragma unroll
        for (int kb = 0; kb < 2; ++kb) {
            bf16x8 wf[2];
#pragma unroll
            for (int s2 = 0; s2 < 2; ++s2) wf[s2] = frag2(WL + ((2 * s2) * 64 + 32 * kb + l31) * 8 + 4 * hh, WL + ((2 * s2 + 1) * 64 + 32 * kb + l31) * 8 + 4 * hh);
            {
                f32x16 acc;
#pragma unroll
                for (int g4 = 0; g4 < 4; ++g4) { const u32x2 w = *(const LAS u32x2*)(RT + ((4 * kb + g4) * 32 + l31) * 8 + 4 * hh);
                    acc[4 * g4] = bflo(w.x); acc[4 * g4 + 1] = bfhi(w.x); acc[4 * g4 + 2] = bflo(w.y); acc[4 * g4 + 3] = bfhi(w.y); }
#pragma unroll
                for (int s2 = 0; s2 < 2; ++s2) acc = __builtin_amdgcn_mfma_f32_32x32x16_bf16(wf[s2], ab[s2], acc, 0, 0, 0);
                RW_STORE_TILE(acc, 8 + kb * 2);
            }
#pragma unroll
            for (int q = 0; q < 2; ++q) {
                f32x16 acc;
#pragma unroll
                for (int r = 0; r < 16; ++r) acc[r] = 0.f;
#pragma unroll
                for (int s2 = 0; s2 < 2; ++s2) { const bf16x8 bf_ = frag2(BB + ((2 * s2) * 64 + 32 * q + l31) * 8 + 4 * hh, BB + ((2 * s2 + 1) * 64 + 32 * q + l31) * 8 + 4 * hh);
                    acc = __builtin_amdgcn_mfma_f32_32x32x16_bf16(wf[s2], bf_, acc, 0, 0, 0); }
                if (kb == q) { const float pcv = q ? pcv1 : pcv0;
#pragma unroll
                    for (int r = 0; r < 16; ++r) if ((r & 3) + 8 * (r >> 2) + 4 * hh == l31) acc[r] += pcv; }
                RW_STORE_TILE(acc, (kb * 2 + q) * 2);
            }
        }
#pragma unroll
        for (int q = 0; q < 2; ++q) {
            f32x16 acc;
#pragma unroll
            for (int g4 = 0; g4 < 4; ++g4)
#pragma unroll
                for (int jx = 0; jx < 4; ++jx) { const float va = __shfl(khv[8 * g4 + jx], 32 * q + l31), vb = __shfl(khv[8 * g4 + 4 + jx], 32 * q + l31); acc[4 * g4 + jx] = hh ? vb : va; }
#pragma unroll
            for (int s2 = 0; s2 < 2; ++s2) { const bf16x8 bf_ = frag2(BB + ((2 * s2) * 64 + 32 * q + l31) * 8 + 4 * hh, BB + ((2 * s2 + 1) * 64 + 32 * q + l31) * 8 + 4 * hh);
                acc = __builtin_amdgcn_mfma_f32_32x32x16_bf16(gf[s2], bf_, acc, 0, 0, 0); }
            RW_STORE_TILE(acc, 12 + q * 2);
        }
#undef RW_STORE_TILE
        LDS_WAIT();
    }
}
__device__ __forceinline__ void rwkv_main(const Args& a, int l, LAS unsigned char* lds, int bh, int tid, int wave, int lane) {
    const unsigned char* RWP = a.ws + R_SI + 64 * MiB + (size_t)bh * 256 * RWP_CHUNK;
    const bf16_t* BON = (const bf16_t*)(a.ws + R_SI); const bf16_t* LO = (const bf16_t*)(a.ws + R_LO); bf16_t* MIX = (bf16_t*)(a.ws + R_MIX);
    LAS float* YB = (LAS float*)(lds + 45056);
    const int hh = lane >> 5, l31 = lane & 31, vb = wave;
    f32x16 st[2];
#pragma unroll
    for (int r = 0; r < 16; ++r) { st[0][r] = 0.f; st[1][r] = 0.f; }
    u32x4 g0, g1, g2 = zero4();
    g0 = *(const u32x4*)(RWP + tid * 16); g1 = *(const u32x4*)(RWP + (512 + tid) * 16); if (tid < 384) g2 = *(const u32x4*)(RWP + (1024 + tid) * 16);
    *(LAS u32x4*)(lds + tid * 16) = g0; *(LAS u32x4*)(lds + (512 + tid) * 16) = g1; if (tid < 384) *(LAS u32x4*)(lds + (1024 + tid) * 16) = g2;
    __syncthreads();
    const int jj = (bh & 3) * 64 + lane;
    const float lng = FIN(I_RWLG)[l * 256 + jj], lnb = FIN(I_RWLB)[l * 256 + jj];
    float pb_[4], pg_[4];
#define RW_POST_LOAD(cc_) do { _Pragma("unroll") for (int q_ = 0; q_ < 4; ++q_) { const size_t tok_ = (size_t)(bh >> 2) * SEQ + (size_t)(cc_) * 32 + wave * 4 + q_; pb_[q_] = bf2f(BON[tok_ * 256 + jj]); pg_[q_] = bf2f(LO[tok_ * 1024 + 512 + jj]); } } while (0)
#define RW_POST(cc_) do { const LAS float* yb_ = YB + ((cc_) & 1) * 2048; _Pragma("unroll") for (int q_ = 0; q_ < 4; ++q_) { const int t_ = wave * 4 + q_; const size_t tok_ = (size_t)(bh >> 2) * SEQ + (size_t)(cc_) * 32 + t_; \
        const float y_ = yb_[t_ * 64 + lane]; const float mean_ = wave_sum(y_) * (1.0f / 64.0f); const float d_ = y_ - mean_; const float var_ = wave_sum(d_ * d_) * (1.0f / 64.0f); \
        const float yn_ = d_ * __builtin_amdgcn_rsqf(var_ + 64e-5f) * lng + lnb; \
        MIX[tok_ * 1024 + 256 + jj] = (bf16_t)f2bf((yn_ + pb_[q_]) * pg_[q_]); } } while (0)
    for (int c = 0; c < 256; ++c) {
        const bool more = (c + 1 < 256);
        if (c > 0) RW_POST_LOAD(c - 1);
        if (more) { const unsigned char* nx = RWP + (size_t)(c + 1) * RWP_CHUNK; g0 = *(const u32x4*)(nx + tid * 16); g1 = *(const u32x4*)(nx + (512 + tid) * 16); if (tid < 384) g2 = *(const u32x4*)(nx + (1024 + tid) * 16); }
        if (wave < 2) {
            const LAS unsigned char* in = lds + (c & 1) * 22528;
#define RW_F(unit_) (*(const LAS bf16x8*)(in + (unit_) * 1024 + lane * 16))
            const bf16x8 vf0 = *(const LAS bf16x8*)(in + (18 + hh) * 1024 + (32 * vb + l31) * 16), vf1 = *(const LAS bf16x8*)(in + (20 + hh) * 1024 + (32 * vb + l31) * 16);
            bf16x8 hi[2][2], lo[2][2];
#pragma unroll
            for (int kb = 0; kb < 2; ++kb)
#pragma unroll
                for (int s2 = 0; s2 < 2; ++s2) { float xh[8], xl[8];
#pragma unroll
                    for (int j = 0; j < 8; ++j) { const float x = st[kb][8 * s2 + j]; const float hf = bf2f(f2bf(x)); xh[j] = hf; xl[j] = x - hf; }
                    hi[kb][s2] = __builtin_bit_cast(bf16x8, pack8(xh)); lo[kb][s2] = __builtin_bit_cast(bf16x8, pack8(xl)); }
            f32x16 y, n0, n1;
#pragma unroll
            for (int r = 0; r < 16; ++r) { y[r] = 0.f; n0[r] = 0.f; n1[r] = 0.f; }
#pragma unroll
            for (int kb = 0; kb < 2; ++kb)
#pragma unroll
                for (int s2 = 0; s2 < 2; ++s2) {
                    y = __builtin_amdgcn_mfma_f32_32x32x16_bf16(RW_F(8 + kb * 2 + s2), hi[kb][s2], y, 0, 0, 0);
                    const bf16x8 m0 = RW_F((kb * 2 + 0) * 2 + s2), m1 = RW_F((kb * 2 + 1) * 2 + s2);
                    n0 = __builtin_amdgcn_mfma_f32_32x32x16_bf16(m0, hi[kb][s2], n0, 0, 0, 0); n0 = __builtin_amdgcn_mfma_f32_32x32x16_bf16(m0, lo[kb][s2], n0, 0, 0, 0);
                    n1 = __builtin_amdgcn_mfma_f32_32x32x16_bf16(m1, hi[kb][s2], n1, 0, 0, 0); n1 = __builtin_amdgcn_mfma_f32_32x32x16_bf16(m1, lo[kb][s2], n1, 0, 0, 0);
                }
            y = __builtin_amdgcn_mfma_f32_32x32x16_bf16(RW_F(16), vf0, y, 0, 0, 0); y = __builtin_amdgcn_mfma_f32_32x32x16_bf16(RW_F(17), vf1, y, 0, 0, 0);
            n0 = __builtin_amdgcn_mfma_f32_32x32x16_bf16(RW_F(12), vf0, n0, 0, 0, 0); n0 = __builtin_amdgcn_mfma_f32_32x32x16_bf16(RW_F(13), vf1, n0, 0, 0, 0);
            n1 = __builtin_amdgcn_mfma_f32_32x32x16_bf16(RW_F(14), vf0, n1, 0, 0, 0); n1 = __builtin_amdgcn_mfma_f32_32x32x16_bf16(RW_F(15), vf1, n1, 0, 0, 0);
#undef RW_F
            LAS float* yo = YB + (c & 1) * 2048 + 32 * vb + l31;
#pragma unroll
            for (int r = 0; r < 16; ++r) yo[((r & 3) + 8 * (r >> 2) + 4 * hh) * 64] = y[r];
            st[0] = n0; st[1] = n1;
        }
        if (c > 0) RW_POST(c - 1);
        if (more) { LAS unsigned char* d = lds + ((c + 1) & 1) * 22528; *(LAS u32x4*)(d + tid * 16) = g0; *(LAS u32x4*)(d + (512 + tid) * 16) = g1; if (tid < 384) *(LAS u32x4*)(d + (1024 + tid) * 16) = g2; }
        __syncthreads();
    }
    RW_POST_LOAD(255); RW_POST(255);
#undef RW_POST
#undef RW_POST_LOAD
    __syncthreads();
}

__device__ __forceinline__ void rwkv_post(const Args& a, int l, int wave, int lane, int G) {
    const float* SI = (const float*)(a.ws + R_SI); const float* YR = (const float*)(a.ws + R_YRAW); const bf16_t* LO = (const bf16_t*)(a.ws + R_LO); bf16_t* MIX = (bf16_t*)(a.ws + R_MIX);
#pragma unroll 4
    for (int idx = blockIdx.x * NWAVES + wave; idx < T * 4; idx += G * NWAVES) {
        const size_t t = idx >> 2; const int h = idx & 3, j = h * 64 + lane;
        const float y = YR[t * 256 + j];
        const float mean = wave_sum(y) * (1.0f / 64.0f); const float d = y - mean; const float var = wave_sum(d * d) * (1.0f / 64.0f);
        const float yn = d * __builtin_amdgcn_rsqf(var + 64e-5f) * FIN(I_RWLG)[l * 256 + j] + FIN(I_RWLB)[l * 256 + j];
        const float bonus = bf2f(((const bf16_t*)SI)[t * 256 + j]);
        const float g = bf2f(LO[t * 1024 + 512 + j]);
        MIX[t * 1024 + 256 + j] = (bf16_t)f2bf((yn + bonus) * g);
    }
}

__device__ __forceinline__ void phase_norm2(const Args& a, int l, LAS unsigned char* lds, int tid, int wave, int lane, int G) {
    LAS unsigned char* img_hi = lds; LAS unsigned char* img_lo = lds + 65536;
    LAS float* pbuf = (LAS float*)lds;
    LAS int* hist = (LAS int*)(lds + 135168);
    const float* rw = FIN(I_RTW) + (size_t)l * 1024 * 32;
    const float* MOD = (const float*)(a.ws + WS_MOD);
    int* tki = (int*)(a.ws + MO_IDX); float* tkw = (float*)(a.ws + MO_W); int* blkcnt = (int*)(a.ws + MO_BLKCNT);
    const float* gn = FIN(I_NFG) + l * D;
    const int hh = lane >> 5, l31 = lane & 31;
    bf16x8 whi[8], wlo[8];
#pragma unroll
    for (int s = 0; s < 8; ++s) { float xh[8], xl[8];
#pragma unroll
        for (int i = 0; i < 8; ++i) { const float w = rw[(size_t)(128 * wave + 16 * s + 8 * hh + i) * 32 + l31]; const float hf = bf2f(f2bf(w)); xh[i] = hf; xl[i] = w - hf; }
        whi[s] = __builtin_bit_cast(bf16x8, pack8(xh)); wlo[s] = __builtin_bit_cast(bf16x8, pack8(xl)); }
    const float rbias = FIN(I_RTB)[l * 32 + l31];
    for (int rb = blockIdx.x; rb < 256; rb += G) {
        if (tid < 32) hist[tid] = 0;
        f32x4 gsc[4], shv[4];
        { const int b0 = (rb * 256) >> 13; const float* sh = MOD + (size_t)(l * 8 + b0) * 6144 + 3072; const float* sc = sh + 1024;
#pragma unroll
          for (int j = 0; j < 4; ++j) { gsc[j] = ((const f32x4*)gn)[64 * j + lane] * (1.0f + ((const f32x4*)sc)[64 * j + lane]); shv[j] = ((const f32x4*)sh)[64 * j + lane]; } }
        f32x4 v[4][4];
#pragma unroll
        for (int q = 0; q < 4; ++q)
#pragma unroll
            for (int j = 0; j < 4; ++j) v[q][j] = ((const f32x4*)(a.out + (size_t)(rb * 256 + 4 * wave + q) * D))[64 * j + lane];
        for (int sbt = 0; sbt < 8; ++sbt) {
            const int mb = rb * 256 + sbt * 32;
#pragma unroll
            for (int q = 0; q < 4; ++q) { const int row = 4 * wave + q, m = mb + row; float ss = 0.f;
#pragma unroll
                for (int j = 0; j < 4; ++j) ss += (v[q][j].x * v[q][j].x + v[q][j].y * v[q][j].y) + (v[q][j].z * v[q][j].z + v[q][j].w * v[q][j].w);
                ss = wave_sum(ss);
                const float rstd = __builtin_amdgcn_rsqf(ss * (1.0f / D) + NORM_EPS);
#pragma unroll
                for (int j = 0; j < 4; ++j) { const f32x4 hq = v[q][j] * rstd * gsc[j] + shv[j]; ((unsigned*)(a.ws + WS_HN8 + (size_t)m * D))[64 * j + lane] = pk4_fp8(hq.x, hq.y, hq.z, hq.w);
                    u32x2 wh, wl; wh.x = cvt_pk_bf16(hq.x, hq.y); wh.y = cvt_pk_bf16(hq.z, hq.w);
                    wl.x = cvt_pk_bf16(hq.x - bflo(wh.x), hq.y - bfhi(wh.x)); wl.y = cvt_pk_bf16(hq.z - bflo(wh.y), hq.w - bfhi(wh.y));
                    const int off = row * 2048 + (((32 * j + (lane >> 1)) ^ (row & 15)) << 4) + ((lane & 1) << 3);
                    *(LAS u32x2*)(img_hi + off) = wh; *(LAS u32x2*)(img_lo + off) = wl; } }
            if (sbt < 7) {
#pragma unroll
                for (int q = 0; q < 4; ++q)
#pragma unroll
                    for (int j = 0; j < 4; ++j) v[q][j] = ((const f32x4*)(a.out + (size_t)(mb + 32 + 4 * wave + q) * D))[64 * j + lane];
            }
            LDS_BARRIER();
            f32x16 acc;
#pragma unroll
            for (int r = 0; r < 16; ++r) acc[r] = 0.f;
#pragma unroll
            for (int s = 0; s < 8; ++s) { const int off = l31 * 2048 + (((16 * wave + 2 * s + hh) ^ (l31 & 15)) << 4);
                const bf16x8 bh = *(const LAS bf16x8*)(img_hi + off), bl = *(const LAS bf16x8*)(img_lo + off);
                acc = __builtin_amdgcn_mfma_f32_32x32x16_bf16(whi[s], bh, acc, 0, 0, 0);
                acc = __builtin_amdgcn_mfma_f32_32x32x16_bf16(wlo[s], bh, acc, 0, 0, 0);
                acc = __builtin_amdgcn_mfma_f32_32x32x16_bf16(whi[s], bl, acc, 0, 0, 0); }
            LDS_BARRIER();
#pragma unroll
            for (int r = 0; r < 16; ++r) pbuf[wave * 1056 + ((r & 3) + 8 * (r >> 2) + 4 * hh) * 33 + l31] = acc[r];
            LDS_BARRIER();
            {
                float val[4]; float tv[4][4]; int ti[4][4];
#pragma unroll
                for (int q = 0; q < 4; ++q) { float sacc = 0.f;
#pragma unroll
                    for (int w2 = 0; w2 < 8; ++w2) sacc += pbuf[w2 * 1056 + l31 * 33 + 4 * wave + q];
                    val[q] = sacc + rbias; }
#pragma unroll
                for (int k = 0; k < 4; ++k) {
#pragma unroll
                    for (int q = 0; q < 4; ++q) { float mxv = val[q];
                        mxv = fmaxf(mxv, dpp_f<0xB1>(mxv)); mxv = fmaxf(mxv, dpp_f<0x4E>(mxv)); mxv = fmaxf(mxv, dpp_f<0x141>(mxv)); mxv = fmaxf(mxv, dpp_f<0x140>(mxv));
                        mxv = fmaxf(mxv, __builtin_bit_cast(float, __builtin_amdgcn_ds_swizzle(__builtin_bit_cast(int, mxv), 0x401F)));
                        const unsigned bal = (unsigned)__builtin_amdgcn_ballot_w64(val[q] == mxv);
                        const int idx = __builtin_ctz(bal);
                        tv[q][k] = mxv; ti[q][k] = idx; if ((lane & 31) == idx) val[q] = -__builtin_inff(); } }
#pragma unroll
                for (int q = 0; q < 4; ++q) { const int m = mb + 4 * wave + q;
                    const float e1 = __expf(tv[q][1] - tv[q][0]), e2 = __expf(tv[q][2] - tv[q][0]), e3 = __expf(tv[q][3] - tv[q][0]); const float inv = __builtin_amdgcn_rcpf(1.0f + e1 + e2 + e3);
                    if (lane == 0) {
                        tki[m * 4] = ti[q][0]; tki[m * 4 + 1] = ti[q][1]; tki[m * 4 + 2] = ti[q][2]; tki[m * 4 + 3] = ti[q][3];
                        tkw[m * 4] = inv; tkw[m * 4 + 1] = e1 * inv; tkw[m * 4 + 2] = e2 * inv; tkw[m * 4 + 3] = e3 * inv;
                        lds_add(&hist[ti[q][0]]); lds_add(&hist[ti[q][1]]); lds_add(&hist[ti[q][2]]); lds_add(&hist[ti[q][3]]); } }
            }
            LDS_BARRIER();
        }
        if (tid < 32) blkcnt[rb * 32 + tid] = hist[tid];
        __syncthreads();
    }
}
__device__ __forceinline__ void phase_plan(const Args& a, LAS unsigned char* lds, int tid, int G) {
    LAS int* tot = (LAS int*)lds; LAS int* base = tot + 32; LAS int* pstart = tot + 64; LAS int* cur = tot + 96;
    const int* blkcnt = (const int*)(a.ws + MO_BLKCNT); const int* tki = (const int*)(a.ws + MO_IDX);
    int* pos = (int*)(a.ws + MO_POS); int* rowtok = (int*)(a.ws + MO_ROWTOK); int* tile_e = (int*)(a.ws + MO_TILEE);
    unsigned* ctl = (unsigned*)(a.ws + WS_CTL);
    for (int rb = blockIdx.x; rb < 256; rb += G) {
        {
            LAS int* ptot = tot + 256; LAS int* pbase = tot + 768; const int e = tid & 31, part = tid >> 5; int c[16]; int t = 0, bs = 0;
#pragma unroll
            for (int j = 0; j < 16; ++j) c[j] = blkcnt[(part * 16 + j) * 32 + e];
#pragma unroll
            for (int j = 0; j < 16; ++j) { if (part * 16 + j < rb) bs += c[j]; t += c[j]; }
            ptot[part * 32 + e] = t; pbase[part * 32 + e] = bs;
            __syncthreads();
            if (tid < 32) { int tt = 0, bb = 0;
#pragma unroll
                for (int p = 0; p < 16; ++p) { tt += ptot[p * 32 + tid]; bb += pbase[p * 32 + tid]; }
                tot[tid] = tt; base[tid] = bb; cur[tid] = 0; }
        }
        __syncthreads();
        if (tid == 0) { int ps = 0; for (int e = 0; e < 32; ++e) { pstart[e] = ps; ps += (tot[e] + 255) & ~255; } if (rb == 0) ctl[CW_NTILES] = (unsigned)(ps >> 8); }
        __syncthreads();
        for (int q = tid; q < 1024; q += NTHR) { const int row = rb * 256 + (q >> 2), k = q & 3; const int e = tki[row * 4 + k];
            const int r = lds_add(&cur[e]); const int p = pstart[e] + base[e] + r; pos[row * 4 + k] = p; rowtok[p] = row; }
        if (rb < 32) { const int e = rb, pe = pstart[e] + ((tot[e] + 255) & ~255); for (int p = pstart[e] + tot[e] + tid; p < pe; p += NTHR) rowtok[p] = 0;
            for (int tl = (pstart[e] >> 8) + tid; tl < (pe >> 8); tl += NTHR) tile_e[tl] = e; }
        __syncthreads();
    }
}

constexpr int PH_PER_LAYER = 13, NPH = 2 + DEPTH * PH_PER_LAYER;
#ifndef MK_SPLIT
#define MK_SPLIT 0
#endif
struct KArgs { Args a; int li, pad; };

__global__ void __launch_bounds__(NTHR, 2) fwd(KArgs ka) {
    extern __shared__ __attribute__((aligned(16))) unsigned char lds_raw[];
    LAS unsigned char* lds = (LAS unsigned char*)lds_raw;
    const int tid0 = threadIdx.x, G = gridDim.x, wave0 = __builtin_amdgcn_readfirstlane(tid0 >> 6);
    volatile LAS unsigned* MISC = (volatile LAS unsigned*)(lds + MISC_OFF);
    if (tid0 < 32) MISC[tid0] = 0u;
    __syncthreads();
    unsigned* ctl0 = (unsigned*)(ka.a.ws + WS_CTL);
    const int lo = ka.a.ph_lo, hi = ka.a.ph_hi;
    XcdBarrier bar; bar.bar = ctl0 + CW_BAR + ka.li * XCD_BAR_WORDS; bar.x = 0; bar.st = MISC + 8;
    if (hi - lo > 1) bar = xcd_barrier_post(ctl0 + CW_BAR + ka.li * XCD_BAR_WORDS, MISC + 8);
#ifndef MK_PHMASK
#define MK_PHMASK 0xFFFF
#endif
#define PHM(j) ((MK_PHMASK >> (j)) & 1)
#ifndef PROBE_DUP
#define PROBE_DUP 0
#endif
#define REP(id) for (int rep_ = 0; rep_ < 1 + ((PROBE_DUP >> (id)) & 1); ++rep_)
#define IN(k) (lo <= (k) && (k) < hi)
#define SEAM(k) do { if (IN(k) && IN((k) + 1)) xcd_barrier(bar); } while (0)

#define FRESH() int lane; asm volatile("v_mbcnt_lo_u32_b32 %0, -1, 0\n\tv_mbcnt_hi_u32_b32 %0, -1, %0" : "=v"(lane)); int wave = wave0; asm volatile("" : "+s"(wave)); const int tid = wave * 64 + lane; (void)tid; \
    Args a = ka.a; { size_t z_ = 0; asm volatile("" : "+s"(z_)); a.ws = ka.a.ws + z_; a.out = ka.a.out + z_; } \
    bf16_t* PROJ = (bf16_t*)(a.ws + R_PROJ); bf16_t* MIX = (bf16_t*)(a.ws + R_MIX); bf16_t* HN = (bf16_t*)(a.ws + WS_HN); const bf16_t* SM = (const bf16_t*)(a.ws + WS_WSM); unsigned* ctl = (unsigned*)(a.ws + WS_CTL); (void)PROJ; (void)MIX; (void)HN; (void)SM; (void)ctl
    if (PHM(0) && IN(0)) { FRESH(); phase_init(a, lds, tid, G); SEAM(0); }

    for (int l = 0; l < DEPTH; ++l) {
        const int pb = 1 + l * PH_PER_LAYER;
        const bool own01 = (l > 0) && (G == T / 256) && IN(pb + 0) && IN(pb + 1) && IN(pb - 3);
        if (PHM(1) && IN(pb + 0)) { FRESH(); if (!own01) { REP(0) phase_conv<0>(a, l, lds, tid, wave, lane, G); } phase_norm1<0>(a, l, wave, lane, G, false);
            SEAM(pb + 0); }
        if (PHM(2) && IN(pb + 1)) { FRESH();
            pg8::Gemm g{HN, (const bf16_t*)(a.ws + WS_WIN), 1024, 1024, 1024, nullptr}; pg8::Order S; S.init(T / 256, INWP / 256, G, (int)blockIdx.x);
            pg8::EpiBf16 E{PROJ, INWP, nullptr, 0};
            REP(1) pg8::gemm_phase<pg8::EpiBf16, false>(lds, g, S, E, tid);
            SEAM(pb + 1);
        }
        if (PHM(3) && IN(pb + 2)) { FRESH(); REP(2) phase_pre(a, l, tid, G); s5_repack(a, tid, G); SEAM(pb + 2); }
        if (PHM(4) && IN(pb + 3)) { FRESH();
            const bf16_t* AP = (const bf16_t*)(a.ws + R_AP); bf16_t* QKV = (bf16_t*)(a.ws + R_QKV); bf16_t* LO = (bf16_t*)(a.ws + R_LO); bf16_t* BU = (bf16_t*)(a.ws + R_BU);
#define SMALL_GEMM(A_, LDA_, BOFF_, NN_, O_, LDC_) do { pg8::Gemm g{A_, SM + (BOFF_) / 2, LDA_, 256, 256, nullptr}; pg8::Order S; S.init(T / 256, NN_, G, (int)blockIdx.x); \
                pg8::EpiBf16 E{O_, LDC_, nullptr, 0}; pg8::gemm_phase<pg8::EpiBf16, false>(lds, g, S, E, tid); } while (0)
            REP(3) {
            SMALL_GEMM(PROJ + C_QC, INWP, SM_WQ, 2, QKV, 1024);
            SMALL_GEMM(PROJ + C_KVC, INWP, SM_WKV, 2, QKV + 512, 1024);
            SMALL_GEMM(AP, 512, SM_WLORA, 3, LO, 1024);
            if (l > 0) SMALL_GEMM(AP + 256, 512, SM_WVV, 1, LO + 768, 1024);
            { pg8::Gemm g{(const bf16_t*)(a.ws + R_UP), (const bf16_t*)(a.ws + R_WE), 768, 512, 512, nullptr}; pg8::Order S; S.init(128, 1, G, (int)blockIdx.x, (const int*)(a.ws + WS_S5TAB), (size_t)256 * 512);
              pg8::EpiS5E E{(float*)(a.ws + R_EB)}; pg8::gemm_phase<pg8::EpiS5E, false>(lds, g, S, E, tid); }
            }
#undef SMALL_GEMM
            SEAM(pb + 3);
        }
        if (PHM(5) && IN(pb + 4)) { FRESH();
            REP(4) mla_finish(a, lds, tid, G);
            REP(6) s5_chunk_scan(a, l, tid, G);
            __syncthreads();
            REP(7) ret_pass_a(a, lds, tid, wave, lane, G);
            SEAM(pb + 4);
        }
        if (PHM(6) && IN(pb + 5)) { FRESH();
            { pg8::Gemm g{(const bf16_t*)(a.ws + R_UP), (const bf16_t*)(a.ws + R_WY), 768, 768, 768, nullptr}; pg8::Order S; S.init(128, 2, G, (int)blockIdx.x, (const int*)(a.ws + WS_S5TAB), (size_t)512 * 768);
              pg8::EpiS5Y E{(bf16_t*)(a.ws + R_YG), PROJ, FIN(I_S5D) + l * 256}; pg8::gemm_phase<pg8::EpiS5Y, false>(lds, g, S, E, tid); }
            REP(9) { rwkv_pre(a, l, lds, wave, lane, G);
            __syncthreads(); }
            __syncthreads();
            REP(10) ret_pass_c(a, lds, tid, wave, lane, G);
            SEAM(pb + 5);
        }
        if (PHM(7) && IN(pb + 6)) { FRESH();
            pg8::Gemm g{(const bf16_t*)(a.ws + R_YG), SM + SM_WGLU / 2, 256, 256, 256, nullptr}; pg8::Order S; S.init(T / 256, 1, G > 64 ? G - 32 : G, G > 64 ? (int)blockIdx.x - 32 : (int)blockIdx.x);
            pg8::EpiGlu E{MIX, (const bf16_t*)(a.ws + R_YG), FIN(I_S5GB) + l * 256};
            if (G > 64) { if ((int)blockIdx.x < 32) rwkv_main(a, l, lds, (int)blockIdx.x, tid, wave, lane); else pg8::gemm_phase<pg8::EpiGlu, false>(lds, g, S, E, tid); }
            else { for (int bh = blockIdx.x; bh < 32; bh += G) rwkv_main(a, l, lds, bh, tid, wave, lane); pg8::gemm_phase<pg8::EpiGlu, false>(lds, g, S, E, tid); }
            __syncthreads();
            attn_queue(a, l, lds, (volatile LAS unsigned*)(lds + MISC_OFF + 64), ctl + CW_ATTQ + 64 * l, tid, wave, lane);
            SEAM(pb + 6);
        }
        if (PHM(8) && IN(pb + 7)) { FRESH();
        }
        if (PHM(9) && IN(pb + 8)) { FRESH();
            pg8::Gemm g{MIX, (const bf16_t*)(a.ws + WS_WOUT), 1024, 1024, 1024, nullptr}; pg8::Order S; S.init(T / 256, 4, G, (int)blockIdx.x);
            pg8::EpiResid E{l == 0 ? FIN(I_X) : a.out, a.out, (const float*)(a.ws + WS_MOD) + (size_t)(l * 8) * 6144 + 2048};
            const bool own = (G == T / 256) && IN(pb + 9);
            S.own = own ? 1 : 0;
            pg8::gemm_phase<pg8::EpiResid, false>(lds, g, S, E, tid);
            if (!own) SEAM(pb + 8);
        }
        if (PHM(10) && IN(pb + 9)) { FRESH(); REP(14) phase_norm2(a, l, lds, tid, wave, lane, G); SEAM(pb + 9); }
        if (PHM(11) && IN(pb + 10)) { FRESH(); REP(15) phase_plan(a, lds, tid, G);
            if (l + 1 < DEPTH && (G == T / 256) && IN(pb + PH_PER_LAYER) && IN(pb + PH_PER_LAYER + 1)) { __syncthreads(); phase_conv<0>(a, l + 1, lds, tid, wave, lane, G); }
            SEAM(pb + 10); }
        if (PHM(12) && IN(pb + 11)) { FRESH();
            const int ntiles = __builtin_amdgcn_readfirstlane((int)__hip_atomic_load(ctl + CW_NTILES, __ATOMIC_RELAXED, __HIP_MEMORY_SCOPE_AGENT));
            pg8::Gemm g{(const bf16_t*)(a.ws + WS_HN8), (const bf16_t*)(a.ws + WS_WGU), 512, 512, 512, (const int*)(a.ws + MO_ROWTOK)}; pg8::Order S; S.init(ntiles, 8, G, (int)blockIdx.x, (const int*)(a.ws + MO_TILEE), (size_t)2048 * 512);
            pg8::EpiSwiglu E{a.ws + R_H, FIN(I_EBG) + (size_t)l * 32 * 1024, FIN(I_EBU) + (size_t)l * 32 * 1024};
            REP(16) pg8::gemm_phase<pg8::EpiSwiglu, true, true>(lds, g, S, E, tid);
            SEAM(pb + 11);
        }
        if (PHM(13) && IN(pb + 12)) { FRESH();
            const int ntiles = __builtin_amdgcn_readfirstlane((int)__hip_atomic_load(ctl + CW_NTILES, __ATOMIC_RELAXED, __HIP_MEMORY_SCOPE_AGENT));
            pg8::Gemm g{(const bf16_t*)(a.ws + R_H), (const bf16_t*)(a.ws + WS_WDN), 512, 512, 512, nullptr}; pg8::Order S; S.init(ntiles, 4, G, (int)blockIdx.x, (const int*)(a.ws + MO_TILEE), (size_t)1024 * 512);
            pg8::EpiBf16 E{(bf16_t*)(a.ws + R_Y), 1024, FIN(I_EBD) + (size_t)l * 32 * 1024, 1024, 1};
            REP(17) pg8::gemm_phase<pg8::EpiBf16, false, true>(lds, g, S, E, tid);
            SEAM(pb + 12);
        }
    }
    if (PHM(14) && IN(NPH - 1)) { FRESH(); phase_norm1<1>(a, DEPTH, wave, lane, G); }
#undef IN
#undef SEAM
}

extern "C" void kernel_launch(void* const* d_in, const int* in_sizes, int n_in, void* d_out, int out_size, void* d_ws, size_t ws_size, hipStream_t stream) {
    static int grid = 0;
    if (grid == 0) {
        if (n_in != 46 || in_sizes[0] != T * D || out_size != T * D || ws_size < WS_END) {
            fprintf(stderr, "kernel_launch: unexpected problem: n_in %d in0 %d out %d ws %zu (need %zu)\n", n_in, n_in > 0 ? in_sizes[0] : -1, out_size, ws_size, (size_t)WS_END); grid = -1; return; }
        int dev = 0, cus = 0;
        if (hipGetDevice(&dev) != hipSuccess || hipDeviceGetAttribute(&cus, hipDeviceAttributeMultiprocessorCount, dev) != hipSuccess) { fprintf(stderr, "kernel_launch: device query failed\n"); grid = -1; return; }
        if (hipFuncSetAttribute((const void*)fwd, hipFuncAttributeMaxDynamicSharedMemorySize, LDS_BYTES) != hipSuccess) { fprintf(stderr, "kernel_launch: hipFuncSetAttribute failed\n"); grid = -1; return; }
        int per_cu = 0;
        if (hipOccupancyMaxActiveBlocksPerMultiprocessor(&per_cu, (const void*)fwd, NTHR, LDS_BYTES) != hipSuccess || per_cu < 1) fprintf(stderr, "kernel_launch: occupancy query reports %d\n", per_cu);
        (void)hipGetLastError();
        grid = cus;
    }
    if (grid < 0) return;
    if (hipMemsetAsync((char*)d_ws + WS_CTL, 0, CTL_ZERO_BYTES, stream) != hipSuccess) { fprintf(stderr, "kernel_launch: memset failed\n"); return; }
    KArgs ka{};
    for (int i = 0; i < 46; ++i) ka.a.in[i] = d_in[i];
    ka.a.out = (float*)d_out; ka.a.ws = (unsigned char*)d_ws;
#if MK_SPLIT
    for (int p = 0; p < NPH; ++p) { ka.a.ph_lo = p; ka.a.ph_hi = p + 1; ka.li = p; ka.pad = 0;
        hipLaunchKernelGGL(fwd, dim3(grid), dim3(NTHR), LDS_BYTES, stream, ka);
        const hipError_t le = hipPeekAtLastError(); if (le != hipSuccess) { fprintf(stderr, "kernel_launch: launch %d failed: %s\n", p, hipGetErrorName(le)); break; } }
#else
    ka.a.ph_lo = 0; ka.a.ph_hi = NPH; ka.li = 0; ka.pad = 0;
    hipLaunchKernelGGL(fwd, dim3(grid), dim3(NTHR), LDS_BYTES, stream, ka);
    const hipError_t le = hipPeekAtLastError(); if (le != hipSuccess) fprintf(stderr, "kernel_launch: launch failed: %s\n", hipGetErrorName(le));
#endif
}
```

```cpp
#include <hip/hip_runtime.h>
#include <cstdint>
#include <cstdio>

#define LAS __attribute__((address_space(3)))
#define GAS __attribute__((address_space(1)))
typedef unsigned short bf16_t;
typedef short bf16x8 __attribute__((ext_vector_type(8)));
typedef float f32x2 __attribute__((ext_vector_type(2)));
typedef float f32x4 __attribute__((ext_vector_type(4)));
typedef float f32x16 __attribute__((ext_vector_type(16)));
typedef unsigned u32x2 __attribute__((ext_vector_type(2)));
typedef unsigned u32x4 __attribute__((ext_vector_type(4)));

constexpr int NB = 8, SEQ = 8192, T = NB * SEQ, D = 1024, DEPTH = 4;
constexpr int INW = 2464, INWP = 2560;
constexpr int C_S5 = 0, C_RWR = 256, C_RWK = 512, C_RWV = 768, C_RWWD = 1024, C_QC = 1280, C_KVC = 1536, C_KPE = 1664;
constexpr int C_RQ = 1696, C_RK = 1824, C_RV = 1952, C_RG = 2208;
constexpr int NE = 32, TOPK = 4, PMAX = 270336  , MAXTILES = 1056;
constexpr float NORM_EPS = 1e-5f;

constexpr size_t MiB = 1u << 20;
constexpr size_t WS_CTL = 0, CTL_ZERO_BYTES = 1 * MiB;
constexpr size_t WS_MOD = 1 * MiB;
constexpr size_t WS_ROPE = 2 * MiB;
constexpr size_t WS_WIN = 10 * MiB;
constexpr size_t WS_WOUT = 15 * MiB;
constexpr size_t WS_WSM = 17 * MiB;
constexpr size_t WS_WGU = 21 * MiB;
constexpr size_t WS_WDN = 149 * MiB;
constexpr size_t WS_HN8 = 85 * MiB;
constexpr size_t WS_HN = 213 * MiB;
constexpr size_t WS_VF = 341 * MiB;
constexpr size_t WS_MOE = 405 * MiB;
constexpr size_t WS_REG = 413 * MiB;
constexpr size_t R_PROJ = WS_REG;
constexpr size_t R_MIX = R_PROJ + 320 * MiB;
constexpr size_t R_AP = R_MIX + 128 * MiB;
constexpr size_t R_E = R_AP;
constexpr size_t R_CKV = R_AP + 8 * MiB;
constexpr size_t R_YG = R_AP + 24 * MiB;
constexpr size_t R_LO = R_AP + 64 * MiB;
constexpr size_t R_SI = R_LO + 128 * MiB;
constexpr size_t R_QKV = R_SI + 384 * MiB;
constexpr size_t R_YRAW = R_QKV;
constexpr size_t R_BU = R_QKV + 128 * MiB;
constexpr size_t R_UP = R_BU;
constexpr size_t R_EB = R_BU + 64 * MiB;
constexpr size_t R_WE = R_BU + 96 * MiB;
constexpr size_t R_WY = R_BU + 104 * MiB;
constexpr size_t WS_KD = R_BU + 120 * MiB;
constexpr size_t WS_S5TAB = R_BU + 124 * MiB;
constexpr size_t R_QB = R_BU + 256 * MiB;
constexpr size_t R_KT = R_QB + 48 * MiB;
constexpr size_t R_VT = R_KT + 48 * MiB;
constexpr size_t R_END = R_VT + 32 * MiB;
constexpr size_t R_H = WS_REG;
constexpr size_t R_Y = WS_REG + 528 * MiB;
constexpr size_t WS_END = R_END;
static_assert(R_Y + 528 * MiB <= R_END, "MoE overlay fits the region");
constexpr size_t SM_WQ = 0;
constexpr size_t SM_WKV = 256 * 1024;
constexpr size_t SM_WLORA = 512 * 1024;
constexpr size_t SM_WVV = 896 * 1024;
constexpr size_t SM_WGLU = 1024 * 1024;
constexpr size_t SM_WBU = 1152 * 1024;
constexpr size_t SM_WC = 2176 * 1024;
constexpr size_t MO_IDX = WS_MOE, MO_W = WS_MOE + 1 * MiB, MO_POS = WS_MOE + 2 * MiB, MO_ROWTOK = WS_MOE + 3 * MiB, MO_BLKCNT = WS_MOE + 5 * MiB, MO_TILEE = WS_MOE + 5 * MiB + 64 * 1024;
constexpr int CW_NTILES = 16, CW_ATTQ = 64  , CW_BAR = 4096;

constexpr int NWAVES = 8, NTHR = 512;
constexpr int LDS_BYTES = 147456;
constexpr int MISC_OFF = 131072 + 8192;


__device__ __forceinline__ float bf2f(unsigned h) { return __builtin_bit_cast(float, h << 16); }
__device__ __forceinline__ float bflo(unsigned w) { return __builtin_bit_cast(float, w << 16); }
__device__ __forceinline__ float bfhi(unsigned w) { return __builtin_bit_cast(float, w & 0xffff0000u); }
typedef __bf16 bf16x2_t __attribute__((ext_vector_type(2)));
__device__ __forceinline__ unsigned cvt_pk_bf16(float lo, float hi) { const f32x2 v = {lo, hi}; const bf16x2_t b = __builtin_convertvector(v, bf16x2_t); return __builtin_bit_cast(unsigned, b); }
__device__ __forceinline__ u32x4 zero4() { unsigned z = 0u; asm volatile("" : "+v"(z)); u32x4 w; w.x = z; w.y = z; w.z = z; w.w = z; return w; }
__device__ __forceinline__ unsigned pk2(float lo, float hi) { return cvt_pk_bf16(lo, hi); }
__device__ __forceinline__ unsigned f2bf(float f) { return cvt_pk_bf16(f, f) & 0xffffu; }
__device__ __forceinline__ unsigned pk4_fp8(float a0, float a1, float a2, float a3) { int w = 0; w = __builtin_amdgcn_cvt_pk_fp8_f32(a0, a1, w, false); w = __builtin_amdgcn_cvt_pk_fp8_f32(a2, a3, w, true); return (unsigned)w; }
__device__ __forceinline__ bf16_t cvt1(float x) { return (bf16_t)(cvt_pk_bf16(x, x) & 0xffffu); }
__device__ __forceinline__ float sigmoidf_(float x) { return __builtin_amdgcn_rcpf(1.0f + __expf(-x)); }
template <int CTRL> __device__ __forceinline__ float dpp_f(float v) { return __builtin_bit_cast(float, __builtin_amdgcn_update_dpp(0, __builtin_bit_cast(int, v), CTRL, 0xF, 0xF, true)); }
__device__ __forceinline__ float wave_sum(float v) {
    v += dpp_f<0xB1>(v);
    v += dpp_f<0x4E>(v);
    v += dpp_f<0x141>(v);
    v += dpp_f<0x140>(v);
    const float a = __builtin_bit_cast(float, __builtin_amdgcn_readlane(__builtin_bit_cast(int, v), 0));
    const float b = __builtin_bit_cast(float, __builtin_amdgcn_readlane(__builtin_bit_cast(int, v), 16));
    const float c = __builtin_bit_cast(float, __builtin_amdgcn_readlane(__builtin_bit_cast(int, v), 32));
    const float d = __builtin_bit_cast(float, __builtin_amdgcn_readlane(__builtin_bit_cast(int, v), 48));
    return (a + b) + (c + d);
}
template <int CTRL, int RM> __device__ __forceinline__ float dpp_fm(float v) { return __builtin_bit_cast(float, __builtin_amdgcn_update_dpp(0, __builtin_bit_cast(int, v), CTRL, RM, 0xF, false)); }
__device__ __forceinline__ float wave_sum_bc(float v) {
    v += dpp_f<0xB1>(v); v += dpp_f<0x4E>(v); v += dpp_f<0x141>(v); v += dpp_f<0x140>(v);
    v += dpp_fm<0x142, 0xA>(v);
    v += dpp_fm<0x143, 0xC>(v);
    return __builtin_bit_cast(float, __builtin_amdgcn_readlane(__builtin_bit_cast(int, v), 63));
}
__device__ __forceinline__ int lds_add(LAS int* p) { return __hip_atomic_fetch_add(p, 1, __ATOMIC_RELAXED, __HIP_MEMORY_SCOPE_WORKGROUP); }
__device__ __forceinline__ float wave_sum_shfl(float v) {
#pragma unroll
    for (int o = 1; o < 64; o <<= 1) v += __shfl_xor(v, o);
    return v;
}

namespace pg8 {
constexpr int BM = 256, BK = 64, HALF = 128, HTB = HALF * BK * 2, STAGE_BYTES = 8 * HTB, NXCD = 8, WGM = 8;
__host__ __device__ __forceinline__ int lds_byte(int r, int c) { const int st = (r >> 4) * 2 + (c >> 5), rr = r & 15, cc = c & 31, ob = rr * 64 + cc * 2; return st * 1024 + (ob ^ (((ob >> 9) & 1) << 5)); }
__host__ __device__ __forceinline__ void stage_rc(int b, int& R, int& C) { const int st = b / 1024, sb = b % 1024, swz = sb ^ (((sb >> 9) & 1) << 5); R = (st >> 1) * 16 + swz / 64; C = (st & 1) * 32 + (swz % 64) / 2; }
__host__ __device__ __forceinline__ int perm32(int rho) { const int n = rho >> 4, i = rho & 15; return 8 * (i >> 2) + 4 * n + (i & 3); }

struct Unit { int pm, pn; };
struct Gemm { const bf16_t* A; const bf16_t* Bt; int lda, ldb, K; const int* rowtok; };

struct Order {
    int nM, nN, nwg, G, c; const int* tile_e; size_t bstride;
    int own = 0;
    __device__ void init(int nM_, int nN_, int G_, int c_, const int* te = nullptr, size_t bs = 0) { nM = nM_; nN = nN_; nwg = nM * nN; G = G_; c = c_; tile_e = te; bstride = bs; }
    __device__ bool next(int i, Unit& u) const {
        if (own) { if (i >= nN) return false; u.pm = c; u.pn = i; return true; }
        const long L = (long)i * G + c; if (L >= nwg) return false;
        int wgid = (int)L; { const int q = nwg / NXCD, r = nwg % NXCD, xcd = wgid % NXCD, off = wgid / NXCD; wgid = (xcd < r ? xcd * (q + 1) : r * (q + 1) + (xcd - r) * q) + off; }
        const int nig = WGM * nN, gid = wgid / nig, fm = gid * WGM, gsz = (nM - fm) < WGM ? (nM - fm) : WGM;
        u.pm = fm + ((wgid % nig) % gsz); u.pn = (wgid % nig) / gsz; return true;
    }
    __device__ __forceinline__ int expert(const Unit& u) const { return tile_e ? __builtin_amdgcn_readfirstlane(tile_e[u.pm]) : 0; }
};

typedef int v8i_t __attribute__((ext_vector_type(8)));
template <class Epi, bool GATHER, bool FP8 = false>
__device__ __forceinline__ void gemm_phase(LAS unsigned char* lds, const Gemm g, const Order& S, const Epi& E, int tid_in) {
    int tid = tid_in; asm volatile("" : "+v"(tid));
    const int wid = __builtin_amdgcn_readfirstlane(tid >> 6), lane = tid & 63, wr = wid >> 2, wc = wid & 3, fr = lane & 15, fq = lane >> 4;
    const int K = g.K, nt = K / BK;
    int Rst[2], Cst[2];
    unsigned voffB[2], vAc[2][2], vAn[2][2];
#pragma unroll
    for (int i = 0; i < 2; ++i) { int R, C; stage_rc(tid * 16 + i * 8192, R, C); Rst[i] = R; Cst[i] = C; const int Rb = Epi::PERM ? ((R & ~31) + perm32(R & 31)) : R;
        voffB[i] = (unsigned)(Rb * g.ldb + C) * 2u; }
    const size_t kstep = (size_t)(BK * 2);
    const size_t hstepB = (size_t)HALF * g.ldb * 2;
    const unsigned ldsw = (unsigned)wid * 1024u;
    const int aoff = lds_byte(wr * 64 + fr, fq * 8), boff = lds_byte(wc * 32 + fr, fq * 8);
    const int aoff1 = aoff + 1024, boff1 = boff + 1024;
#define PG8_SA(b, h) (((b) * 2 + (h)) * HTB)
#define PG8_SB(b, h) ((4 + (b) * 2 + (h)) * HTB)
#define PG8_STAGE(bufoff, gbase, voff) do { _Pragma("unroll") for (int _i = 0; _i < 2; ++_i) \
        __builtin_amdgcn_global_load_lds((const unsigned*)((const char*)(gbase) + (voff)[_i]), (LAS unsigned*)(lds + (bufoff) + ldsw + _i * 8192), 16, 0, 0); } while (0)
#define PG8_LD8(p0, p1) __builtin_bit_cast(v8i_t, __builtin_shufflevector(*(const LAS u32x4*)(p0), *(const LAS u32x4*)(p1), 0, 1, 2, 3, 4, 5, 6, 7))
#define PG8_LDA(dst, b, h) do { _Pragma("unroll") for (int m = 0; m < 4; ++m) { if (FP8) { dst##8[m] = PG8_LD8(lds + PG8_SA(b, h) + aoff + m * 2048, lds + PG8_SA(b, h) + aoff1 + m * 2048); } \
        else { _Pragma("unroll") for (int k = 0; k < 2; ++k) dst[m][k] = *(const LAS bf16x8*)(lds + PG8_SA(b, h) + aoff + m * 2048 + k * 1024); } } } while (0)
#define PG8_LDB(dst, b, h) do { _Pragma("unroll") for (int n = 0; n < 2; ++n) { if (FP8) { dst##8[n] = PG8_LD8(lds + PG8_SB(b, h) + boff + n * 2048, lds + PG8_SB(b, h) + boff1 + n * 2048); } \
        else { _Pragma("unroll") for (int k = 0; k < 2; ++k) dst[n][k] = *(const LAS bf16x8*)(lds + PG8_SB(b, h) + boff + n * 2048 + k * 1024); } } } while (0)
#define PG8_V8(x) __builtin_bit_cast(v8i_t, __builtin_shufflevector(__builtin_bit_cast(u32x4, x[0]), __builtin_bit_cast(u32x4, x[1]), 0, 1, 2, 3, 4, 5, 6, 7))
#define PG8_MMA(ai, bj, At, Bt) do { __builtin_amdgcn_s_setprio(1); _Pragma("unroll") for (int m = 0; m < 4; ++m) _Pragma("unroll") for (int n = 0; n < 2; ++n) { \
        if (FP8) asm volatile("v_mfma_scale_f32_16x16x128_f8f6f4 %0, %1, %2, %0, %3, %4 op_sel_hi:[0,0,0]" : "+v"(acc[ai][bj][m][n]) : "v"(Bt##8[n]), "v"(At##8[m]), "v"(scB), "v"(scA)); \
        else { _Pragma("unroll") for (int k = 0; k < 2; ++k) acc[ai][bj][m][n] = __builtin_amdgcn_mfma_f32_16x16x32_bf16(Bt[n][k], At[m][k], acc[ai][bj][m][n], 0, 0, 0); } } __builtin_amdgcn_s_setprio(0); } while (0)
#define PG8_WAIT_V(n) asm volatile("s_waitcnt vmcnt(" #n ")" ::: "memory")
#define PG8_WAIT_L(n) asm volatile("s_waitcnt lgkmcnt(" #n ")" ::: "memory")
#define PG8_BAR __builtin_amdgcn_s_barrier()
#define PG8_SCHED __builtin_amdgcn_sched_barrier(0)
#define PG8_AOFFS(dst, unit) do { int _t = tid; if (GATHER) asm volatile("" : "+v"(_t)); _Pragma("unroll") for (int _h = 0; _h < 2; ++_h) _Pragma("unroll") for (int _i = 0; _i < 2; ++_i) { \
        if (GATHER) { int _R, _C; stage_rc(_t * 16 + _i * 8192, _R, _C);        \
            const int _tok = g.rowtok[(unit).pm * BM + _h * HALF + _R]; dst[_h][_i] = (unsigned)(_tok * g.lda + _C) * 2u; } \
        else dst[_h][_i] = (unsigned)((_h * HALF + Rst[_i]) * g.lda + Cst[_i]) * 2u; } } while (0)
    Unit cur, nxt; int ui = 0;
    if (!S.next(0, cur)) return;
    f32x4 acc[2][2][4][2];
#pragma unroll
    for (int a = 0; a < 2; ++a)
#pragma unroll
        for (int b = 0; b < 2; ++b)
#pragma unroll
            for (int m = 0; m < 4; ++m)
#pragma unroll
                for (int n = 0; n < 2; ++n) acc[a][b][m][n] = (f32x4){0.f, 0.f, 0.f, 0.f};
    bf16x8 At[4][2], B0[2][2], B1[2][2];
    v8i_t At8[4], B08[2], B18[2];
    const int scB = 0x7a7a7a7a, scA = 0x7f7f7f7f;
    const size_t tstepA = GATHER ? 0 : (size_t)BM * g.lda * 2, tstepB = (size_t)BM * g.ldb * 2;
    const char* cA = (const char*)g.A + (size_t)cur.pm * tstepA;
    const char* cB = (const char*)g.Bt + ((size_t)S.expert(cur) * S.bstride) * 2 + (size_t)cur.pn * tstepB;
    PG8_AOFFS(vAc, cur);
    if (GATHER) { asm volatile("s_waitcnt vmcnt(0)" ::: "memory"); }
    PG8_STAGE(PG8_SB(0, 0), cB, voffB); PG8_STAGE(PG8_SB(0, 1), cB + hstepB, voffB); PG8_STAGE(PG8_SA(0, 0), cA, vAc[0]); PG8_STAGE(PG8_SA(0, 1), cA, vAc[1]);
    if (wr == 1) PG8_BAR;
    PG8_WAIT_V(2); PG8_BAR;
    PG8_STAGE(PG8_SB(1, 0), cB + kstep, voffB); PG8_STAGE(PG8_SA(1, 0), cA + kstep, vAc[0]); PG8_STAGE(PG8_SB(1, 1), cB + hstepB + kstep, voffB);
    PG8_WAIT_V(6); PG8_BAR;
    for (;;) {
        if constexpr (Epi::PRE && FP8) { if (wid == 0) E.pre_dma(lds + 131072 + (ui & 1) * 1024, cur, S.expert(cur), fq * 16 + fr); }
        const bool has_next = S.next(ui + 1, nxt);
        const char* nA = cA; const char* nB = cB;
        if (has_next) { nA = (const char*)g.A + (size_t)nxt.pm * tstepA; nB = (const char*)g.Bt + ((size_t)S.expert(nxt) * S.bstride) * 2 + (size_t)nxt.pn * tstepB; PG8_AOFFS(vAn, nxt); }
        else {
#pragma unroll
            for (int h = 0; h < 2; ++h)
#pragma unroll
                for (int i = 0; i < 2; ++i) vAn[h][i] = vAc[h][i];
        }
        if (GATHER) { asm volatile("" : "+v"(vAn[0][0]), "+v"(vAn[0][1]), "+v"(vAn[1][0]), "+v"(vAn[1][1])); }
#pragma nounroll
        for (int t = 0; t < nt; t += 2) {
            const bool last = (t == nt - 2);
            const char* a1 = cA + (size_t)(t + 1) * kstep;
            const char* a2 = last ? nA : cA + (size_t)(t + 2) * kstep; const char* b2 = last ? nB : cB + (size_t)(t + 2) * kstep;
            const char* a3 = a2 + kstep; const char* b3 = b2 + kstep;
            unsigned v2[2][2];
#pragma unroll
            for (int h = 0; h < 2; ++h)
#pragma unroll
                for (int i = 0; i < 2; ++i) v2[h][i] = (GATHER && last) ? vAn[h][i] : vAc[h][i];
            PG8_LDB(B0, 0, 0); PG8_LDB(B1, 0, 1); PG8_SCHED; PG8_LDA(At, 0, 0); PG8_STAGE(PG8_SA(1, 1), a1, vAc[1]);
            PG8_WAIT_V(8); PG8_WAIT_L(0); PG8_BAR; PG8_MMA(0, 0, At, B0); PG8_MMA(0, 1, At, B1); PG8_BAR; PG8_SCHED;
            PG8_LDA(At, 0, 1); PG8_STAGE(PG8_SB(0, 0), b2, voffB); PG8_STAGE(PG8_SB(0, 1), b2 + hstepB, voffB); PG8_STAGE(PG8_SA(0, 0), a2, v2[0]);
            PG8_WAIT_V(8); PG8_WAIT_L(0); PG8_BAR; PG8_MMA(1, 0, At, B0); PG8_MMA(1, 1, At, B1); PG8_BAR; PG8_SCHED;
            PG8_LDB(B0, 1, 0); PG8_LDB(B1, 1, 1); PG8_SCHED; PG8_LDA(At, 1, 0); PG8_STAGE(PG8_SA(0, 1), a2, v2[1]);
            PG8_WAIT_V(8); PG8_WAIT_L(0); PG8_BAR; PG8_MMA(0, 0, At, B0); PG8_MMA(0, 1, At, B1); PG8_BAR; PG8_SCHED;
            PG8_LDA(At, 1, 1); PG8_STAGE(PG8_SB(1, 0), b3, voffB); PG8_STAGE(PG8_SB(1, 1), b3 + hstepB, voffB); PG8_STAGE(PG8_SA(1, 0), a3, v2[0]);
            PG8_WAIT_V(8); PG8_WAIT_L(0); PG8_BAR; PG8_MMA(1, 0, At, B0); PG8_MMA(1, 1, At, B1); PG8_BAR; PG8_SCHED;
        }
        if (wr == 0) PG8_BAR;
        if (FP8) asm volatile("s_nop 15\n\ts_nop 15" ::: "memory");
        if constexpr (Epi::PRE && FP8) E(acc, cur, S.expert(cur), wr, wc, fr, fq, (const LAS float*)(lds + 131072 + (ui & 1) * 1024)); else E(acc, cur, S.expert(cur), wr, wc, fr, fq);
        if (!has_next) break;
#pragma unroll
        for (int a = 0; a < 2; ++a)
#pragma unroll
            for (int b = 0; b < 2; ++b)
#pragma unroll
                for (int m = 0; m < 4; ++m)
#pragma unroll
                    for (int n = 0; n < 2; ++n) acc[a][b][m][n] = (f32x4){0.f, 0.f, 0.f, 0.f};
        cur = nxt; cA = nA; cB = nB; ++ui;
#pragma unroll
        for (int h = 0; h < 2; ++h)
#pragma unroll
            for (int i = 0; i < 2; ++i) vAc[h][i] = vAn[h][i];
        if (wr == 1) PG8_BAR;
    }
    PG8_WAIT_V(0);
    PG8_BAR;
#undef PG8_SA
#undef PG8_SB
#undef PG8_STAGE
#undef PG8_LDA
#undef PG8_LDB
#undef PG8_MMA
#undef PG8_V8
#undef PG8_LD8
#undef PG8_WAIT_V
#undef PG8_WAIT_L
#undef PG8_BAR
#undef PG8_SCHED
#undef PG8_AOFFS
}

struct EpiBf16 {
    static constexpr bool PERM = true; static constexpr bool PRE = true;
    bf16_t* O; int ldc; const float* bias; int bias_estride; int nt;
    __device__ __forceinline__ void pre_dma(LAS unsigned char* dst, const Unit& u, int e, int lane) const {
        __builtin_amdgcn_global_load_lds((const unsigned*)(bias + (size_t)e * bias_estride + u.pn * BM + 4 * lane), (LAS unsigned*)dst, 16, 0, 0); }
    __device__ __forceinline__ void operator()(const f32x4 (&acc)[2][2][4][2], const Unit& u, int e, int wr, int wc, int fr, int fq, const LAS float* pb = nullptr) const {
        asm volatile("" : "+v"(fq), "+v"(fr));
        const int row0 = u.pm * BM + wr * 64 + fr, col0 = u.pn * BM + wc * 32 + 8 * fq;
        f32x4 bv[2][2];
#pragma unroll
        for (int bj = 0; bj < 2; ++bj)
#pragma unroll
            for (int n = 0; n < 2; ++n) bv[bj][n] = pb ? *(const LAS f32x4*)(pb + wc * 32 + 8 * fq + bj * HALF + 4 * n) : (bias ? *(const f32x4*)(bias + (size_t)e * bias_estride + col0 + bj * HALF + 4 * n) : (f32x4){0.f, 0.f, 0.f, 0.f});
#pragma unroll
        for (int ai = 0; ai < 2; ++ai)
#pragma unroll
            for (int m = 0; m < 4; ++m) { bf16_t* rowp = O + (size_t)(row0 + ai * HALF + m * 16) * ldc + col0;
#pragma unroll
                for (int bj = 0; bj < 2; ++bj) { const f32x4 v0 = acc[ai][bj][m][0] + bv[bj][0], v1 = acc[ai][bj][m][1] + bv[bj][1];
                    u32x4 w; w.x = cvt_pk_bf16(v0[0], v0[1]); w.y = cvt_pk_bf16(v0[2], v0[3]); w.z = cvt_pk_bf16(v1[0], v1[1]); w.w = cvt_pk_bf16(v1[2], v1[3]);
                    if (nt) __builtin_nontemporal_store(w, (u32x4*)(rowp + bj * HALF)); else *(u32x4*)(rowp + bj * HALF) = w; } }
    }
};
struct EpiResid {
    static constexpr bool PERM = false; static constexpr bool PRE = false;
    const float* R; float* X; const float* gate;
    __device__ __forceinline__ void operator()(const f32x4 (&acc)[2][2][4][2], const Unit& u, int, int wr, int wc, int fr, int fq) const {
        asm volatile("" : "+v"(fq), "+v"(fr));
        const int col0 = u.pn * BM + wc * 32 + 4 * fq; const int b = (u.pm * BM) / SEQ;
        f32x4 gv[2][2];
#pragma unroll
        for (int bj = 0; bj < 2; ++bj)
#pragma unroll
            for (int n = 0; n < 2; ++n) gv[bj][n] = *(const f32x4*)(gate + (size_t)b * 6144 + col0 + bj * HALF + n * 16);
#pragma unroll
        for (int ai = 0; ai < 2; ++ai)
#pragma unroll
            for (int m = 0; m < 4; ++m) { const size_t off = (size_t)(u.pm * BM + ai * HALF + wr * 64 + m * 16 + fr) * D + col0;
#pragma unroll
                for (int bj = 0; bj < 2; ++bj)
#pragma unroll
                    for (int n = 0; n < 2; ++n) { const f32x4 r = *(const f32x4*)(R + off + bj * HALF + n * 16); *(f32x4*)(X + off + bj * HALF + n * 16) = r + gv[bj][n] * acc[ai][bj][m][n]; } }
    }
};
struct EpiSwiglu {
    static constexpr bool PERM = true; static constexpr bool PRE = true;
    unsigned char* H; const float* bg; const float* bu;
    __device__ __forceinline__ void pre_dma(LAS unsigned char* dst, const Unit& u, int e, int lane) const {
        const float* src = (lane < 32 ? bg : bu) + (size_t)e * 1024 + u.pn * HALF + 4 * (lane & 31);
        __builtin_amdgcn_global_load_lds((const unsigned*)src, (LAS unsigned*)dst, 16, 0, 0); }
    __device__ __forceinline__ void operator()(const f32x4 (&acc)[2][2][4][2], const Unit& u, int e, int wr, int wc, int fr, int fq, const LAS float* pb) const {
        asm volatile("" : "+v"(fq), "+v"(fr));
        const int row0 = u.pm * BM + wr * 64 + fr, col0 = u.pn * HALF + wc * 32 + 8 * fq;
        const int cl = wc * 32 + 8 * fq;
        f32x4 g0 = *(const LAS f32x4*)(pb + cl), g1 = *(const LAS f32x4*)(pb + cl + 4);
        f32x4 u0 = *(const LAS f32x4*)(pb + 128 + cl), u1 = *(const LAS f32x4*)(pb + 128 + cl + 4);
#pragma unroll
        for (int ai = 0; ai < 2; ++ai)
#pragma unroll
            for (int m = 0; m < 4; ++m) {
                float o[8];
#pragma unroll
                for (int n = 0; n < 2; ++n)
#pragma unroll
                    for (int j = 0; j < 4; ++j) {
                        float gt = acc[ai][0][m][n][j] + (n ? g1[j] : g0[j]); gt = fminf(gt, 7.0f);
                        float up = acc[ai][1][m][n][j] + (n ? u1[j] : u0[j]); up = fminf(fmaxf(up, -7.0f), 7.0f);
                        o[n * 4 + j] = gt * sigmoidf_(1.702f * gt) * (up + 1.0f);
                    }
                u32x2 w; w.x = pk4_fp8(o[0], o[1], o[2], o[3]); w.y = pk4_fp8(o[4], o[5], o[6], o[7]);
                *(u32x2*)(H + (size_t)(row0 + ai * HALF + m * 16) * 1024 + col0) = w;
            }
    }
};
struct EpiS5C {
    static constexpr bool PERM = true; static constexpr bool PRE = false;
    bf16_t* YG; const bf16_t* PROJ; const float* dskip;
    __device__ __forceinline__ void operator()(const f32x4 (&acc)[2][2][4][2], const Unit& u, int, int wr, int wc, int fr, int fq) const {
        asm volatile("" : "+v"(fq), "+v"(fr));
        const int row0 = u.pm * BM + wr * 64 + fr, col0 = wc * 32 + 8 * fq;
#pragma unroll
        for (int ai = 0; ai < 2; ++ai)
#pragma unroll
            for (int m = 0; m < 4; ++m) { const size_t row = (size_t)(row0 + ai * HALF + m * 16);
#pragma unroll
                for (int bj = 0; bj < 2; ++bj) { const int c = col0 + bj * HALF;
                    const u32x4 uu = *(const u32x4*)(PROJ + row * INWP + C_S5 + c);
                    const f32x4 d0 = *(const f32x4*)(dskip + c), d1 = *(const f32x4*)(dskip + c + 4);
                    float y[8]; const unsigned uw[4] = {uu.x, uu.y, uu.z, uu.w};
#pragma unroll
                    for (int j = 0; j < 8; ++j) { const float uj = (j & 1) ? bfhi(uw[j >> 1]) : bflo(uw[j >> 1]); const float dj = j < 4 ? d0[j & 3] : d1[j & 3];
                        const float v = acc[ai][bj][m][j >> 2][j & 3] + dj * uj;
                        const float tt = 0.7978845608028654f * (v + 0.044715f * v * v * v);
                        const float th = 1.0f - 2.0f * __builtin_amdgcn_rcpf(1.0f + __expf(2.0f * tt));
                        y[j] = 0.5f * v * (1.0f + th); }
                    u32x4 w; w.x = cvt_pk_bf16(y[0], y[1]); w.y = cvt_pk_bf16(y[2], y[3]); w.z = cvt_pk_bf16(y[4], y[5]); w.w = cvt_pk_bf16(y[6], y[7]);
                    *(u32x4*)(YG + row * 256 + c) = w; asm volatile("" ::: "memory"); } }
    }
};
struct EpiS5E {
    static constexpr bool PERM = false; static constexpr bool PRE = false;
    float* EB;
    __device__ __forceinline__ void operator()(const f32x4 (&acc)[2][2][4][2], const Unit& u, int, int wr, int wc, int fr, int fq) const {
        asm volatile("" : "+v"(fq), "+v"(fr));
#pragma unroll
        for (int ai = 0; ai < 2; ++ai)
#pragma unroll
            for (int m = 0; m < 4; ++m) { float* rp = EB + (size_t)(u.pm * BM + ai * HALF + wr * 64 + m * 16 + fr) * 128 + wc * 32 + 4 * fq;
#pragma unroll
                for (int n = 0; n < 2; ++n) *(f32x4*)(rp + n * 16) = acc[ai][0][m][n]; }
    }
};
struct EpiS5Y {
    static constexpr bool PERM = true; static constexpr bool PRE = false;
    bf16_t* YG; const bf16_t* PROJ; const float* dskip;
    __device__ __forceinline__ void operator()(const f32x4 (&acc)[2][2][4][2], const Unit& u, int, int wr, int wc, int fr, int fq) const {
        asm volatile("" : "+v"(fq), "+v"(fr));
        const int g = u.pm >> 3;
#pragma unroll
        for (int ai = 0; ai < 2; ++ai)
#pragma unroll
            for (int m = 0; m < 4; ++m) { const int chunk = (u.pm & 7) * BM + ai * HALF + wr * 64 + m * 16 + fr;
#pragma unroll
                for (int bj = 0; bj < 2; ++bj) { const int col = u.pn * BM + bj * HALF + wc * 32 + 8 * fq, tau = col >> 4, c = g * 16 + (col & 15); const size_t tok = (size_t)chunk * 32 + tau;
                    const u32x4 uu = *(const u32x4*)(PROJ + tok * INWP + C_S5 + c);
                    const f32x4 d0 = *(const f32x4*)(dskip + c), d1 = *(const f32x4*)(dskip + c + 4);
                    float y[8]; const unsigned uw[4] = {uu.x, uu.y, uu.z, uu.w};
#pragma unroll
                    for (int j = 0; j < 8; ++j) { const float uj = (j & 1) ? bfhi(uw[j >> 1]) : bflo(uw[j >> 1]); const float dj = j < 4 ? d0[j & 3] : d1[j & 3];
                        const float v = acc[ai][bj][m][j >> 2][j & 3] + dj * uj;
                        const float tt = 0.7978845608028654f * (v + 0.044715f * v * v * v);
                        const float th = 1.0f - 2.0f * __builtin_amdgcn_rcpf(1.0f + __expf(2.0f * tt));
                        y[j] = 0.5f * v * (1.0f + th); }
                    u32x4 w; w.x = cvt_pk_bf16(y[0], y[1]); w.y = cvt_pk_bf16(y[2], y[3]); w.z = cvt_pk_bf16(y[4], y[5]); w.w = cvt_pk_bf16(y[6], y[7]);
                    *(u32x4*)(YG + tok * 256 + c) = w; asm volatile("" ::: "memory"); } }
    }
};
struct EpiGlu {
    static constexpr bool PERM = true; static constexpr bool PRE = false;
    bf16_t* MIX; const bf16_t* YG; const float* gb;
    __device__ __forceinline__ void operator()(const f32x4 (&acc)[2][2][4][2], const Unit& u, int, int wr, int wc, int fr, int fq) const {
        asm volatile("" : "+v"(fq), "+v"(fr));
        const int row0 = u.pm * BM + wr * 64 + fr, col0 = wc * 32 + 8 * fq;
#pragma unroll
        for (int ai = 0; ai < 2; ++ai)
#pragma unroll
            for (int m = 0; m < 4; ++m) { const size_t row = (size_t)(row0 + ai * HALF + m * 16);
#pragma unroll
                for (int bj = 0; bj < 2; ++bj) { const int c = col0 + bj * HALF;
                    const u32x4 yy = *(const u32x4*)(YG + row * 256 + c);
                    const f32x4 b0 = *(const f32x4*)(gb + c), b1 = *(const f32x4*)(gb + c + 4);
                    float o[8]; const unsigned yw[4] = {yy.x, yy.y, yy.z, yy.w};
#pragma unroll
                    for (int j = 0; j < 8; ++j) { const float yj = (j & 1) ? bfhi(yw[j >> 1]) : bflo(yw[j >> 1]); const float bj_ = j < 4 ? b0[j & 3] : b1[j & 3];
                        o[j] = yj * sigmoidf_(acc[ai][bj][m][j >> 2][j & 3] + bj_); }
                    u32x4 w; w.x = cvt_pk_bf16(o[0], o[1]); w.y = cvt_pk_bf16(o[2], o[3]); w.z = cvt_pk_bf16(o[4], o[5]); w.w = cvt_pk_bf16(o[6], o[7]);
                    *(u32x4*)(MIX + row * 1024 + c) = w; asm volatile("" ::: "memory"); } }
    }
};
}

#define XB_TMO      128
#define XB_XCNT(j)  (256  + 64 * (j))
#define XB_XSUB(j)  (1280 + 64 * (j))
#define XB_XGEN(j)  (2304 + 64 * (j))
#define XB_TOP      3328
#define XB_TOPGEN   3392
#define XCD_BAR_WORDS 3456
#define XB_SPIN_CAP (1u << 23)
__device__ __forceinline__ unsigned xb_ld(unsigned* p)              { return __hip_atomic_load(p, __ATOMIC_RELAXED, __HIP_MEMORY_SCOPE_AGENT); }
__device__ __forceinline__ unsigned xb_add(unsigned* p, unsigned v) { return __hip_atomic_fetch_add(p, v, __ATOMIC_RELAXED, __HIP_MEMORY_SCOPE_AGENT); }
__device__ __forceinline__ unsigned xb_xcc_id() { return (unsigned)__builtin_amdgcn_s_getreg((3 << 11) | 20) & 0xFu; }
#define XB_SPIN(cond, bar) do { unsigned _sp = 0; while (cond) { __builtin_amdgcn_s_sleep(1); \
    if ((++_sp & 255u) == 0u) { if (xb_ld(&(bar)[XB_TMO])) break; if (_sp > XB_SPIN_CAP) { atomicAdd(&(bar)[XB_TMO], 1u); break; } } } } while (0)
struct XcdBarrier { unsigned* bar; unsigned x; volatile LAS unsigned* st; };
__device__ __forceinline__ XcdBarrier xcd_barrier_post(unsigned* bar, volatile LAS unsigned* st) {
    XcdBarrier b; b.bar = bar; b.x = xb_xcc_id(); b.st = st;
    if (threadIdx.x == 0) (void)xb_add(&bar[XB_XCNT(b.x)], 1u);
    return b;
}
__device__ __forceinline__ void xcd_barrier_complete(unsigned* bar, unsigned x, unsigned& nloc, unsigned& nx) {
    const unsigned G = gridDim.x * gridDim.y * gridDim.z;
    unsigned sum, cnt, mine, sp = 0u;
    for (;;) {
        sum = 0u; cnt = 0u; mine = 0u;
#pragma unroll
        for (unsigned j = 0; j < 16; ++j) { const unsigned c = xb_ld(&bar[XB_XCNT(j)]); sum += c; cnt += (c > 0u) ? 1u : 0u; mine = (j == x) ? c : mine; }
        if (sum == G) break;
        __builtin_amdgcn_s_sleep(1);
        if ((++sp & 255u) == 0u) { if (xb_ld(&bar[XB_TMO])) break; if (sp > XB_SPIN_CAP) { atomicAdd(&bar[XB_TMO], 1u); break; } }
    }
    nloc = mine > 0u ? mine : 1u; nx = cnt > 0u ? cnt : 1u;
}
__device__ __forceinline__ void xcd_barrier(const XcdBarrier& b) {
    asm volatile("s_waitcnt vmcnt(0)" ::: "memory");
    __syncthreads();
    if (threadIdx.x == 0) {
        unsigned* bar = b.bar;
        __builtin_amdgcn_s_waitcnt(0);
        unsigned nloc = b.st[0], nx = b.st[1];
        if (nloc == 0u) { xcd_barrier_complete(bar, b.x, nloc, nx); b.st[0] = nloc; b.st[1] = nx; }
        const unsigned old = xb_add(&bar[XB_XSUB(b.x)], 1u);
        const unsigned gen = old / nloc;
        if (old + 1u == (gen + 1u) * nloc) {
            __builtin_amdgcn_fence(__ATOMIC_RELEASE, "agent");
            asm volatile("s_waitcnt vmcnt(0)" ::: "memory");
            const unsigned og = xb_add(&bar[XB_TOP], 1u);
            const unsigned tg = og / nx;
            if (og + 1u == (tg + 1u) * nx) xb_add(&bar[XB_TOPGEN], 1u);
            else XB_SPIN(xb_ld(&bar[XB_TOPGEN]) == tg, bar);
            __builtin_amdgcn_fence(__ATOMIC_ACQUIRE, "agent");
            xb_add(&bar[XB_XGEN(b.x)], 1u);
            asm volatile("s_waitcnt vmcnt(0)" ::: "memory");
        } else {
            XB_SPIN(xb_ld(&bar[XB_XGEN(b.x)]) == gen, bar);
            __builtin_amdgcn_fence(__ATOMIC_ACQUIRE, "agent");
            asm volatile("s_waitcnt vmcnt(0)" ::: "memory");
        }
    }
    __syncthreads();
}

struct Args { const void* in[46]; float* out; unsigned char* ws; int ph_lo, ph_hi; };
enum { I_X = 0, I_C, I_POS, I_ADAW, I_ADAB, I_NMG, I_NFG, I_WIN, I_WOUT, I_S5LR, I_S5LI, I_S5LS, I_S5BR, I_S5BI, I_S5CR, I_S5CI, I_S5D, I_S5GW, I_S5GB,
       I_RWMU, I_RWW0, I_RWW2, I_RWA0, I_RWA2, I_RWG2, I_RWKK, I_RWKA, I_RWRK, I_RWLG, I_RWLB, I_RWV0, I_RWV1, I_RWV2,
       I_MQG, I_MKVG, I_MWQ, I_MWKV, I_RTW, I_RTB, I_EWG, I_EBG, I_EWU, I_EBU, I_EWD, I_EBD, I_FNG };
#define FIN(k) ((const float*)a.in[k])
__constant__ float ROPE_INV[16] = {1.000000000e+00f, 5.623413324e-01f, 3.162277639e-01f, 1.778279394e-01f, 1.000000015e-01f, 5.623413250e-02f, 3.162277490e-02f, 1.778279431e-02f,
                                   9.999999776e-03f, 5.623413250e-03f, 3.162277630e-03f, 1.778279431e-03f, 1.000000047e-03f, 5.623413017e-04f, 3.162277571e-04f, 1.778279402e-04f};
#define LDS_BARRIER() asm volatile("s_waitcnt lgkmcnt(0)\n\ts_barrier" ::: "memory")
#define LDS_WAIT() asm volatile("s_waitcnt lgkmcnt(0)" ::: "memory")

__device__ __forceinline__ void transpose_item_fp8(const float* W, int N, unsigned char* WT, int ldo, int k0, int n0, int drow0, LAS float* scr, int lane) {
#pragma unroll 8
    for (int i = 0; i < 32; ++i) { const int kk = 2 * i + (lane >> 5); scr[kk * 33 + (lane & 31)] = W[(size_t)(k0 + kk) * N + n0 + (lane & 31)]; }
    LDS_WAIT();
    const int c = lane & 7;
#pragma unroll
    for (int j = 0; j < 4; ++j) { const int n = (lane >> 3) + 8 * j; const LAS float* sp = scr + (8 * c) * 33 + n;
        u32x2 o; o.x = pk4_fp8(sp[0 * 33] * 32.f, sp[1 * 33] * 32.f, sp[2 * 33] * 32.f, sp[3 * 33] * 32.f); o.y = pk4_fp8(sp[4 * 33] * 32.f, sp[5 * 33] * 32.f, sp[6 * 33] * 32.f, sp[7 * 33] * 32.f);
        *(u32x2*)(WT + (size_t)(drow0 + n) * ldo + k0 + 8 * c) = o; }
    LDS_WAIT();
}
__device__ __forceinline__ void s5_lambda_bar(const Args& a, int l, int g, int p, float& lbr, float& lbi, float& fre, float& fim) {
    const float dt = __expf(FIN(I_S5LS)[l * 16 + g]);
    const float lr = FIN(I_S5LR)[(l * 16 + g) * 64 + p], li = FIN(I_S5LI)[(l * 16 + g) * 64 + p];
    const float mag = __expf(lr * dt);
    const float ang = li * dt;
    double x = (double)ang * 0.15915494309189535; x -= __builtin_rint(x);
    const float fr = (float)x;
    lbr = mag * __builtin_amdgcn_cosf(fr); lbi = mag * __builtin_amdgcn_sinf(fr);
    const float den = lr * lr + li * li, nre = lbr - 1.0f;
    fre = (nre * lr + lbi * li) / den; fim = (lbi * lr - nre * li) / den;
}
__device__ __forceinline__ void phase_init(const Args& a, LAS unsigned char* lds, int tid, int G) {
    LAS float* sc = (LAS float*)lds;
    const float* c = FIN(I_C);
    for (int i = tid; i < 8192; i += NTHR) { const float v = c[i]; sc[i] = v / (1.0f + __expf(-v)); }
    __syncthreads();
    float* MOD = (float*)(a.ws + WS_MOD);
    {
        LAS float* red = (LAS float*)(lds + 65536);
        const bool wide = (G >= 256);
        int item0 = (int)blockIdx.x; if (wide) item0 = (int)blockIdx.x < 64 ? (int)blockIdx.x : ((int)blockIdx.x >= 128 ? (int)blockIdx.x - 64 : 1 << 20);
        for (int item = item0; item < 192; item += (wide ? (1 << 20) : G)) {
            const int l = item / 48, cl = tid & 127, kq = tid >> 7, col = (item % 48) * 128 + cl;
            float acc[8];
#pragma unroll
            for (int b = 0; b < 8; ++b) acc[b] = 0.f;
            const float* w = FIN(I_ADAW) + (size_t)l * 1024 * 6144 + col;
#pragma unroll 8
            for (int k = kq * 256; k < kq * 256 + 256; ++k) { const float wv = w[(size_t)k * 6144];
#pragma unroll
                for (int b = 0; b < 8; ++b) acc[b] += sc[b * 1024 + k] * wv; }
#pragma unroll
            for (int b = 0; b < 8; ++b) red[(kq * 8 + b) * 128 + cl] = acc[b];
            __syncthreads();
            if (kq == 0) {
                const float bias = FIN(I_ADAB)[l * 6144 + col];
#pragma unroll
                for (int b = 0; b < 8; ++b) MOD[(size_t)(l * 8 + b) * 6144 + col] = bias + ((red[b * 128 + cl] + red[(8 + b) * 128 + cl]) + (red[(16 + b) * 128 + cl] + red[(24 + b) * 128 + cl])); }
            __syncthreads();
        }
    }
    {
        float* KD = (float*)(a.ws + WS_KD); int* tab = (int*)(a.ws + WS_S5TAB);
        if (blockIdx.x == 0 && tid < 128) tab[tid] = tid >> 3;
        LAS float* PW = (LAS float*)(lds + 32768);
        LAS float* BBl = PW + 32 * 64 * 2;
        LAS float* CCl = BBl + 64 * 16 * 2;
        for (int lg = (G >= 128 ? (int)blockIdx.x - 64 : (int)blockIdx.x); lg >= 0 && lg < DEPTH * 16; lg += G) {
            const int l = lg >> 4, g = lg & 15;
            __syncthreads();
            for (int i = tid; i < 32 * 64; i += NTHR) { const int p = i & 63, d = i >> 6;
                const float dt = __expf(FIN(I_S5LS)[l * 16 + g]), lr = FIN(I_S5LR)[(l * 16 + g) * 64 + p], li = FIN(I_S5LI)[(l * 16 + g) * 64 + p];
                const float mag = __expf((float)d * lr * dt); double x = (double)((float)d * (li * dt)) * 0.15915494309189535; x -= __builtin_rint(x);
                PW[i * 2] = mag * __builtin_amdgcn_cosf((float)x); PW[i * 2 + 1] = mag * __builtin_amdgcn_sinf((float)x); }
            for (int i = tid; i < 64 * 16; i += NTHR) { const int hq = i & 15, p = i >> 4; float lbr, lbi, fre, fim; s5_lambda_bar(a, l, g, p, lbr, lbi, fre, fim);
                const float bre = FIN(I_S5BR)[(((size_t)l * 16 + g) * 64 + p) * 16 + hq], bim = FIN(I_S5BI)[(((size_t)l * 16 + g) * 64 + p) * 16 + hq];
                BBl[i * 2] = fre * bre - fim * bim; BBl[i * 2 + 1] = fre * bim + fim * bre;
                const int hp = i >> 6, pp = i & 63;
                CCl[i * 2] = FIN(I_S5CR)[(((size_t)l * 16 + g) * 16 + hp) * 64 + pp]; CCl[i * 2 + 1] = FIN(I_S5CI)[(((size_t)l * 16 + g) * 16 + hp) * 64 + pp]; }
            __syncthreads();
            for (int i = tid; i < 32 * 256; i += NTHR) { const int hk = i & 255, d = i >> 8, hp = hk >> 4, hq = hk & 15; float acc = 0.f;
                for (int p = 0; p < 64; ++p) { const float pr = PW[(d * 64 + p) * 2], pi_ = PW[(d * 64 + p) * 2 + 1], bbr = BBl[(p * 16 + hq) * 2], bbi = BBl[(p * 16 + hq) * 2 + 1];
                    const float cr = CCl[(hp * 64 + p) * 2], ci = CCl[(hp * 64 + p) * 2 + 1];
                    const float tr = pr * bbr - pi_ * bbi, ti = pr * bbi + pi_ * bbr; acc += cr * tr - ci * ti; }
                KD[((size_t)lg * 32 + d) * 256 + hk] = acc; }
        }
        __syncthreads();
    }
    float* rope = (float*)(a.ws + WS_ROPE);
    const int* pos = (const int*)a.in[I_POS];
    for (int idx = blockIdx.x * NTHR + tid; idx < T * 16; idx += G * NTHR) {
        const int t = idx >> 4, i = idx & 15;
        const float ang = (float)pos[t] * ROPE_INV[i];
        double x = (double)ang * 0.15915494309189535; x -= __builtin_rint(x);
        const float fr = (float)x;
        rope[(size_t)idx * 2] = __builtin_amdgcn_cosf(fr); rope[(size_t)idx * 2 + 1] = __builtin_amdgcn_sinf(fr);
    }
    __syncthreads();
}

__device__ __forceinline__ void transpose_item(const float* W, int N, bf16_t* WT, int ldo, int k0, int n0, int drow0, LAS float* scr, int lane) {
#pragma unroll 8
    for (int i = 0; i < 32; ++i) { const int kk = 2 * i + (lane >> 5); scr[kk * 33 + (lane & 31)] = W[(size_t)(k0 + kk) * N + n0 + (lane & 31)]; }
    LDS_WAIT();
    const int c = lane & 7;
#pragma unroll
    for (int j = 0; j < 4; ++j) { const int n = (lane >> 3) + 8 * j; const LAS float* s = scr + (8 * c) * 33 + n;
        u32x4 o; o.x = pk2(s[0 * 33], s[1 * 33]); o.y = pk2(s[2 * 33], s[3 * 33]); o.z = pk2(s[4 * 33], s[5 * 33]); o.w = pk2(s[6 * 33], s[7 * 33]);
        *(u32x4*)(WT + (size_t)(drow0 + n) * ldo + k0 + 8 * c) = o; }
    LDS_WAIT();
}
__device__ __forceinline__ void conv_expert_item(const Args& a, int l, int bi, LAS float* scr, int wave, int lane) {
    unsigned char* WGU = a.ws + WS_WGU; unsigned char* WDN = a.ws + WS_WDN;
    for (int k = 0; k < 12; ++k) {
        const int r = bi * 96 + k * 8 + wave;
        const int e = r / 1536, mm = (r % 1536) / 512, q = r % 512, kb = q / 32, nb = q % 32, n0 = 32 * nb;
        const size_t eoff = ((size_t)l * 32 + e) * 1024 * 1024;
        if (mm == 0) transpose_item_fp8(FIN(I_EWG) + eoff, 1024, WGU + (size_t)e * 2048 * 1024, 1024, 64 * kb, n0, (n0 >> 7) * 256 + (n0 & 127), scr, lane);
        else if (mm == 1) transpose_item_fp8(FIN(I_EWU) + eoff, 1024, WGU + (size_t)e * 2048 * 1024, 1024, 64 * kb, n0, (n0 >> 7) * 256 + 128 + (n0 & 127), scr, lane);
        else transpose_item_fp8(FIN(I_EWD) + eoff, 1024, WDN + (size_t)e * 1024 * 1024, 1024, 64 * kb, n0, n0, scr, lane);
    }
}
template <int PART> __device__ __forceinline__ void phase_conv(const Args& a, int l, LAS unsigned char* lds, int tid, int wave, int lane, int G) {
    LAS float* scr = (LAS float*)(lds + wave * 8704);
    const int gw = blockIdx.x * NWAVES + wave, NGW = G * NWAVES;
    bf16_t* WIN = (bf16_t*)(a.ws + WS_WIN); bf16_t* WOUT = (bf16_t*)(a.ws + WS_WOUT); bf16_t* WGU = (bf16_t*)(a.ws + WS_WGU); bf16_t* WDN = (bf16_t*)(a.ws + WS_WDN);
    constexpr int I_A = 16 * 77, I_Z = 96, I_O = 512, I_E = 32 * 1536;
    for (int it = (PART == 0 ? gw : gw + I_A + I_Z + I_O); it < (PART == 0 ? I_A + I_Z + I_O : I_A + I_Z + I_O + I_E); it += NGW) {
        int r = it;
        if (r < I_A) { const int kb = r / 77, nb = r % 77; transpose_item(FIN(I_WIN) + (size_t)l * 1024 * INW, INW, WIN, 1024, 64 * kb, 32 * nb, 32 * nb, scr, lane); continue; } r -= I_A;
        if (r < I_Z) { u32x4 z = zero4(); u32x4* d = (u32x4*)(WIN + (size_t)(INW + r) * 1024);
#pragma unroll
            for (int j = 0; j < 2; ++j) d[j * 64 + lane] = z; continue; } r -= I_Z;
        if (r < I_O) { const int kb = r / 32, nb = r % 32; transpose_item(FIN(I_WOUT) + (size_t)l * 1024 * 1024, 1024, WOUT, 1024, 64 * kb, 32 * nb, 32 * nb, scr, lane); continue; } r -= I_O;
        const int e = r / 1536, mm = (r % 1536) / 512, q = r % 512, kb = q / 32, nb = q % 32, n0 = 32 * nb;
        const size_t eoff = ((size_t)l * 32 + e) * 1024 * 1024;
        if (mm == 0) transpose_item(FIN(I_EWG) + eoff, 1024, WGU + (size_t)e * 2048 * 1024, 1024, 64 * kb, n0, (n0 >> 7) * 256 + (n0 & 127), scr, lane);
        else if (mm == 1) transpose_item(FIN(I_EWU) + eoff, 1024, WGU + (size_t)e * 2048 * 1024, 1024, 64 * kb, n0, (n0 >> 7) * 256 + 128 + (n0 & 127), scr, lane);
        else transpose_item(FIN(I_EWD) + eoff, 1024, WDN + (size_t)e * 1024 * 1024, 1024, 64 * kb, n0, n0, scr, lane);
    }
    if (PART == 1) return;
    bf16_t* SM = (bf16_t*)(a.ws + WS_WSM);
    const int gt = blockIdx.x * NTHR + tid, NGT = G * NTHR;
    for (int i = gt; i < 512 * 256; i += NGT) { const int n = i >> 8, k = i & 255;
        const float vq = n < 384 ? FIN(I_MQG)[l * 256 + k] * FIN(I_MWQ)[((size_t)l * 256 + k) * 384 + n] : 0.f;
        const float vk = k < 128 ? FIN(I_MKVG)[l * 128 + k] * FIN(I_MWKV)[((size_t)l * 128 + k) * 512 + n] : 0.f;
        SM[SM_WQ / 2 + i] = (bf16_t)f2bf(vq); SM[SM_WKV / 2 + i] = (bf16_t)f2bf(vk); }
    for (int i = gt; i < 768 * 256; i += NGT) { const int n = i >> 8, k = i & 255; float v = 0.f;
        if (n < 256) { if (k < 64) v = FIN(I_RWW2)[((size_t)l * 64 + k) * 256 + n]; }
        else if (n < 512) { if (k >= 64 && k < 128) v = FIN(I_RWA2)[((size_t)l * 64 + (k - 64)) * 256 + (n - 256)]; }
        else { if (k >= 128) v = FIN(I_RWG2)[((size_t)l * 128 + (k - 128)) * 256 + (n - 512)]; }
        SM[SM_WLORA / 2 + i] = (bf16_t)f2bf(v); }
    for (int i = gt; i < 256 * 256; i += NGT) { const int n = i >> 8, k = i & 255; float v = 0.f;
        if (l > 0) { const float* v1 = FIN(I_RWV1) + (size_t)(l - 1) * 256 * 32 + k * 32; const float* v2 = FIN(I_RWV2) + (size_t)(l - 1) * 32 * 256 + n;
#pragma unroll 8
            for (int m = 0; m < 32; ++m) v += v1[m] * v2[m * 256]; }
        SM[SM_WVV / 2 + i] = (bf16_t)f2bf(v);
        SM[SM_WGLU / 2 + i] = (bf16_t)f2bf(FIN(I_S5GW)[((size_t)l * 256 + k) * 256 + n]); }
    {
        bf16_t* WE = (bf16_t*)(a.ws + R_WE); bf16_t* WY = (bf16_t*)(a.ws + R_WY); const float* KD = (const float*)(a.ws + WS_KD) + (size_t)l * 16 * 32 * 256;
        for (int i0 = gt; i0 < 16 * 256 * 512; i0 += 4 * NGT) { float v4[4];
#pragma unroll
          for (int u = 0; u < 4; ++u) { const int i = i0 + u * NGT; const int k = i & 511, q = (i >> 9) & 255, g = i >> 17; float v = 0.f;
            if (q < 128 && i < 16 * 256 * 512) { const int p = q & 63, tau = k >> 4, h = k & 15; float lbr, lbi, fre, fim; s5_lambda_bar(a, l, g, p, lbr, lbi, fre, fim);
                const float bre = FIN(I_S5BR)[(((size_t)l * 16 + g) * 64 + p) * 16 + h], bim = FIN(I_S5BI)[(((size_t)l * 16 + g) * 64 + p) * 16 + h];
                const float bbr = fre * bre - fim * bim, bbi = fre * bim + fim * bre;
                const float dt = __expf(FIN(I_S5LS)[l * 16 + g]), lr = FIN(I_S5LR)[(l * 16 + g) * 64 + p], li = FIN(I_S5LI)[(l * 16 + g) * 64 + p]; const float d = (float)(31 - tau);
                const float mag = __expf(d * lr * dt); double x = (double)(d * (li * dt)) * 0.15915494309189535; x -= __builtin_rint(x);
                const float pr = mag * __builtin_amdgcn_cosf((float)x), pi_ = mag * __builtin_amdgcn_sinf((float)x);
                v = (q < 64) ? (pr * bbr - pi_ * bbi) : (pr * bbi + pi_ * bbr); }
            v4[u] = v; }
#pragma unroll
          for (int u = 0; u < 4; ++u) if (i0 + u * NGT < 16 * 256 * 512) WE[i0 + u * NGT] = (bf16_t)f2bf(v4[u]); }
        for (int i0 = gt; i0 < 16 * 512 * 768; i0 += 4 * NGT) { float v4[4];
#pragma unroll
          for (int u = 0; u < 4; ++u) { const int i = i0 + u * NGT; const int k = i % 768, n = (i / 768) & 511, g = i / (768 * 512), tau = n >> 4, hp = n & 15; float v = 0.f;
            if (i >= 16 * 512 * 768) { } else if (k < 512) { const int j = k >> 4, h = k & 15; if (j <= tau) v = KD[((g * 32 + (tau - j)) * 16 + hp) * 16 + h]; }
            else if (k < 640) { const int q = k - 512, p = q & 63;
                const float dt = __expf(FIN(I_S5LS)[l * 16 + g]), lr = FIN(I_S5LR)[(l * 16 + g) * 64 + p], li = FIN(I_S5LI)[(l * 16 + g) * 64 + p]; const float d = (float)(tau + 1);
                const float mag = __expf(d * lr * dt); double x = (double)(d * (li * dt)) * 0.15915494309189535; x -= __builtin_rint(x);
                const float pr = mag * __builtin_amdgcn_cosf((float)x), pi_ = mag * __builtin_amdgcn_sinf((float)x);
                const float cr = FIN(I_S5CR)[(((size_t)l * 16 + g) * 16 + hp) * 64 + p], ci = FIN(I_S5CI)[(((size_t)l * 16 + g) * 16 + hp) * 64 + p];
                v = (q < 64) ? (cr * pr - ci * pi_) : -(cr * pi_ + ci * pr); }
            v4[u] = v; }
#pragma unroll
          for (int u = 0; u < 4; ++u) if (i0 + u * NGT < 16 * 512 * 768) WY[i0 + u * NGT] = (bf16_t)f2bf(v4[u]); }
    }
}

template <int MODE>
__device__ __forceinline__ void phase_norm1(const Args& a, int l, int wave, int lane, int G, bool own = false) {
    const int gw = blockIdx.x * NWAVES + wave, NGW = G * NWAVES;
    const int m0 = own ? (int)blockIdx.x * 256 + wave : gw, ms = own ? NWAVES : NGW, mend = own ? (int)blockIdx.x * 256 + 256 : T;
    const float* MOD = (const float*)(a.ws + WS_MOD);
    const int* pos = (const int*)(a.ws + MO_POS); const float* tw = (const float*)(a.ws + MO_W);
    const bf16_t* Y = (const bf16_t*)(a.ws + R_Y);
    bf16_t* HN = (bf16_t*)(a.ws + WS_HN);
#pragma unroll 2
    for (int m = m0; m < mend; m += ms) {
        const int b = m >> 13;
        const float* xr = (l == 0 ? FIN(I_X) : a.out) + (size_t)m * D;
        f32x4 v[4];
#pragma unroll
        for (int j = 0; j < 4; ++j) v[j] = ((const f32x4*)xr)[64 * j + lane];
        if (l > 0) {
            f32x4 acc[4];
#pragma unroll
            for (int j = 0; j < 4; ++j) acc[j] = (f32x4){0.f, 0.f, 0.f, 0.f};
#pragma unroll
            for (int k = 0; k < 4; ++k) { const int p = pos[m * 4 + k]; const float w = tw[m * 4 + k]; const u32x2* yr = (const u32x2*)(Y + (size_t)p * 1024);
#pragma unroll
                for (int j = 0; j < 4; ++j) { const u32x2 yy = __builtin_nontemporal_load(yr + 64 * j + lane); acc[j] += w * (f32x4){bflo(yy.x), bfhi(yy.x), bflo(yy.y), bfhi(yy.y)}; } }
            const float* g2 = MOD + (size_t)((l - 1) * 8 + b) * 6144 + 5120;
#pragma unroll
            for (int j = 0; j < 4; ++j) { v[j] += ((const f32x4*)g2)[64 * j + lane] * acc[j]; ((f32x4*)(a.out + (size_t)m * D))[64 * j + lane] = v[j]; }
        }
        float ss = 0.f;
#pragma unroll
        for (int j = 0; j < 4; ++j) ss += (v[j].x * v[j].x + v[j].y * v[j].y) + (v[j].z * v[j].z + v[j].w * v[j].w);
        ss = wave_sum(ss);
        const float rstd = __builtin_amdgcn_rsqf(ss * (1.0f / D) + NORM_EPS);
        if (MODE == 0) {
            const float* gn = FIN(I_NMG) + l * D; const float* sh = MOD + (size_t)(l * 8 + b) * 6144; const float* sc = sh + 1024;
            u32x2* o = (u32x2*)(HN + (size_t)m * D);
#pragma unroll
            for (int j = 0; j < 4; ++j) { const f32x4 g = ((const f32x4*)gn)[64 * j + lane], s1 = ((const f32x4*)sc)[64 * j + lane], s0 = ((const f32x4*)sh)[64 * j + lane];
                const f32x4 h = v[j] * rstd * g * (1.0f + s1) + s0; u32x2 w; w.x = pk2(h.x, h.y); w.y = pk2(h.z, h.w); o[64 * j + lane] = w; }
        } else {
            const float* gn = FIN(I_FNG);
#pragma unroll
            for (int j = 0; j < 4; ++j) { const f32x4 g = ((const f32x4*)gn)[64 * j + lane]; ((f32x4*)(a.out + (size_t)m * D))[64 * j + lane] = v[j] * rstd * g; }
        }
    }
}

__device__ __forceinline__ void phase_pre(const Args& a, int l, int tid, int G) {
    const bf16_t* PROJ = (const bf16_t*)(a.ws + R_PROJ); bf16_t* AP = (bf16_t*)(a.ws + R_AP);
    const float* mu = FIN(I_RWMU) + l * 1024;
    const int stride = G * NTHR;
    float muv[8];
    { const int ch0 = tid & 63, mi0 = ch0 < 32 ? (768 + ch0 * 8) : (512 + (ch0 - 32) * 8);
#pragma unroll
      for (int j = 0; j < 8; ++j) muv[j] = mu[mi0 + j]; }
    for (int idx0 = blockIdx.x * NTHR + tid; idx0 < T * 64; idx0 += 4 * stride) {
        u32x4 cu[4], pv[4];
#pragma unroll
        for (int u = 0; u < 4; ++u) { const int idx = idx0 + u * stride; cu[u] = zero4(); pv[u] = zero4();
            if (idx < T * 64) { const int t = idx >> 6, ch = idx & 63; const int pc = ch < 32 ? (C_RWWD + ch * 8) : (C_RWV + (ch - 32) * 8);
                cu[u] = *(const u32x4*)(PROJ + (size_t)t * INWP + pc); if ((t & (SEQ - 1)) != 0) pv[u] = *(const u32x4*)(PROJ + (size_t)(t - 1) * INWP + pc); } }
#pragma unroll
        for (int u = 0; u < 4; ++u) { const int idx = idx0 + u * stride; if (idx >= T * 64) break;
            const int t = idx >> 6, ch = idx & 63;
            const unsigned cw[4] = {cu[u].x, cu[u].y, cu[u].z, cu[u].w}, pw[4] = {pv[u].x, pv[u].y, pv[u].z, pv[u].w};
            float o[8];
#pragma unroll
            for (int j = 0; j < 8; ++j) { const float c = (j & 1) ? bfhi(cw[j >> 1]) : bflo(cw[j >> 1]), p = (j & 1) ? bfhi(pw[j >> 1]) : bflo(pw[j >> 1]);
                float x = c + (p - c) * muv[j];
                if (ch < 8) x = 1.0f - 2.0f * __builtin_amdgcn_rcpf(1.0f + __expf(2.0f * x)); else if (ch >= 16 && ch < 32) x = sigmoidf_(x);
                o[j] = x; }
            u32x4 w; w.x = pk2(o[0], o[1]); w.y = pk2(o[2], o[3]); w.z = pk2(o[4], o[5]); w.w = pk2(o[6], o[7]);
            *(u32x4*)(AP + (size_t)t * 512 + ch * 8) = w;
        }
    }
}

constexpr float QSCALE = 0.14724444602590306f;
__device__ __forceinline__ void mla_finish(const Args& a, LAS unsigned char* lds, int tid, int G) {
    const bf16_t* PROJ = (const bf16_t*)(a.ws + R_PROJ); const bf16_t* RAW = (const bf16_t*)(a.ws + R_QKV);
    bf16_t* QB = (bf16_t*)(a.ws + R_QB); unsigned char* KT = a.ws + R_KT; unsigned char* VT = a.ws + R_VT;
    const float* rope = (const float*)(a.ws + WS_ROPE);
    LAS float* rs = (LAS float*)lds;
    for (int tile = blockIdx.x; tile < T / 64; tile += G) {
        const int t0 = tile * 64, b = t0 >> 13, tidx = (t0 & (SEQ - 1)) >> 6;
        {
            const int tk = tid >> 3, part = tid & 7; const bf16_t* pr = PROJ + (size_t)(t0 + tk) * INWP;
            float sq = 0.f, sk = 0.f;
#pragma unroll
            for (int i = 0; i < 4; ++i) { const u32x4 w = *(const u32x4*)(pr + C_QC + part * 32 + i * 8); const unsigned ww[4] = {w.x, w.y, w.z, w.w};
#pragma unroll
                for (int j = 0; j < 4; ++j) { const float x0 = bflo(ww[j]), x1 = bfhi(ww[j]); sq += x0 * x0 + x1 * x1; } }
#pragma unroll
            for (int i = 0; i < 2; ++i) { const u32x4 w = *(const u32x4*)(pr + C_KVC + part * 16 + i * 8); const unsigned ww[4] = {w.x, w.y, w.z, w.w};
#pragma unroll
                for (int j = 0; j < 4; ++j) { const float x0 = bflo(ww[j]), x1 = bfhi(ww[j]); sk += x0 * x0 + x1 * x1; } }
            sq += __shfl_xor(sq, 1); sq += __shfl_xor(sq, 2); sq += __shfl_xor(sq, 4);
            sk += __shfl_xor(sk, 1); sk += __shfl_xor(sk, 2); sk += __shfl_xor(sk, 4);
            if (part == 0) { rs[tk * 2] = __builtin_amdgcn_rsqf(sq * (1.0f / 256.0f) + NORM_EPS); rs[tk * 2 + 1] = __builtin_amdgcn_rsqf(sk * (1.0f / 128.0f) + NORM_EPS); }
        }
        __syncthreads();
#pragma nounroll
        for (int c0 = 0; c0 < 6; c0 += 3) {
            asm volatile("" ::: "memory");
            u32x4 w_[3], wp_[3]; f32x4 rp_[3][4];
#pragma unroll
            for (int u = 0; u < 3; ++u) { const int ci = tid + (c0 + u) * NTHR; const int tk = ci / 48, rem = ci % 48, h = rem / 12, c = rem % 12; const size_t t = (size_t)t0 + tk;
                w_[u] = *(const u32x4*)(RAW + t * 1024 + h * 96 + c * 8); wp_[u] = zero4();
#pragma unroll
                for (int q = 0; q < 4; ++q) rp_[u][q] = (f32x4){0.f, 0.f, 0.f, 0.f};
                if (c >= 8) { const int cp = (c < 10) ? c + 2 : c - 2; wp_[u] = *(const u32x4*)(RAW + t * 1024 + h * 96 + cp * 8); const f32x4* rr = (const f32x4*)(rope + (t * 16 + ((c - 8) & 1) * 8) * 2);
#pragma unroll
                    for (int q = 0; q < 4; ++q) rp_[u][q] = rr[q]; } }
#pragma unroll
            for (int u = 0; u < 3; ++u) { const int ci = tid + (c0 + u) * NTHR; const int tk = ci / 48, rem = ci % 48, h = rem / 12, c = rem % 12; const size_t t = (size_t)t0 + tk;
                const float sc = rs[tk * 2] * QSCALE;
                const unsigned ww[4] = {w_[u].x, w_[u].y, w_[u].z, w_[u].w}, pp[4] = {wp_[u].x, wp_[u].y, wp_[u].z, wp_[u].w};
                float o[8];
#pragma unroll
                for (int j = 0; j < 8; ++j) { const float xo = (j & 1) ? bfhi(ww[j >> 1]) : bflo(ww[j >> 1]), xp = (j & 1) ? bfhi(pp[j >> 1]) : bflo(pp[j >> 1]);
                    const float cs = rp_[u][j >> 1][(j & 1) * 2], sn = rp_[u][j >> 1][(j & 1) * 2 + 1];
                    o[j] = (c < 8) ? xo * sc : ((c < 10) ? (xo * cs - xp * sn) : (xp * sn + xo * cs)) * sc; }
                u32x4 ow; ow.x = pk2(o[0], o[1]); ow.y = pk2(o[2], o[3]); ow.z = pk2(o[4], o[5]); ow.w = pk2(o[6], o[7]);
                *(u32x4*)(QB + t * 384 + h * 96 + c * 8) = ow; }
        }
#pragma nounroll
        for (int c0 = 0; c0 < 6; c0 += 3) {
            asm volatile("" ::: "memory");
            u32x4 w_[3], wp_[3]; f32x4 rp_[3][4];
#pragma unroll
            for (int u = 0; u < 3; ++u) { const int ci = tid + (c0 + u) * NTHR; const int h = ci / 768, rem = ci % 768, c = rem >> 6, key = rem & 63; const size_t t = (size_t)t0 + key;
                wp_[u] = zero4();
#pragma unroll
                for (int q = 0; q < 4; ++q) rp_[u][q] = (f32x4){0.f, 0.f, 0.f, 0.f};
                if (c < 8) w_[u] = *(const u32x4*)(RAW + t * 1024 + 512 + h * 128 + c * 8);
                else { const int cp = (c < 10) ? c + 2 : c - 2; w_[u] = *(const u32x4*)(PROJ + t * INWP + C_KPE + (c - 8) * 8); wp_[u] = *(const u32x4*)(PROJ + t * INWP + C_KPE + (cp - 8) * 8);
                    const f32x4* rr = (const f32x4*)(rope + (t * 16 + ((c - 8) & 1) * 8) * 2);
#pragma unroll
                    for (int q = 0; q < 4; ++q) rp_[u][q] = rr[q]; } }
#pragma unroll
            for (int u = 0; u < 3; ++u) { const int ci = tid + (c0 + u) * NTHR; const int h = ci / 768, rem = ci % 768, c = rem >> 6, key = rem & 63;
                const float sc = rs[key * 2 + 1];
                const unsigned ww[4] = {w_[u].x, w_[u].y, w_[u].z, w_[u].w}, pp[4] = {wp_[u].x, wp_[u].y, wp_[u].z, wp_[u].w};
                float o[8];
#pragma unroll
                for (int j = 0; j < 8; ++j) { const float xo = (j & 1) ? bfhi(ww[j >> 1]) : bflo(ww[j >> 1]), xp = (j & 1) ? bfhi(pp[j >> 1]) : bflo(pp[j >> 1]);
                    const float cs = rp_[u][j >> 1][(j & 1) * 2], sn = rp_[u][j >> 1][(j & 1) * 2 + 1];
                    o[j] = (c < 8) ? xo * sc : ((c < 10) ? (xo * cs - xp * sn) : (xp * sn + xo * cs)); }
                u32x4 ow; ow.x = pk2(o[0], o[1]); ow.y = pk2(o[2], o[3]); ow.z = pk2(o[4], o[5]); ow.w = pk2(o[6], o[7]);
                *(u32x4*)(KT + ((size_t)((b * 4 + h) * 128 + tidx)) * 12288 + (size_t)(c * 64 + key) * 16) = ow; }
        }
        {
            asm volatile("" ::: "memory");
            unsigned rv[4][8];
#pragma unroll
            for (int u = 0; u < 4; ++u) { const int ci = tid + u * NTHR; const int h = ci >> 9, rem = ci & 511, kh = rem >> 6, dv = rem & 63, ks = kh >> 1, hh = kh & 1;
#pragma unroll
                for (int j = 0; j < 8; ++j) { const int key = 16 * ks + 8 * (j >> 2) + 4 * hh + (j & 3); rv[u][j] = RAW[((size_t)t0 + key) * 1024 + 512 + h * 128 + 64 + dv]; } }
#pragma unroll
            for (int u = 0; u < 4; ++u) { const int ci = tid + u * NTHR; const int h = ci >> 9, rem = ci & 511, kh = rem >> 6, dv = rem & 63, ks = kh >> 1, hh = kh & 1;
                float o[8];
#pragma unroll
                for (int j = 0; j < 8; ++j) { const int key = 16 * ks + 8 * (j >> 2) + 4 * hh + (j & 3); o[j] = bf2f(rv[u][j]) * rs[key * 2 + 1]; }
                u32x4 ow; ow.x = pk2(o[0], o[1]); ow.y = pk2(o[2], o[3]); ow.z = pk2(o[4], o[5]); ow.w = pk2(o[6], o[7]);
                *(u32x4*)(VT + ((size_t)((b * 4 + h) * 128 + tidx)) * 8192 + (size_t)(kh * 64 + dv) * 16) = ow; }
        }
        __syncthreads();
    }
}
__device__ __forceinline__ void rwkv_finish(const Args& a, int l, int wave, int lane, int G) {
    const bf16_t* PROJ = (const bf16_t*)(a.ws + R_PROJ); const bf16_t* LO = (const bf16_t*)(a.ws + R_LO);
    float* SI = (float*)(a.ws + R_SI); float* VF = (float*)(a.ws + WS_VF);
    const float* mu = FIN(I_RWMU) + l * 1024;
    const int h = wave & 3, j = h * 64 + lane;
    const float mur = mu[j], muk = mu[256 + j], muv = mu[512 + j];
    const float w0 = FIN(I_RWW0)[l * 256 + j], a0 = FIN(I_RWA0)[l * 256 + j], kkp = FIN(I_RWKK)[l * 256 + j], kap = FIN(I_RWKA)[l * 256 + j];
    const float v0 = l > 0 ? FIN(I_RWV0)[(l - 1) * 256 + j] : 0.f;
#pragma unroll 4
    for (int tp = blockIdx.x; tp < T / 2; tp += G) {
        const size_t t = (size_t)tp * 2 + (wave >> 2); const bool first = (t & (SEQ - 1)) == 0;
        const bf16_t* pc = PROJ + t * INWP; const bf16_t* pp = pc - INWP;
        float r = bf2f(pc[C_RWR + j]), k = bf2f(pc[C_RWK + j]), v = bf2f(pc[C_RWV + j]);
        const float rp = first ? 0.f : bf2f(pp[C_RWR + j]), kp = first ? 0.f : bf2f(pp[C_RWK + j]), vp = first ? 0.f : bf2f(pp[C_RWV + j]);
        r += (rp - r) * mur; k += (kp - k) * muk; v += (vp - v) * muv;
        const float wl = w0 + bf2f(LO[t * 1024 + j]);
        const float sp = log1pf(__expf(-wl));
        const float wraw = -sp - 0.5f;
        const float decay = __expf(-__expf(wraw));
        const float aa = sigmoidf_(a0 + bf2f(LO[t * 1024 + 256 + j]));
        if (l > 0) { const float vf = VF[t * 256 + j]; v += (vf - v) * sigmoidf_(v0 + bf2f(LO[t * 1024 + 768 + j])); }
        else VF[t * 256 + j] = v;
        const float kk0 = k * kkp;
        const float nrm = sqrtf(wave_sum(kk0 * kk0));
        const float kk = kk0 / fmaxf(nrm, 1e-12f);
        const float k2 = k * (1.0f + (aa - 1.0f) * kap);
        float* o = SI + (t * 4 + h) * 384;
        o[lane] = r; o[64 + lane] = decay; o[128 + lane] = k2; o[192 + lane] = kk; o[256 + lane] = kk * aa; o[320 + lane] = v;
    }
}
struct S5State { float lbr, lbi; int cre, cim; };
__device__ __forceinline__ S5State s5_state(const Args& a, int l, int s) { S5State st; const int g = s >> 6, p = s & 63; float fre, fim; s5_lambda_bar(a, l, g, p, st.lbr, st.lbi, fre, fim); st.cre = g * 128 + p; st.cim = st.cre + 64; return st; }
__device__ __forceinline__ void s5_repack(const Args& a, int tid, int G) {
    const bf16_t* PROJ = (const bf16_t*)(a.ws + R_PROJ); bf16_t* UP = (bf16_t*)(a.ws + R_UP);
    for (int i = blockIdx.x * NTHR + tid; i < T * 32; i += G * NTHR) { const int p8 = i & 31, t = i >> 5, g = p8 >> 1, h0 = (p8 & 1) * 8;
        *(u32x4*)(UP + ((size_t)g * 2048 + (t >> 5)) * 768 + (t & 31) * 16 + h0) = *(const u32x4*)(PROJ + (size_t)t * INWP + C_S5 + p8 * 8); }
    for (int i = blockIdx.x * NTHR + tid; i < 16 * 2048 * 16; i += G * NTHR) { const int r = i >> 4, c8 = i & 15; *(u32x4*)(UP + (size_t)r * 768 + 640 + c8 * 8) = zero4(); }
}
__device__ __forceinline__ void s5_chunk_scan(const Args& a, int l, int tid, int G, int pair = -1) {
    bf16_t* UP = (bf16_t*)(a.ws + R_UP); const float* EB = (const float*)(a.ws + R_EB);
    if (tid < 64)
    for (int i = (pair >= 0 ? pair : (int)blockIdx.x) * 64 + tid; i < (pair >= 0 ? (pair + 1) * 64 : NB * 16 * 64); i += G * 64) { const int p = i & 63, g = (i >> 6) & 15, b = i >> 10;
        float lbr, lbi, fre, fim; s5_lambda_bar(a, l, g, p, lbr, lbi, fre, fim);
        float pr = lbr, pi_ = lbi;
#pragma unroll
        for (int k = 0; k < 5; ++k) { const float tr = pr * pr - pi_ * pi_, ti = 2.f * pr * pi_; pr = tr; pi_ = ti; }
        float sr = 0.f, si = 0.f;
        for (int c0 = 0; c0 < 256; c0 += 32) { float er[32], ei[32];
#pragma unroll
            for (int c = 0; c < 32; ++c) { const size_t row = (size_t)g * 2048 + b * 256 + c0 + c; er[c] = EB[row * 128 + p]; ei[c] = EB[row * 128 + 64 + p]; }
#pragma unroll
            for (int c = 0; c < 32; ++c) { const size_t row = (size_t)g * 2048 + b * 256 + c0 + c;
                UP[row * 768 + 512 + p] = (bf16_t)f2bf(sr); UP[row * 768 + 576 + p] = (bf16_t)f2bf(si);
                const float nr = pr * sr - pi_ * si + er[c], ni = pr * si + pi_ * sr + ei[c]; sr = nr; si = ni; }
        }
    }
}
__device__ __forceinline__ void s5_pass_a(const Args& a, int l, int tid, int G) {
    const bf16_t* BU = (const bf16_t*)(a.ws + R_BU); float* E = (float*)(a.ws + R_E);
    const S5State s0 = s5_state(a, l, tid), s1 = s5_state(a, l, tid + 512);
    for (int u = blockIdx.x; u < NB * 64; u += G) {
        const size_t t0 = (size_t)(u >> 6) * SEQ + (size_t)(u & 63) * 128;
        float ar = 0.f, ai = 0.f, br = 0.f, bi = 0.f;
#pragma unroll 4
        for (int tk = 0; tk < 128; ++tk) { const bf16_t* row = BU + (t0 + tk) * 2048;
            const float x0 = bf2f(row[s0.cre]), y0 = bf2f(row[s0.cim]), x1 = bf2f(row[s1.cre]), y1 = bf2f(row[s1.cim]);
            const float nar = s0.lbr * ar - s0.lbi * ai + x0, nai = s0.lbr * ai + s0.lbi * ar + y0; ar = nar; ai = nai;
            const float nbr = s1.lbr * br - s1.lbi * bi + x1, nbi = s1.lbr * bi + s1.lbi * br + y1; br = nbr; bi = nbi; }
        float* e = E + (size_t)u * 2048;
        e[tid * 2] = ar; e[tid * 2 + 1] = ai; e[(tid + 512) * 2] = br; e[(tid + 512) * 2 + 1] = bi;
    }
}
__device__ __forceinline__ void s5_pass_c(const Args& a, int l, int tid, int G) {
    bf16_t* BU = (bf16_t*)(a.ws + R_BU); const float* E = (const float*)(a.ws + R_E);
    const S5State s0 = s5_state(a, l, tid), s1 = s5_state(a, l, tid + 512);
    float p0r = s0.lbr, p0i = s0.lbi, p1r = s1.lbr, p1i = s1.lbi;
#pragma unroll
    for (int i = 0; i < 7; ++i) { const float t0r = p0r * p0r - p0i * p0i, t0i = 2.f * p0r * p0i; p0r = t0r; p0i = t0i; const float t1r = p1r * p1r - p1i * p1i, t1i = 2.f * p1r * p1i; p1r = t1r; p1i = t1i; }
    for (int u = blockIdx.x; u < NB * 64; u += G) {
        const int b = u >> 6, c = u & 63; const size_t t0 = (size_t)b * SEQ + (size_t)c * 128;
        float ar = 0.f, ai = 0.f, br = 0.f, bi = 0.f;
        for (int cc = 0; cc < c; ++cc) { const float* e = E + (size_t)(b * 64 + cc) * 2048;
            const float e0r = e[tid * 2], e0i = e[tid * 2 + 1], e1r = e[(tid + 512) * 2], e1i = e[(tid + 512) * 2 + 1];
            const float nar = p0r * ar - p0i * ai + e0r, nai = p0r * ai + p0i * ar + e0i; ar = nar; ai = nai;
            const float nbr = p1r * br - p1i * bi + e1r, nbi = p1r * bi + p1i * br + e1i; br = nbr; bi = nbi; }
#pragma unroll 4
        for (int tk = 0; tk < 128; ++tk) { bf16_t* row = BU + (t0 + tk) * 2048;
            const float x0 = bf2f(row[s0.cre]), y0 = bf2f(row[s0.cim]), x1 = bf2f(row[s1.cre]), y1 = bf2f(row[s1.cim]);
            const float nar = s0.lbr * ar - s0.lbi * ai + x0, nai = s0.lbr * ai + s0.lbi * ar + y0; ar = nar; ai = nai;
            const float nbr = s1.lbr * br - s1.lbi * bi + x1, nbi = s1.lbr * bi + s1.lbi * br + y1; br = nbr; bi = nbi;
            row[s0.cre] = (bf16_t)f2bf(ar); row[s0.cim] = (bf16_t)f2bf(ai); row[s1.cre] = (bf16_t)f2bf(br); row[s1.cim] = (bf16_t)f2bf(bi); }
    }
}
__device__ __forceinline__ float ret_rope(const bf16_t* PROJ, const float* rope, size_t t, int colbase, int h, int d) {
    const bf16_t* p = PROJ + t * INWP + colbase + h * 32; const int i = d & 15;
    const float x1 = bf2f(p[i]), x2 = bf2f(p[i + 16]); const float cs = rope[(t * 16 + i) * 2], sn = rope[(t * 16 + i) * 2 + 1];
    return d < 16 ? (x1 * cs - x2 * sn) : (x1 * sn + x2 * cs);
}
__device__ __forceinline__ void ret_rope8(const bf16_t* PROJ, const float* rope, size_t t, int colbase, int h, int ch, float (&o)[8]) {
    const bf16_t* p = PROJ + t * INWP + colbase + h * 32;
    const u32x4 wo = *(const u32x4*)(p + 8 * ch), wp = *(const u32x4*)(p + 8 * (ch ^ 2));
    const unsigned ow[4] = {wo.x, wo.y, wo.z, wo.w}, pw[4] = {wp.x, wp.y, wp.z, wp.w};
    const f32x4* cs = (const f32x4*)(rope + (t * 16 + (ch & 1) * 8) * 2);
    const f32x4 c0 = cs[0], c1 = cs[1], c2 = cs[2], c3 = cs[3];
    const float cc[8] = {c0.x, c0.z, c1.x, c1.z, c2.x, c2.z, c3.x, c3.z}, sn[8] = {c0.y, c0.w, c1.y, c1.w, c2.y, c2.w, c3.y, c3.w};
#pragma unroll
    for (int j = 0; j < 8; ++j) { const float xo = (j & 1) ? bfhi(ow[j >> 1]) : bflo(ow[j >> 1]), xp = (j & 1) ? bfhi(pw[j >> 1]) : bflo(pw[j >> 1]);
        o[j] = (ch < 2) ? (xo * cc[j] - xp * sn[j]) : (xp * sn[j] + xo * cc[j]); }
}
__device__ __forceinline__ void ret_stage_vt(const bf16_t* PROJ, LAS bf16_t* VT, size_t t0, int h, int tid) {
    const int m = tid >> 2, eg = tid & 3, ks = m >> 4, w = m & 15, hh = (w >> 2) & 1, j = 4 * (w >> 3) + (w & 3);
    const u32x4 v0 = *(const u32x4*)(PROJ + (t0 + m) * INWP + C_RV + h * 64 + eg * 16), v1 = *(const u32x4*)(PROJ + (t0 + m) * INWP + C_RV + h * 64 + eg * 16 + 8);
    const unsigned vw[8] = {v0.x, v0.y, v0.z, v0.w, v1.x, v1.y, v1.z, v1.w};
    LAS bf16_t* d = VT + ((ks * 2 + hh) * 64 + eg * 16) * 8 + j;
#pragma unroll
    for (int i = 0; i < 16; ++i) d[i * 8] = (bf16_t)((i & 1) ? (vw[i >> 1] >> 16) : (vw[i >> 1] & 0xffffu));
}
__device__ __forceinline__ void ret_pass_a(const Args& a, LAS unsigned char* lds, int tid, int wave, int lane, int G) {
    const bf16_t* PROJ = (const bf16_t*)(a.ws + R_PROJ); const float* rope = (const float*)(a.ws + WS_ROPE); float* CKV = (float*)(a.ws + R_CKV);
    LAS bf16_t* VT = (LAS bf16_t*)lds; LAS bf16_t* KW = (LAS bf16_t*)(lds + 16384);
    const int hh = lane >> 5, l31 = lane & 31;
    for (int u = blockIdx.x; u < NB * 64 * 4; u += G) {
        const int h = u & 3, n = (u >> 2) & 63, b = u >> 8; const size_t t0 = (size_t)b * SEQ + (size_t)n * 128;
        const float lg2 = log2f(1.0f - exp2f(-5.0f - (float)h));
        ret_stage_vt(PROJ, VT, t0, h, tid);
        {
            const int d = tid & 31, kh = tid >> 5, ks = kh >> 1, khh = kh & 1, i = d & 15; float o[8];
#pragma unroll
            for (int j = 0; j < 8; ++j) { const int m = 16 * ks + 8 * (j >> 2) + 4 * khh + (j & 3); const size_t t = t0 + m;
                const bf16_t* p = PROJ + t * INWP + C_RK + h * 32; const float x1 = bf2f(p[i]), x2 = bf2f(p[i + 16]);
                const float cs = rope[(t * 16 + i) * 2], sn = rope[(t * 16 + i) * 2 + 1];
                o[j] = (d < 16 ? (x1 * cs - x2 * sn) : (x1 * sn + x2 * cs)) * 0.17677669529663687f * exp2f((float)(127 - m) * lg2); }
            u32x4 w; w.x = pk2(o[0], o[1]); w.y = pk2(o[2], o[3]); w.z = pk2(o[4], o[5]); w.w = pk2(o[6], o[7]);
            *(LAS u32x4*)(KW + (kh * 32 + d) * 8) = w;
        }
        __syncthreads();
        if (wave < 2) {
            f32x16 acc;
#pragma unroll
            for (int r = 0; r < 16; ++r) acc[r] = 0.f;
#pragma unroll
            for (int ks = 0; ks < 8; ++ks) {
                const bf16x8 va = *(const LAS bf16x8*)(VT + ((ks * 2 + hh) * 64 + 32 * wave + l31) * 8);
                const bf16x8 kb = *(const LAS bf16x8*)(KW + ((ks * 2 + hh) * 32 + l31) * 8);
                acc = __builtin_amdgcn_mfma_f32_32x32x16_bf16(va, kb, acc, 0, 0, 0);
            }
            float* o = CKV + (size_t)u * 2048;
#pragma unroll
            for (int r = 0; r < 16; ++r) { const int e = 32 * wave + (r & 3) + 8 * (r >> 2) + 4 * hh; o[e * 32 + l31] = acc[r]; }
        }
        __syncthreads();
    }
}
__device__ __forceinline__ void ret_pass_c(const Args& a, LAS unsigned char* lds, int tid, int wave, int lane, int G) {
    const bf16_t* PROJ = (const bf16_t*)(a.ws + R_PROJ); const float* rope = (const float*)(a.ws + WS_ROPE); const float* CKV = (const float*)(a.ws + R_CKV);
    bf16_t* MIX = (bf16_t*)(a.ws + R_MIX);
    LAS bf16_t* VT = (LAS bf16_t*)lds; LAS bf16_t* QS = (LAS bf16_t*)(lds + 16384); LAS bf16_t* KS = (LAS bf16_t*)(lds + 24576); LAS bf16_t* RT = (LAS bf16_t*)(lds + 32768);
    LAS float* SSQ = (LAS float*)(lds + 36864);
    const int hh = lane >> 5, l31 = lane & 31, cb = wave & 3, eb = wave >> 2;
    const int vm = tid >> 2, veg = tid & 3;
    const int row = tid & 127, ch = tid >> 7;
    const int re = tid >> 3, rd0 = (tid & 7) * 4;
    for (int su = blockIdx.x; su < NB * 4 * 8; su += G) {
        const int bh = su >> 3, h = bh & 3, b = bh >> 2, n0 = (su & 7) * 8;
        const float gam = 1.0f - exp2f(-5.0f - (float)h), lg2 = log2f(gam), cd = exp2f(128.0f * lg2);
        const float* ck = CKV + ((size_t)((b * 64) * 4 + h)) * 2048 + re * 32 + rd0;
        f32x4 Rc = (f32x4){0.f, 0.f, 0.f, 0.f};
        for (int nn = 0; nn + 1 < n0; nn += 8) { f32x4 c8[8];
#pragma unroll
            for (int i = 0; i < 8; ++i) c8[i] = (nn + i < n0 - 1) ? *(const f32x4*)(ck + (size_t)(nn + i) * 4 * 2048) : (f32x4){0.f, 0.f, 0.f, 0.f};
#pragma unroll
            for (int i = 0; i < 8; ++i) if (nn + i < n0 - 1) Rc = Rc * cd + c8[i]; }
        u32x4 sv0, sv1, sqo, sqp, sko, skp; f32x4 sc0, sc1, sc2, sc3, sck;
#define RC_LOAD(n_) do { const size_t t0_ = (size_t)b * SEQ + (size_t)(n_) * 128; \
            const bf16_t* pv_ = PROJ + (t0_ + vm) * INWP + C_RV + h * 64 + veg * 16; sv0 = *(const u32x4*)pv_; sv1 = *(const u32x4*)(pv_ + 8); \
            const bf16_t* pq_ = PROJ + (t0_ + row) * INWP + C_RQ + h * 32; sqo = *(const u32x4*)(pq_ + 8 * ch); sqp = *(const u32x4*)(pq_ + 8 * (ch ^ 2)); \
            const bf16_t* pk_ = PROJ + (t0_ + row) * INWP + C_RK + h * 32; sko = *(const u32x4*)(pk_ + 8 * ch); skp = *(const u32x4*)(pk_ + 8 * (ch ^ 2)); \
            const f32x4* cs_ = (const f32x4*)(rope + ((t0_ + row) * 16 + (ch & 1) * 8) * 2); sc0 = cs_[0]; sc1 = cs_[1]; sc2 = cs_[2]; sc3 = cs_[3]; \
            sck = (n_) > 0 ? *(const f32x4*)(ck + (size_t)((n_) - 1) * 4 * 2048) : (f32x4){0.f, 0.f, 0.f, 0.f}; } while (0)
        RC_LOAD(n0);
        for (int kq = 0; kq < 8; ++kq) {
            const int n = n0 + kq; const size_t t0 = (size_t)b * SEQ + (size_t)n * 128;
            {
                const int ks = vm >> 4, w = vm & 15, vh = (w >> 2) & 1, j = 4 * (w >> 3) + (w & 3);
                const unsigned vw[8] = {sv0.x, sv0.y, sv0.z, sv0.w, sv1.x, sv1.y, sv1.z, sv1.w};
                LAS bf16_t* d = VT + ((ks * 2 + vh) * 64 + veg * 16) * 8 + j;
#pragma unroll
                for (int i = 0; i < 16; ++i) d[i * 8] = (bf16_t)((i & 1) ? (vw[i >> 1] >> 16) : (vw[i >> 1] & 0xffffu));
            }
            {
                const float cc[8] = {sc0.x, sc0.z, sc1.x, sc1.z, sc2.x, sc2.z, sc3.x, sc3.z}, sn[8] = {sc0.y, sc0.w, sc1.y, sc1.w, sc2.y, sc2.w, sc3.y, sc3.w};
                const unsigned qo[4] = {sqo.x, sqo.y, sqo.z, sqo.w}, qp[4] = {sqp.x, sqp.y, sqp.z, sqp.w}, ko[4] = {sko.x, sko.y, sko.z, sko.w}, kp[4] = {skp.x, skp.y, skp.z, skp.w};
                float oq[8], ok[8];
#pragma unroll
                for (int j = 0; j < 8; ++j) { const float xo = (j & 1) ? bfhi(qo[j >> 1]) : bflo(qo[j >> 1]), xp = (j & 1) ? bfhi(qp[j >> 1]) : bflo(qp[j >> 1]);
                    oq[j] = (ch < 2) ? (xo * cc[j] - xp * sn[j]) : (xp * sn[j] + xo * cc[j]);
                    const float yo = (j & 1) ? bfhi(ko[j >> 1]) : bflo(ko[j >> 1]), yp = (j & 1) ? bfhi(kp[j >> 1]) : bflo(kp[j >> 1]);
                    ok[j] = (ch < 2) ? (yo * cc[j] - yp * sn[j]) : (yp * sn[j] + yo * cc[j]); }
                const float qs = exp2f((float)row * lg2);
                u32x4 w; w.x = pk2(oq[0] * qs, oq[1] * qs); w.y = pk2(oq[2] * qs, oq[3] * qs); w.z = pk2(oq[4] * qs, oq[5] * qs); w.w = pk2(oq[6] * qs, oq[7] * qs);
                *(LAS u32x4*)(QS + (ch * 128 + row) * 8) = w;
                const float ks_ = 0.17677669529663687f * exp2f(-(float)row * lg2);
                w.x = pk2(ok[0] * ks_, ok[1] * ks_); w.y = pk2(ok[2] * ks_, ok[3] * ks_); w.z = pk2(ok[4] * ks_, ok[5] * ks_); w.w = pk2(ok[6] * ks_, ok[7] * ks_);
                *(LAS u32x4*)(KS + (ch * 128 + row) * 8) = w;
            }
            {
                if (n > 0) Rc = Rc * cd + sck;
                const f32x4 R = Rc;
                u32x2 w; w.x = pk2(R.x * gam, R.y * gam); w.y = pk2(R.z * gam, R.w * gam);
                *(LAS u32x2*)(RT + ((rd0 >> 3) * 64 + re) * 8 + (rd0 & 7)) = w;
            }
            LDS_BARRIER();
            if (kq < 7) RC_LOAD(n + 1);
            const size_t t = t0 + 32 * cb + l31;
            u32x2 gwv[4];
#pragma unroll
            for (int g = 0; g < 4; ++g) gwv[g] = *(const u32x2*)(PROJ + t * INWP + C_RG + h * 64 + 32 * eb + 8 * g + 4 * hh);
            f32x16 o;
#pragma unroll
            for (int r = 0; r < 16; ++r) o[r] = 0.f;
            bf16x8 qf[2];
#pragma unroll
            for (int s2 = 0; s2 < 2; ++s2) qf[s2] = *(const LAS bf16x8*)(QS + ((2 * s2 + hh) * 128 + 32 * cb + l31) * 8);
#pragma unroll
            for (int s2 = 0; s2 < 2; ++s2) { const bf16x8 ra = *(const LAS bf16x8*)(RT + ((2 * s2 + hh) * 64 + 32 * eb + l31) * 8); o = __builtin_amdgcn_mfma_f32_32x32x16_bf16(ra, qf[s2], o, 0, 0, 0); }
            for (int mb = 0; mb <= cb; ++mb) {
                f32x16 sc;
#pragma unroll
                for (int r = 0; r < 16; ++r) sc[r] = 0.f;
#pragma unroll
                for (int s2 = 0; s2 < 2; ++s2) { const bf16x8 ka = *(const LAS bf16x8*)(KS + ((2 * s2 + hh) * 128 + 32 * mb + l31) * 8); sc = __builtin_amdgcn_mfma_f32_32x32x16_bf16(ka, qf[s2], sc, 0, 0, 0); }
                if (mb == cb) {
#pragma unroll
                    for (int r = 0; r < 16; ++r) if ((r & 3) + 8 * (r >> 2) + 4 * hh > l31) sc[r] = 0.f;
                }
#pragma unroll
                for (int sb = 0; sb < 2; ++sb) { u32x4 w; w.x = cvt_pk_bf16(sc[8 * sb], sc[8 * sb + 1]); w.y = cvt_pk_bf16(sc[8 * sb + 2], sc[8 * sb + 3]); w.z = cvt_pk_bf16(sc[8 * sb + 4], sc[8 * sb + 5]); w.w = cvt_pk_bf16(sc[8 * sb + 6], sc[8 * sb + 7]);
                    const bf16x8 pb = __builtin_bit_cast(bf16x8, w);
                    const bf16x8 va = *(const LAS bf16x8*)(VT + (((2 * mb + sb) * 2 + hh) * 64 + 32 * eb + l31) * 8);
                    o = __builtin_amdgcn_mfma_f32_32x32x16_bf16(va, pb, o, 0, 0, 0); }
            }
            float ss = 0.f;
#pragma unroll
            for (int r = 0; r < 16; ++r) ss += o[r] * o[r];
            ss += __shfl_xor(ss, 32);
            if (hh == 0) SSQ[(cb * 2 + eb) * 32 + l31] = ss;
            LDS_BARRIER();
            const float tot = SSQ[(cb * 2) * 32 + l31] + SSQ[(cb * 2 + 1) * 32 + l31];
            const float rstd = __builtin_amdgcn_rsqf(tot * (1.0f / 64.0f) + NORM_EPS);
#pragma unroll
            for (int g = 0; g < 4; ++g) { const int e0 = 32 * eb + 8 * g + 4 * hh;
                const float g0 = bflo(gwv[g].x), g1 = bfhi(gwv[g].x), g2 = bflo(gwv[g].y), g3 = bfhi(gwv[g].y);
                u32x2 w; w.x = cvt_pk_bf16(o[4 * g] * rstd * g0 * sigmoidf_(g0), o[4 * g + 1] * rstd * g1 * sigmoidf_(g1)); w.y = cvt_pk_bf16(o[4 * g + 2] * rstd * g2 * sigmoidf_(g2), o[4 * g + 3] * rstd * g3 * sigmoidf_(g3));
                *(u32x2*)(MIX + t * 1024 + 768 + h * 64 + e0) = w; }
        }
#undef RC_LOAD
        __syncthreads();
    }
}
__device__ __forceinline__ float exp2_(float x) { return __builtin_amdgcn_exp2f(x); }
__device__ __forceinline__ void attn_unit(LAS unsigned char* lds, const bf16_t* QB, const unsigned char* KT, const unsigned char* VT, bf16_t* MIX, int bh, int qb, int tid, int wave, int lane) {
    const int b = bh >> 2, h = bh & 3, hh = lane >> 5, l31 = lane & 31, grp = wave >> 2;
    const int qrel = wave * 32 + l31;
    const size_t trow = (size_t)b * SEQ + (size_t)qb * 256 + qrel;
    bf16x8 qf[6];
#pragma unroll
    for (int s = 0; s < 6; ++s) qf[s] = *(const bf16x8*)(QB + trow * 384 + h * 96 + 16 * s + 8 * hh);
    f32x16 o0, o1;
#pragma unroll
    for (int r = 0; r < 16; ++r) { o0[r] = 0.f; o1[r] = 0.f; }
    float mrun = -1e30f, lsum = 0.f;
    const int ntile = 4 * (qb + 1);
    const unsigned char* kbase = KT + (size_t)bh * 128 * 12288 + lane * 16; const unsigned char* vbase = VT + (size_t)bh * 128 * 8192 + wave * 1024 + lane * 16;
    const int kp0 = wave * 1024, kp1 = (wave < 4 ? wave + 8 : wave) * 1024;
    LAS unsigned char* vring = lds + 36864;
#define AT_DMA_K(T, SLOT) do { const unsigned char* kp_ = kbase + (size_t)(T) * 12288; LAS unsigned char* kd_ = lds + (SLOT) * 12288; \
        __builtin_amdgcn_global_load_lds((const unsigned*)(kp_ + kp0), (LAS unsigned*)(kd_ + kp0), 16, 0, 0); \
        __builtin_amdgcn_global_load_lds((const unsigned*)(kp_ + kp1), (LAS unsigned*)(kd_ + kp1), 16, 0, 0); } while (0)
#define AT_DMA_V(T, SLOT) __builtin_amdgcn_global_load_lds((const unsigned*)(vbase + (size_t)(T) * 8192), (LAS unsigned*)(vring + (SLOT) * 8192 + wave * 1024), 16, 0, 0)
#define AT_BAR() asm volatile("s_barrier" ::: "memory")
#define AT_PV(SLOT) do { LAS unsigned char* vl = vring + (SLOT) * 8192; _Pragma("unroll") for (int ks = 0; ks < 4; ++ks) { \
        const bf16x8 va0 = *(const LAS bf16x8*)(vl + ((ks * 2 + hh) * 64 + l31) * 16); const bf16x8 va1 = *(const LAS bf16x8*)(vl + ((ks * 2 + hh) * 64 + 32 + l31) * 16); \
        o0 = __builtin_amdgcn_mfma_f32_32x32x16_bf16(va0, pb[ks], o0, 0, 0, 0); o1 = __builtin_amdgcn_mfma_f32_32x32x16_bf16(va1, pb[ks], o1, 0, 0, 0); } } while (0)
    AT_DMA_K(0, 0);
    AT_DMA_K(1, 1); AT_DMA_V(0, 0);
    *(LAS u32x4*)(vring + 2 * 8192 + tid * 16) = zero4();
    asm volatile("s_waitcnt vmcnt(3) lgkmcnt(0)" ::: "memory"); AT_BAR();
    if (grp) AT_BAR();
    int i0 = 0, i1 = 1, i2 = 2;
    bf16x8 pb[4];
#pragma unroll
    for (int ks = 0; ks < 4; ++ks) pb[ks] = __builtin_bit_cast(bf16x8, zero4());
    const int lrow = (hh * 64 + l31) * 16;
    for (int t = 0; t < ntile; ++t) {
        { const int tk = (t + 2 < ntile) ? t + 2 : ntile - 1, tv = (t + 1 < ntile) ? t + 1 : ntile - 1; AT_DMA_K(tk, i2); AT_DMA_V(tv, i1); }
        const int jr = t - 4 * qb;
        f32x16 s0, s1;
#pragma unroll
        for (int r = 0; r < 16; ++r) { s0[r] = 0.f; s1[r] = 0.f; }
        {
            LAS unsigned char* kl = lds + i0 * 12288 + lrow; LAS unsigned char* vl = vring + i2 * 8192 + lrow;
            bf16x8 kf[12], vf[8];
#pragma unroll
            for (int s = 0; s < 2; ++s) { kf[2 * s] = *(const LAS bf16x8*)(kl + s * 2048); kf[2 * s + 1] = *(const LAS bf16x8*)(kl + s * 2048 + 512); }
            __builtin_amdgcn_sched_barrier(0);
            __builtin_amdgcn_s_setprio(1);
#pragma unroll
            for (int s = 0; s < 6; ++s) {
                s0 = __builtin_amdgcn_mfma_f32_32x32x16_bf16(kf[2 * s], qf[s], s0, 0, 0, 0);
                s1 = __builtin_amdgcn_mfma_f32_32x32x16_bf16(kf[2 * s + 1], qf[s], s1, 0, 0, 0);
                if (s < 4) { kf[2 * s + 4] = *(const LAS bf16x8*)(kl + (s + 2) * 2048); kf[2 * s + 5] = *(const LAS bf16x8*)(kl + (s + 2) * 2048 + 512); }
                else {
#pragma unroll
                    for (int q = 0; q < 2; ++q) { const int ks = (s - 4) * 2 + q; vf[2 * ks] = *(const LAS bf16x8*)(vl + ks * 2048); vf[2 * ks + 1] = *(const LAS bf16x8*)(vl + ks * 2048 + 512); } }
                __builtin_amdgcn_sched_barrier(0);
            }
#pragma unroll
            for (int ks = 0; ks < 4; ++ks) { o0 = __builtin_amdgcn_mfma_f32_32x32x16_bf16(vf[2 * ks], pb[ks], o0, 0, 0, 0); o1 = __builtin_amdgcn_mfma_f32_32x32x16_bf16(vf[2 * ks + 1], pb[ks], o1, 0, 0, 0); }
            __builtin_amdgcn_s_setprio(0);
        }
        asm volatile("s_waitcnt vmcnt(3)" ::: "memory"); AT_BAR();
        {
            if (jr >= 0 && (64 * jr + 63 > wave * 32)) {
                const float ninf = -__builtin_inff();
#pragma unroll
                for (int r = 0; r < 16; ++r) { const int key = 64 * jr + (r & 3) + 8 * (r >> 2) + 4 * hh;
                    if (key > qrel) s0[r] = ninf; if (key + 32 > qrel) s1[r] = ninf; }
            }
            float mx = s0[0];
#pragma unroll
            for (int r = 1; r < 16; ++r) mx = fmaxf(mx, s0[r]);
#pragma unroll
            for (int r = 0; r < 16; ++r) mx = fmaxf(mx, s1[r]);
            mx = fmaxf(mx, __shfl_xor(mx, 32));
            const float mnew = fmaxf(mrun, mx);
            const float alpha = exp2_(mrun - mnew);
            float rs = 0.f;
#pragma unroll
            for (int r = 0; r < 16; ++r) { s0[r] = exp2_(s0[r] - mnew); s1[r] = exp2_(s1[r] - mnew); rs += s0[r] + s1[r]; }
            lsum = lsum * alpha + rs;
            if (__builtin_amdgcn_ballot_w64(mnew > mrun) != 0ull) {
#pragma unroll
                for (int r = 0; r < 16; ++r) { o0[r] *= alpha; o1[r] *= alpha; } }
            mrun = mnew;
#pragma unroll
            for (int ks = 0; ks < 4; ++ks) { u32x4 w;
                if (ks < 2) { w.x = cvt_pk_bf16(s0[8 * ks + 0], s0[8 * ks + 1]); w.y = cvt_pk_bf16(s0[8 * ks + 2], s0[8 * ks + 3]); w.z = cvt_pk_bf16(s0[8 * ks + 4], s0[8 * ks + 5]); w.w = cvt_pk_bf16(s0[8 * ks + 6], s0[8 * ks + 7]); }
                else { const int k2 = ks - 2; w.x = cvt_pk_bf16(s1[8 * k2 + 0], s1[8 * k2 + 1]); w.y = cvt_pk_bf16(s1[8 * k2 + 2], s1[8 * k2 + 3]); w.z = cvt_pk_bf16(s1[8 * k2 + 4], s1[8 * k2 + 5]); w.w = cvt_pk_bf16(s1[8 * k2 + 6], s1[8 * k2 + 7]); }
                pb[ks] = __builtin_bit_cast(bf16x8, w); }
        }
        AT_BAR();
        { const int tmp = i0; i0 = i1; i1 = i2; i2 = tmp; }
    }
    AT_PV(i2);
    asm volatile("s_waitcnt vmcnt(0)" ::: "memory"); AT_BAR();
    if (!grp) AT_BAR();
#undef AT_DMA_K
#undef AT_DMA_V
#undef AT_BAR
#undef AT_PV
    const float ltot = lsum + __shfl_xor(lsum, 32);
    const float inv = 1.0f / ltot;
    bf16_t* orow = MIX + trow * 1024 + 512 + h * 64;
#pragma unroll
    for (int g = 0; g < 4; ++g) {
        u32x2 w0, w1;
        w0.x = cvt_pk_bf16(o0[4 * g] * inv, o0[4 * g + 1] * inv); w0.y = cvt_pk_bf16(o0[4 * g + 2] * inv, o0[4 * g + 3] * inv);
        w1.x = cvt_pk_bf16(o1[4 * g] * inv, o1[4 * g + 1] * inv); w1.y = cvt_pk_bf16(o1[4 * g + 2] * inv, o1[4 * g + 3] * inv);
        *(u32x2*)(orow + 8 * g + 4 * hh) = w0; *(u32x2*)(orow + 32 + 8 * g + 4 * hh) = w1;
    }
}
__device__ __forceinline__ void attn_queue(const Args& a, int l, LAS unsigned char* lds, volatile LAS unsigned* qw, unsigned* qctr, int tid, int wave, int lane) {
    const bf16_t* QB = (const bf16_t*)(a.ws + R_QB); const unsigned char* KT = a.ws + R_KT; const unsigned char* VT = a.ws + R_VT; bf16_t* MIX = (bf16_t*)(a.ws + R_MIX);
    for (;;) {
        if (tid == 0) *qw = __hip_atomic_fetch_add(qctr, 1u, __ATOMIC_RELAXED, __HIP_MEMORY_SCOPE_AGENT);
        __syncthreads();
        const int u = (int)__builtin_amdgcn_readfirstlane(*qw);
        __syncthreads();
        if (u >= 1536) break;
        if (u < 1024 && (u & 1)) { conv_expert_item(a, l, u >> 1, (LAS float*)(lds + 65536 + wave * 8704), wave, lane); continue; }
        const int au = u < 1024 ? (u >> 1) : u - 512;
        attn_unit(lds, QB, KT, VT, MIX, au & 31, 31 - (au >> 5), tid, wave, lane);
    }
}
__device__ __forceinline__ void attn_phase(const Args& a, LAS unsigned char* lds, int tid, int wave, int lane, int G) {
    const bf16_t* QB = (const bf16_t*)(a.ws + R_QB); const unsigned char* KT = a.ws + R_KT; const unsigned char* VT = a.ws + R_VT; bf16_t* MIX = (bf16_t*)(a.ws + R_MIX);
    for (int u = blockIdx.x; u < 512; u += G) {
        int bh, pq;
        if ((G & 7) == 0 && (512 % G) == 0) { const int x = blockIdx.x & 7, jj = (u / G) * (G / 8) + (blockIdx.x >> 3); bh = x + 8 * (jj >> 4); pq = jj & 15; }
        else { bh = u >> 4; pq = u & 15; }
        attn_unit(lds, QB, KT, VT, MIX, bh, 31 - pq, tid, wave, lane);
        attn_unit(lds, QB, KT, VT, MIX, bh, pq, tid, wave, lane);
    }
}

__device__ __forceinline__ void rwkv_scan(const Args& a, LAS unsigned char* lds, int tid, int wave, int lane, int G) {
    const float* SI = (const float*)(a.ws + R_SI); float* YR = (float*)(a.ws + R_YRAW);
    constexpr int CH = 16, NCH = SEQ / CH;
    LAS float* buf = (LAS float*)lds;
    const int lt = tid >> 5, lp = tid & 31;
    for (int blk = blockIdx.x; blk < 256; blk += G) {
        int bh, rg;
        if (G == 256) { const int x = blk & 7, j = blk >> 3; bh = x * 4 + (j >> 3); rg = j & 7; }
        else { bh = blk >> 3; rg = blk & 7; }
        const int row = rg * 8 + wave, b = bh >> 2, h = bh & 3;
        const f32x4* src = (const f32x4*)(SI + ((size_t)b * SEQ * 4 + h) * 384 + (size_t)lt * 1536) + lp;
        float* yo = YR + (size_t)b * SEQ * 256 + h * 64 + row;
        f32x4 g0 = src[0], g1 = src[32], g2 = src[64];
        { LAS f32x4* d = (LAS f32x4*)(buf + lt * 384) + lp; d[0] = g0; d[32] = g1; d[64] = g2; }
        __syncthreads();
        float s = 0.f;
        for (int c = 0; c < NCH; ++c) {
            const bool more = (c + 1 < NCH);
            if (more) { const f32x4* sn = src + (size_t)(c + 1) * CH * 384; g0 = sn[0]; g1 = sn[32]; g2 = sn[64]; }
            const LAS float* cb = buf + (c & 1) * CH * 384;
            float ykeep = 0.f;
#pragma unroll
            for (int i = 0; i < CH; ++i) {
                const LAS float* p = cb + i * 384;
                const float r = p[lane], w = p[64 + lane], k = p[128 + lane], kk = p[192 + lane], bb = p[256 + lane], v = p[320 + row];
                const float sa = -wave_sum_bc(s * kk);
                s = fmaf(sa, bb, fmaf(s, w, v * k));
                const float y = wave_sum_bc(s * r);
                ykeep = (lane == i) ? y : ykeep;
            }
            if (lane < CH) yo[(size_t)(c * CH + lane) * 256] = ykeep;
            if (more) { LAS f32x4* d = (LAS f32x4*)(buf + ((c + 1) & 1) * CH * 384 + lt * 384) + lp; d[0] = g0; d[32] = g1; d[64] = g2; }
            __syncthreads();
        }
    }
}
constexpr size_t RWP_CHUNK = 22 * 1024;
__device__ __forceinline__ u32x4 pack8(const float* x) { u32x4 w; w.x = cvt_pk_bf16(x[0], x[1]); w.y = cvt_pk_bf16(x[2], x[3]); w.z = cvt_pk_bf16(x[4], x[5]); w.w = cvt_pk_bf16(x[6], x[7]); return w; }
__device__ __forceinline__ bf16x8 frag2(const LAS bf16_t* p0, const LAS bf16_t* p1) { const u32x2 lo = *(const LAS u32x2*)p0, hi = *(const LAS u32x2*)p1; u32x4 w; w.x = lo.x; w.y = lo.y; w.z = hi.x; w.w = hi.y; return __builtin_bit_cast(bf16x8, w); }
__device__ __forceinline__ void rwkv_pre(const Args& a, int l, LAS unsigned char* lds, int wave, int lane, int G) {
    const bf16_t* PROJ = (const bf16_t*)(a.ws + R_PROJ); const bf16_t* LO = (const bf16_t*)(a.ws + R_LO); float* VF = (float*)(a.ws + WS_VF); bf16_t* BON = (bf16_t*)(a.ws + R_SI);
    unsigned char* RWP = a.ws + R_SI + 64 * MiB;
    LAS unsigned char* L = lds + wave * 16384;
    LAS bf16_t* AT = (LAS bf16_t*)L; LAS bf16_t* BH = (LAS bf16_t*)(L + 4096); LAS bf16_t* KH = (LAS bf16_t*)(L + 8192); LAS bf16_t* RT = (LAS bf16_t*)(L + 12288);
    LAS float* LT = (LAS float*)L; LAS float* TAL = (LAS float*)(L + 4096); LAS bf16_t* BB = (LAS bf16_t*)(L + 8192);
    LAS bf16_t* WL = (LAS bf16_t*)L; LAS bf16_t* GL = (LAS bf16_t*)(L + 4096);
    const int hh = lane >> 5, l31 = lane & 31;
    for (int ci = blockIdx.x * 8 + wave; ci < NB * 4 * 256; ci += G * 8) {
        const int bh = ci >> 8, c = ci & 255, b = bh >> 2, h = bh & 3;
        const size_t tok0 = (size_t)b * SEQ + (size_t)c * 32; const int jj = h * 64 + lane;
        unsigned char* out = RWP + (size_t)ci * RWP_CHUNK;
        float at[32], vv[32], bhv[32], khv[32];
        float pC;
        {
            const float* mu = FIN(I_RWMU) + l * 1024;
            const float mur = mu[jj], muk = mu[256 + jj], muv = mu[512 + jj];
            const float w0 = FIN(I_RWW0)[l * 256 + jj], a0 = FIN(I_RWA0)[l * 256 + jj], kkp = FIN(I_RWKK)[l * 256 + jj], kap = FIN(I_RWKA)[l * 256 + jj], rkp = FIN(I_RWRK)[l * 256 + jj];
            const float v0 = l > 0 ? FIN(I_RWV0)[(l - 1) * 256 + jj] : 0.f;
            float rp = 0.f, kp = 0.f, vp = 0.f;
            if (c != 0) { const bf16_t* pp = PROJ + (tok0 - 1) * INWP; rp = bf2f(pp[C_RWR + jj]); kp = bf2f(pp[C_RWK + jj]); vp = bf2f(pp[C_RWV + jj]); }
            float p = 1.f;
            unsigned raw[2][4][6]; float rvf[2][4];
#define RW_LOADG(buf_, g_) do { _Pragma("unroll") for (int q_ = 0; q_ < 4; ++q_) { const size_t tk_ = tok0 + 4 * (g_) + q_; const bf16_t* pc_ = PROJ + tk_ * INWP; const bf16_t* lo_ = LO + tk_ * 1024; \
                raw[buf_][q_][0] = pc_[C_RWR + jj]; raw[buf_][q_][1] = pc_[C_RWK + jj]; raw[buf_][q_][2] = pc_[C_RWV + jj]; raw[buf_][q_][3] = lo_[jj]; raw[buf_][q_][4] = lo_[256 + jj]; \
                raw[buf_][q_][5] = lo_[768 + jj]; rvf[buf_][q_] = VF[tk_ * 256 + jj]; } } while (0)
            RW_LOADG(0, 0);
#pragma unroll
            for (int t = 0; t < 32; ++t) { const size_t tok = tok0 + t; const int g_ = t >> 2, q = t & 3, bu = g_ & 1;
                if (q == 0 && g_ < 7) { RW_LOADG(bu ^ 1, g_ + 1); asm volatile("" ::: "memory"); }
                const float rc = bf2f(raw[bu][q][0]), kc = bf2f(raw[bu][q][1]), vc = bf2f(raw[bu][q][2]);
                const float r = rc + (rp - rc) * mur, k = kc + (kp - kc) * muk; float v = vc + (vp - vc) * muv; rp = rc; kp = kc; vp = vc;
                const float wl = w0 + bf2f(raw[bu][q][3]); const float w = __expf(-__expf(-__logf(1.0f + __expf(-wl)) - 0.5f));
                const float aa = sigmoidf_(a0 + bf2f(raw[bu][q][4]));
                if (l > 0) { const float vf = rvf[bu][q]; v += (vf - v) * sigmoidf_(v0 + bf2f(raw[bu][q][5])); } else VF[tok * 256 + jj] = v;
                const float kk0 = k * kkp; const float kk = kk0 * __builtin_amdgcn_rcpf(fmaxf(sqrtf(wave_sum_bc(kk0 * kk0)), 1e-12f));
                const float kx = k * (1.0f + (aa - 1.0f) * kap), bb = kk * aa;
                BON[tok * 256 + jj] = cvt1(wave_sum_bc(r * kx * rkp) * v);
                vv[t] = v;
                const float pprev = p; p *= w; at[t] = -kk * pprev; const float ip = __builtin_amdgcn_rcpf(p); bhv[t] = bb * ip; khv[t] = kx * ip;
                const int idx = ((lane >> 3) * 32 + t) * 8 + (lane & 7);
                AT[idx] = cvt1(at[t]); BH[idx] = cvt1(bhv[t]); KH[idx] = cvt1(khv[t]); RT[idx] = cvt1(r * p);
                if ((t & 3) == 3) asm volatile("" ::: "memory"); }
#undef RW_LOADG
            pC = p;
        }
        {
#pragma unroll
            for (int sh = 0; sh < 4; ++sh) { const int s2 = sh >> 1, h2 = sh & 1; float x[8];
#pragma unroll
                for (int j = 0; j < 8; ++j) x[j] = vv[16 * s2 + 8 * (j >> 2) + 4 * h2 + (j & 3)];
                *(u32x4*)(out + (size_t)(18 + sh) * 1024 + lane * 16) = pack8(x); }
        }
        LDS_WAIT();
        f32x16 lt, ta, abr, akr;
#pragma unroll
        for (int r = 0; r < 16; ++r) { lt[r] = 0.f; ta[r] = 0.f; abr[r] = 0.f; akr[r] = 0.f; }
#pragma unroll
        for (int s4 = 0; s4 < 4; ++s4) { const int fo = ((2 * s4 + hh) * 32 + l31) * 8;
            const bf16x8 fa = *(const LAS bf16x8*)(AT + fo), fb = *(const LAS bf16x8*)(BH + fo), fk = *(const LAS bf16x8*)(KH + fo), fr = *(const LAS bf16x8*)(RT + fo);
            lt = __builtin_amdgcn_mfma_f32_32x32x16_bf16(fa, fb, lt, 0, 0, 0); ta = __builtin_amdgcn_mfma_f32_32x32x16_bf16(fa, fk, ta, 0, 0, 0);
            abr = __builtin_amdgcn_mfma_f32_32x32x16_bf16(fb, fr, abr, 0, 0, 0); akr = __builtin_amdgcn_mfma_f32_32x32x16_bf16(fk, fr, akr, 0, 0, 0); }
#pragma unroll
        for (int r = 0; r < 16; ++r) { const int row = (r & 3) + 8 * (r >> 2) + 4 * hh;
            if (!(l31 < row)) { lt[r] = 0.f; ta[r] = 0.f; } if (!(row <= l31)) { abr[r] = 0.f; akr[r] = 0.f; } }
        LDS_WAIT();
#pragma unroll
        for (int r = 0; r < 16; ++r) { const int row = (r & 3) + 8 * (r >> 2) + 4 * hh; LT[row * 32 + l31] = lt[r]; TAL[row * 32 + l31] = ta[r]; }
#pragma unroll
        for (int ic = 0; ic < 4; ++ic) { float x[8];
#pragma unroll
            for (int j = 0; j < 8; ++j) { x[j] = bhv[8 * ic + j] * pC; khv[8 * ic + j] *= pC; }
            *(LAS u32x4*)(BB + (ic * 64 + lane) * 8) = pack8(x); }
        LDS_WAIT();
        {
            float g[32];
#pragma unroll
            for (int j = 0; j < 32; ++j) g[j] = TAL[j * 32 + l31];
#pragma unroll
            for (int j = 1; j < 32; ++j) {
#pragma unroll
                for (int i4 = 0; i4 * 4 < j; ++i4) { const f32x4 c4 = *(const LAS f32x4*)(LT + j * 32 + 4 * i4);
#pragma unroll
                    for (int ii = 0; ii < 4; ++ii) { const int i = 4 * i4 + ii; if (i < j) { at[j] = fmaf(at[i], c4[ii], at[j]); g[j] = fmaf(g[i], c4[ii], g[j]); } } }
                if ((j & 1) == 1) asm volatile("" ::: "memory"); }
            LDS_WAIT();
#pragma unroll
            for (int ic = 0; ic < 4; ++ic) { *(LAS u32x4*)(WL + (ic * 64 + lane) * 8) = pack8(at + 8 * ic); if (lane < 32) *(LAS u32x4*)(GL + (ic * 32 + lane) * 8) = pack8(g + 8 * ic); }
        }
        LDS_WAIT();
        bf16x8 ab[2];
#pragma unroll
        for (int s2 = 0; s2 < 2; ++s2) { float x[8];
#pragma unroll
            for (int j = 0; j < 8; ++j) x[j] = abr[8 * s2 + j];
            ab[s2] = __builtin_bit_cast(bf16x8, pack8(x)); }
        bf16x8 gf[2];
#pragma unroll
        for (int s2 = 0; s2 < 2; ++s2) gf[s2] = frag2(GL + ((2 * s2) * 32 + l31) * 8 + 4 * hh, GL + ((2 * s2 + 1) * 32 + l31) * 8 + 4 * hh);
#define RW_STORE_TILE(acc_, unit_) do { _Pragma("unroll") for (int s2_ = 0; s2_ < 2; ++s2_) { float x_[8]; _Pragma("unroll") for (int j_ = 0; j_ < 8; ++j_) x_[j_] = acc_[8 * s2_ + j_]; \
            *(u32x4*)(out + (size_t)((unit_) + s2_) * 1024 + lane * 16) = pack8(x_); } } while (0)
        {
            f32x16 acc = akr;
#pragma unroll
            for (int s2 = 0; s2 < 2; ++s2) acc = __builtin_amdgcn_mfma_f32_32x32x16_bf16(gf[s2], ab[s2], acc, 0, 0, 0);
            RW_STORE_TILE(acc, 16);
        }
        const float pcv0 = __shfl(pC, l31), pcv1 = __shfl(pC, 32 + l31);
#pragma unroll
        for (int kb = 0; kb < 2; ++kb) {
            bf16x8 wf[2];
#pragma unroll
            for (int s2 = 0; s2 < 2; ++s2) wf[s2] = frag2(WL + ((2 * s2) * 64 + 32 * kb + l31) * 8 + 4 * hh, WL + ((2 * s2 + 1) * 64 + 32 * kb + l31) * 8 + 4 * hh);
            {
                f32x16 acc;
#pragma unroll
                for (int g4 = 0; g4 < 4; ++g4) { const u32x2 w = *(const LAS u32x2*)(RT + ((4 * kb + g4) * 32 + l31) * 8 + 4 * hh);
                    acc[4 * g4] = bflo(w.x); acc[4 * g4 + 1] = bfhi(w.x); acc[4 * g4 + 2] = bflo(w.y); acc[4 * g4 + 3] = bfhi(w.y); }
#pragma unroll
                for (int s2 = 0; s2 < 2; ++s2) acc = __builtin_amdgcn_mfma_f32_32x32x16_bf16(wf[s2], ab[s2], acc, 0, 0, 0);
                RW_STORE_TILE(acc, 8 + kb * 2);
            }
#pragma unroll
            for (int q = 0; q < 2; ++q) {
                f32x16 acc;
#pragma unroll
                for (int r = 0; r < 16; ++r) acc[r] = 0.f;
#pragma unroll
                for (int s2 = 0; s2 < 2; ++s2) { const bf16x8 bf_ = frag2(BB + ((2 * s2) * 64 + 32 * q + l31) * 8 + 4 * hh, BB + ((2 * s2 + 1) * 64 + 32 * q + l31) * 8 + 4 * hh);
                    acc = __builtin_amdgcn_mfma_f32_32x32x16_bf16(wf[s2], bf_, acc, 0, 0, 0); }
                if (kb == q) { const float pcv = q ? pcv1 : pcv0;
#pragma unroll
                    for (int r = 0; r < 16; ++r) if ((r & 3) + 8 * (r >> 2) + 4 * hh == l31) acc[r] += pcv; }
                RW_STORE_TILE(acc, (kb * 2 + q) * 2);
            }
        }
#pragma unroll
        for (int q = 0; q < 2; ++q) {
            f32x16 acc;
#pragma unroll
            for (int g4 = 0; g4 < 4; ++g4)
#pragma unroll
                for (int jx = 0; jx < 4; ++jx) { const float va = __shfl(khv[8 * g4 + jx], 32 * q + l31), vb = __shfl(khv[8 * g4 + 4 + jx], 32 * q + l31); acc[4 * g4 + jx] = hh ? vb : va; }
#pragma unroll
            for (int s2 = 0; s2 < 2; ++s2) { const bf16x8 bf_ = frag2(BB + ((2 * s2) * 64 + 32 * q + l31) * 8 + 4 * hh, BB + ((2 * s2 + 1) * 64 + 32 * q + l31) * 8 + 4 * hh);
                acc = __builtin_amdgcn_mfma_f32_32x32x16_bf16(gf[s2], bf_, acc, 0, 0, 0); }
            RW_STORE_TILE(acc, 12 + q * 2);
        }
#undef RW_STORE_TILE
        LDS_WAIT();
    }
}
__device__ __forceinline__ void rwkv_main(const Args& a, int l, LAS unsigned char* lds, int bh, int tid, int wave, int lane) {
    const unsigned char* RWP = a.ws + R_SI + 64 * MiB + (size_t)bh * 256 * RWP_CHUNK;
    const bf16_t* BON = (const bf16_t*)(a.ws + R_SI); const bf16_t* LO = (const bf16_t*)(a.ws + R_LO); bf16_t* MIX = (bf16_t*)(a.ws + R_MIX);
    LAS float* YB = (LAS float*)(lds + 45056);
    const int hh = lane >> 5, l31 = lane & 31, vb = wave;
    f32x16 st[2];
#pragma unroll
    for (int r = 0; r < 16; ++r) { st[0][r] = 0.f; st[1][r] = 0.f; }
    u32x4 g0, g1, g2 = zero4();
    g0 = *(const u32x4*)(RWP + tid * 16); g1 = *(const u32x4*)(RWP + (512 + tid) * 16); if (tid < 384) g2 = *(const u32x4*)(RWP + (1024 + tid) * 16);
    *(LAS u32x4*)(lds + tid * 16) = g0; *(LAS u32x4*)(lds + (512 + tid) * 16) = g1; if (tid < 384) *(LAS u32x4*)(lds + (1024 + tid) * 16) = g2;
    __syncthreads();
    const int jj = (bh & 3) * 64 + lane;
    const float lng = FIN(I_RWLG)[l * 256 + jj], lnb = FIN(I_RWLB)[l * 256 + jj];
    float pb_[4], pg_[4];
#define RW_POST_LOAD(cc_) do { _Pragma("unroll") for (int q_ = 0; q_ < 4; ++q_) { const size_t tok_ = (size_t)(bh >> 2) * SEQ + (size_t)(cc_) * 32 + wave * 4 + q_; pb_[q_] = bf2f(BON[tok_ * 256 + jj]); pg_[q_] = bf2f(LO[tok_ * 1024 + 512 + jj]); } } while (0)
#define RW_POST(cc_) do { const LAS float* yb_ = YB + ((cc_) & 1) * 2048; _Pragma("unroll") for (int q_ = 0; q_ < 4; ++q_) { const int t_ = wave * 4 + q_; const size_t tok_ = (size_t)(bh >> 2) * SEQ + (size_t)(cc_) * 32 + t_; \
        const float y_ = yb_[t_ * 64 + lane]; const float mean_ = wave_sum(y_) * (1.0f / 64.0f); const float d_ = y_ - mean_; const float var_ = wave_sum(d_ * d_) * (1.0f / 64.0f); \
        const float yn_ = d_ * __builtin_amdgcn_rsqf(var_ + 64e-5f) * lng + lnb; \
        MIX[tok_ * 1024 + 256 + jj] = (bf16_t)f2bf((yn_ + pb_[q_]) * pg_[q_]); } } while (0)
    for (int c = 0; c < 256; ++c) {
        const bool more = (c + 1 < 256);
        if (c > 0) RW_POST_LOAD(c - 1);
        if (more) { const unsigned char* nx = RWP + (size_t)(c + 1) * RWP_CHUNK; g0 = *(const u32x4*)(nx + tid * 16); g1 = *(const u32x4*)(nx + (512 + tid) * 16); if (tid < 384) g2 = *(const u32x4*)(nx + (1024 + tid) * 16); }
        if (wave < 2) {
            const LAS unsigned char* in = lds + (c & 1) * 22528;
#define RW_F(unit_) (*(const LAS bf16x8*)(in + (unit_) * 1024 + lane * 16))
            const bf16x8 vf0 = *(const LAS bf16x8*)(in + (18 + hh) * 1024 + (32 * vb + l31) * 16), vf1 = *(const LAS bf16x8*)(in + (20 + hh) * 1024 + (32 * vb + l31) * 16);
            bf16x8 hi[2][2], lo[2][2];
#pragma unroll
            for (int kb = 0; kb < 2; ++kb)
#pragma unroll
                for (int s2 = 0; s2 < 2; ++s2) { float xh[8], xl[8];
#pragma unroll
                    for (int j = 0; j < 8; ++j) { const float x = st[kb][8 * s2 + j]; const float hf = bf2f(f2bf(x)); xh[j] = hf; xl[j] = x - hf; }
                    hi[kb][s2] = __builtin_bit_cast(bf16x8, pack8(xh)); lo[kb][s2] = __builtin_bit_cast(bf16x8, pack8(xl)); }
            f32x16 y, n0, n1;
#pragma unroll
            for (int r = 0; r < 16; ++r) { y[r] = 0.f; n0[r] = 0.f; n1[r] = 0.f; }
#pragma unroll
            for (int kb = 0; kb < 2; ++kb)
#pragma unroll
                for (int s2 = 0; s2 < 2; ++s2) {
                    y = __builtin_amdgcn_mfma_f32_32x32x16_bf16(RW_F(8 + kb * 2 + s2), hi[kb][s2], y, 0, 0, 0);
                    const bf16x8 m0 = RW_F((kb * 2 + 0) * 2 + s2), m1 = RW_F((kb * 2 + 1) * 2 + s2);
                    n0 = __builtin_amdgcn_mfma_f32_32x32x16_bf16(m0, hi[kb][s2], n0, 0, 0, 0); n0 = __builtin_amdgcn_mfma_f32_32x32x16_bf16(m0, lo[kb][s2], n0, 0, 0, 0);
                    n1 = __builtin_amdgcn_mfma_f32_32x32x16_bf16(m1, hi[kb][s2], n1, 0, 0, 0); n1 = __builtin_amdgcn_mfma_f32_32x32x16_bf16(m1, lo[kb][s2], n1, 0, 0, 0);
                }
            y = __builtin_amdgcn_mfma_f32_32x32x16_bf16(RW_F(16), vf0, y, 0, 0, 0); y = __builtin_amdgcn_mfma_f32_32x32x16_bf16(RW_F(17), vf1, y, 0, 0, 0);
            n0 = __builtin_amdgcn_mfma_f32_32x32x16_bf16(RW_F(12), vf0, n0, 0, 0, 0); n0 = __builtin_amdgcn_mfma_f32_32x32x16_bf16(RW_F(13), vf1, n0, 0, 0, 0);
            n1 = __builtin_amdgcn_mfma_f32_32x32x16_bf16(RW_F(14), vf0, n1, 0, 0, 0); n1 = __builtin_amdgcn_mfma_f32_32x32x16_bf16(RW_F(15), vf1, n1, 0, 0, 0);
#undef RW_F
            LAS float* yo = YB + (c & 1) * 2048 + 32 * vb + l31;
#pragma unroll
            for (int r = 0; r < 16; ++r) yo[((r & 3) + 8 * (r >> 2) + 4 * hh) * 64] = y[r];
            st[0] = n0; st[1] = n1;
        }
        if (c > 0) RW_POST(c - 1);
        if (more) { LAS unsigned char* d = lds + ((c + 1) & 1) * 22528; *(LAS u32x4*)(d + tid * 16) = g0; *(LAS u32x4*)(d + (512 + tid) * 16) = g1; if (tid < 384) *(LAS u32x4*)(d + (1024 + tid) * 16) = g2; }
        __syncthreads();
    }
    RW_POST_LOAD(255); RW_POST(255);
#undef RW_POST
#undef RW_POST_LOAD
    __syncthreads();
}

__device__ __forceinline__ void rwkv_post(const Args& a, int l, int wave, int lane, int G) {
    const float* SI = (const float*)(a.ws + R_SI); const float* YR = (const float*)(a.ws + R_YRAW); const bf16_t* LO = (const bf16_t*)(a.ws + R_LO); bf16_t* MIX = (bf16_t*)(a.ws + R_MIX);
#pragma unroll 4
    for (int idx = blockIdx.x * NWAVES + wave; idx < T * 4; idx += G * NWAVES) {
        const size_t t = idx >> 2; const int h = idx & 3, j = h * 64 + lane;
        const float y = YR[t * 256 + j];
        const float mean = wave_sum(y) * (1.0f / 64.0f); const float d = y - mean; const float var = wave_sum(d * d) * (1.0f / 64.0f);
        const float yn = d * __builtin_amdgcn_rsqf(var + 64e-5f) * FIN(I_RWLG)[l * 256 + j] + FIN(I_RWLB)[l * 256 + j];
        const float bonus = bf2f(((const bf16_t*)SI)[t * 256 + j]);
        const float g = bf2f(LO[t * 1024 + 512 + j]);
        MIX[t * 1024 + 256 + j] = (bf16_t)f2bf((yn + bonus) * g);
    }
}

__device__ __forceinline__ void phase_norm2(const Args& a, int l, LAS unsigned char* lds, int tid, int wave, int lane, int G) {
    LAS unsigned char* img_hi = lds; LAS unsigned char* img_lo = lds + 65536;
    LAS float* pbuf = (LAS float*)lds;
    LAS int* hist = (LAS int*)(lds + 135168);
    const float* rw = FIN(I_RTW) + (size_t)l * 1024 * 32;
    const float* MOD = (const float*)(a.ws + WS_MOD);
    int* tki = (int*)(a.ws + MO_IDX); float* tkw = (float*)(a.ws + MO_W); int* blkcnt = (int*)(a.ws + MO_BLKCNT);
    const float* gn = FIN(I_NFG) + l * D;
    const int hh = lane >> 5, l31 = lane & 31;
    bf16x8 whi[8], wlo[8];
#pragma unroll
    for (int s = 0; s < 8; ++s) { float xh[8], xl[8];
#pragma unroll
        for (int i = 0; i < 8; ++i) { const float w = rw[(size_t)(128 * wave + 16 * s + 8 * hh + i) * 32 + l31]; const float hf = bf2f(f2bf(w)); xh[i] = hf; xl[i] = w - hf; }
        whi[s] = __builtin_bit_cast(bf16x8, pack8(xh)); wlo[s] = __builtin_bit_cast(bf16x8, pack8(xl)); }
    const float rbias = FIN(I_RTB)[l * 32 + l31];
    for (int rb = blockIdx.x; rb < 256; rb += G) {
        if (tid < 32) hist[tid] = 0;
        f32x4 gsc[4], shv[4];
        { const int b0 = (rb * 256) >> 13; const float* sh = MOD + (size_t)(l * 8 + b0) * 6144 + 3072; const float* sc = sh + 1024;
#pragma unroll
          for (int j = 0; j < 4; ++j) { gsc[j] = ((const f32x4*)gn)[64 * j + lane] * (1.0f + ((const f32x4*)sc)[64 * j + lane]); shv[j] = ((const f32x4*)sh)[64 * j + lane]; } }
        f32x4 v[4][4];
#pragma unroll
        for (int q = 0; q < 4; ++q)
#pragma unroll
            for (int j = 0; j < 4; ++j) v[q][j] = ((const f32x4*)(a.out + (size_t)(rb * 256 + 4 * wave + q) * D))[64 * j + lane];
        for (int sbt = 0; sbt < 8; ++sbt) {
            const int mb = rb * 256 + sbt * 32;
#pragma unroll
            for (int q = 0; q < 4; ++q) { const int row = 4 * wave + q, m = mb + row; float ss = 0.f;
#pragma unroll
                for (int j = 0; j < 4; ++j) ss += (v[q][j].x * v[q][j].x + v[q][j].y * v[q][j].y) + (v[q][j].z * v[q][j].z + v[q][j].w * v[q][j].w);
                ss = wave_sum(ss);
                const float rstd = __builtin_amdgcn_rsqf(ss * (1.0f / D) + NORM_EPS);
#pragma unroll
                for (int j = 0; j < 4; ++j) { const f32x4 hq = v[q][j] * rstd * gsc[j] + shv[j]; ((unsigned*)(a.ws + WS_HN8 + (size_t)m * D))[64 * j + lane] = pk4_fp8(hq.x, hq.y, hq.z, hq.w);
                    u32x2 wh, wl; wh.x = cvt_pk_bf16(hq.x, hq.y); wh.y = cvt_pk_bf16(hq.z, hq.w);
                    wl.x = cvt_pk_bf16(hq.x - bflo(wh.x), hq.y - bfhi(wh.x)); wl.y = cvt_pk_bf16(hq.z - bflo(wh.y), hq.w - bfhi(wh.y));
                    const int off = row * 2048 + (((32 * j + (lane >> 1)) ^ (row & 15)) << 4) + ((lane & 1) << 3);
                    *(LAS u32x2*)(img_hi + off) = wh; *(LAS u32x2*)(img_lo + off) = wl; } }
            if (sbt < 7) {
#pragma unroll
                for (int q = 0; q < 4; ++q)
#pragma unroll
                    for (int j = 0; j < 4; ++j) v[q][j] = ((const f32x4*)(a.out + (size_t)(mb + 32 + 4 * wave + q) * D))[64 * j + lane];
            }
            LDS_BARRIER();
            f32x16 acc;
#pragma unroll
            for (int r = 0; r < 16; ++r) acc[r] = 0.f;
#pragma unroll
            for (int s = 0; s < 8; ++s) { const int off = l31 * 2048 + (((16 * wave + 2 * s + hh) ^ (l31 & 15)) << 4);
                const bf16x8 bh = *(const LAS bf16x8*)(img_hi + off), bl = *(const LAS bf16x8*)(img_lo + off);
                acc = __builtin_amdgcn_mfma_f32_32x32x16_bf16(whi[s], bh, acc, 0, 0, 0);
                acc = __builtin_amdgcn_mfma_f32_32x32x16_bf16(wlo[s], bh, acc, 0, 0, 0);
                acc = __builtin_amdgcn_mfma_f32_32x32x16_bf16(whi[s], bl, acc, 0, 0, 0); }
            LDS_BARRIER();
#pragma unroll
            for (int r = 0; r < 16; ++r) pbuf[wave * 1056 + ((r & 3) + 8 * (r >> 2) + 4 * hh) * 33 + l31] = acc[r];
            LDS_BARRIER();
            {
                float val[4]; float tv[4][4]; int ti[4][4];
#pragma unroll
                for (int q = 0; q < 4; ++q) { float sacc = 0.f;
#pragma unroll
                    for (int w2 = 0; w2 < 8; ++w2) sacc += pbuf[w2 * 1056 + l31 * 33 + 4 * wave + q];
                    val[q] = sacc + rbias; }
#pragma unroll
                for (int k = 0; k < 4; ++k) {
#pragma unroll
                    for (int q = 0; q < 4; ++q) { float mxv = val[q];
                        mxv = fmaxf(mxv, dpp_f<0xB1>(mxv)); mxv = fmaxf(mxv, dpp_f<0x4E>(mxv)); mxv = fmaxf(mxv, dpp_f<0x141>(mxv)); mxv = fmaxf(mxv, dpp_f<0x140>(mxv));
                        mxv = fmaxf(mxv, __builtin_bit_cast(float, __builtin_amdgcn_ds_swizzle(__builtin_bit_cast(int, mxv), 0x401F)));
                        const unsigned bal = (unsigned)__builtin_amdgcn_ballot_w64(val[q] == mxv);
                        const int idx = __builtin_ctz(bal);
                        tv[q][k] = mxv; ti[q][k] = idx; if ((lane & 31) == idx) val[q] = -__builtin_inff(); } }
#pragma unroll
                for (int q = 0; q < 4; ++q) { const int m = mb + 4 * wave + q;
                    const float e1 = __expf(tv[q][1] - tv[q][0]), e2 = __expf(tv[q][2] - tv[q][0]), e3 = __expf(tv[q][3] - tv[q][0]); const float inv = __builtin_amdgcn_rcpf(1.0f + e1 + e2 + e3);
                    if (lane == 0) {
                        tki[m * 4] = ti[q][0]; tki[m * 4 + 1] = ti[q][1]; tki[m * 4 + 2] = ti[q][2]; tki[m * 4 + 3] = ti[q][3];
                        tkw[m * 4] = inv; tkw[m * 4 + 1] = e1 * inv; tkw[m * 4 + 2] = e2 * inv; tkw[m * 4 + 3] = e3 * inv;
                        lds_add(&hist[ti[q][0]]); lds_add(&hist[ti[q][1]]); lds_add(&hist[ti[q][2]]); lds_add(&hist[ti[q][3]]); } }
            }
            LDS_BARRIER();
        }
        if (tid < 32) blkcnt[rb * 32 + tid] = hist[tid];
        __syncthreads();
    }
}
__device__ __forceinline__ void phase_plan(const Args& a, LAS unsigned char* lds, int tid, int G) {
    LAS int* tot = (LAS int*)lds; LAS int* base = tot + 32; LAS int* pstart = tot + 64; LAS int* cur = tot + 96;
    const int* blkcnt = (const int*)(a.ws + MO_BLKCNT); const int* tki = (const int*)(a.ws + MO_IDX);
    int* pos = (int*)(a.ws + MO_POS); int* rowtok = (int*)(a.ws + MO_ROWTOK); int* tile_e = (int*)(a.ws + MO_TILEE);
    unsigned* ctl = (unsigned*)(a.ws + WS_CTL);
    for (int rb = blockIdx.x; rb < 256; rb += G) {
        {
            LAS int* ptot = tot + 256; LAS int* pbase = tot + 768; const int e = tid & 31, part = tid >> 5; int c[16]; int t = 0, bs = 0;
#pragma unroll
            for (int j = 0; j < 16; ++j) c[j] = blkcnt[(part * 16 + j) * 32 + e];
#pragma unroll
            for (int j = 0; j < 16; ++j) { if (part * 16 + j < rb) bs += c[j]; t += c[j]; }
            ptot[part * 32 + e] = t; pbase[part * 32 + e] = bs;
            __syncthreads();
            if (tid < 32) { int tt = 0, bb = 0;
#pragma unroll
                for (int p = 0; p < 16; ++p) { tt += ptot[p * 32 + tid]; bb += pbase[p * 32 + tid]; }
                tot[tid] = tt; base[tid] = bb; cur[tid] = 0; }
        }
        __syncthreads();
        if (tid == 0) { int ps = 0; for (int e = 0; e < 32; ++e) { pstart[e] = ps; ps += (tot[e] + 255) & ~255; } if (rb == 0) ctl[CW_NTILES] = (unsigned)(ps >> 8); }
        __syncthreads();
        for (int q = tid; q < 1024; q += NTHR) { const int row = rb * 256 + (q >> 2), k = q & 3; const int e = tki[row * 4 + k];
            const int r = lds_add(&cur[e]); const int p = pstart[e] + base[e] + r; pos[row * 4 + k] = p; rowtok[p] = row; }
        if (rb < 32) { const int e = rb, pe = pstart[e] + ((tot[e] + 255) & ~255); for (int p = pstart[e] + tot[e] + tid; p < pe; p += NTHR) rowtok[p] = 0;
            for (int tl = (pstart[e] >> 8) + tid; tl < (pe >> 8); tl += NTHR) tile_e[tl] = e; }
        __syncthreads();
    }
}

constexpr int PH_PER_LAYER = 13, NPH = 2 + DEPTH * PH_PER_LAYER;
#ifndef MK_SPLIT
#define MK_SPLIT 0
#endif
struct KArgs { Args a; int li, pad; };

__global__ void __launch_bounds__(NTHR, 2) fwd(KArgs ka) {
    extern __shared__ __attribute__((aligned(16))) unsigned char lds_raw[];
    LAS unsigned char* lds = (LAS unsigned char*)lds_raw;
    const int tid0 = threadIdx.x, G = gridDim.x, wave0 = __builtin_amdgcn_readfirstlane(tid0 >> 6);
    volatile LAS unsigned* MISC = (volatile LAS unsigned*)(lds + MISC_OFF);
    if (tid0 < 32) MISC[tid0] = 0u;
    __syncthreads();
    unsigned* ctl0 = (unsigned*)(ka.a.ws + WS_CTL);
    const int lo = ka.a.ph_lo, hi = ka.a.ph_hi;
    XcdBarrier bar; bar.bar = ctl0 + CW_BAR + ka.li * XCD_BAR_WORDS; bar.x = 0; bar.st = MISC + 8;
    if (hi - lo > 1) bar = xcd_barrier_post(ctl0 + CW_BAR + ka.li * XCD_BAR_WORDS, MISC + 8);
#ifndef MK_PHMASK
#define MK_PHMASK 0xFFFF
#endif
#define PHM(j) ((MK_PHMASK >> (j)) & 1)
#ifndef PROBE_DUP
#define PROBE_DUP 0
#endif
#define REP(id) for (int rep_ = 0; rep_ < 1 + ((PROBE_DUP >> (id)) & 1); ++rep_)
#define IN(k) (lo <= (k) && (k) < hi)
#define SEAM(k) do { if (IN(k) && IN((k) + 1)) xcd_barrier(bar); } while (0)

#define FRESH() int lane; asm volatile("v_mbcnt_lo_u32_b32 %0, -1, 0\n\tv_mbcnt_hi_u32_b32 %0, -1, %0" : "=v"(lane)); int wave = wave0; asm volatile("" : "+s"(wave)); const int tid = wave * 64 + lane; (void)tid; \
    Args a = ka.a; { size_t z_ = 0; asm volatile("" : "+s"(z_)); a.ws = ka.a.ws + z_; a.out = ka.a.out + z_; } \
    bf16_t* PROJ = (bf16_t*)(a.ws + R_PROJ); bf16_t* MIX = (bf16_t*)(a.ws + R_MIX); bf16_t* HN = (bf16_t*)(a.ws + WS_HN); const bf16_t* SM = (const bf16_t*)(a.ws + WS_WSM); unsigned* ctl = (unsigned*)(a.ws + WS_CTL); (void)PROJ; (void)MIX; (void)HN; (void)SM; (void)ctl
    if (PHM(0) && IN(0)) { FRESH(); phase_init(a, lds, tid, G); SEAM(0); }

    for (int l = 0; l < DEPTH; ++l) {
        const int pb = 1 + l * PH_PER_LAYER;
        const bool own01 = (l > 0) && (G == T / 256) && IN(pb + 0) && IN(pb + 1) && IN(pb - 3);
        if (PHM(1) && IN(pb + 0)) { FRESH(); if (!own01) { REP(0) phase_conv<0>(a, l, lds, tid, wave, lane, G); } phase_norm1<0>(a, l, wave, lane, G, false);
            SEAM(pb + 0); }
        if (PHM(2) && IN(pb + 1)) { FRESH();
            pg8::Gemm g{HN, (const bf16_t*)(a.ws + WS_WIN), 1024, 1024, 1024, nullptr}; pg8::Order S; S.init(T / 256, INWP / 256, G, (int)blockIdx.x);
            pg8::EpiBf16 E{PROJ, INWP, nullptr, 0};
            REP(1) pg8::gemm_phase<pg8::EpiBf16, false>(lds, g, S, E, tid);
            SEAM(pb + 1);
        }
        if (PHM(3) && IN(pb + 2)) { FRESH(); REP(2) phase_pre(a, l, tid, G); s5_repack(a, tid, G); SEAM(pb + 2); }
        const bool fuse34 = (G == T / 256) && IN(pb + 3) && IN(pb + 4) && IN(pb + 5);
        if (PHM(4) && IN(pb + 3)) { FRESH();
            const bf16_t* AP = (const bf16_t*)(a.ws + R_AP); bf16_t* QKV = (bf16_t*)(a.ws + R_QKV); bf16_t* LO = (bf16_t*)(a.ws + R_LO); bf16_t* BU = (bf16_t*)(a.ws + R_BU);
#define SMALL_GEMM(A_, LDA_, BOFF_, NN_, O_, LDC_) do { pg8::Gemm g{A_, SM + (BOFF_) / 2, LDA_, 256, 256, nullptr}; pg8::Order S; S.init(T / 256, NN_, G, (int)blockIdx.x); \
                pg8::EpiBf16 E{O_, LDC_, nullptr, 0}; pg8::gemm_phase<pg8::EpiBf16, false>(lds, g, S, E, tid); } while (0)
            REP(3) {
            SMALL_GEMM(PROJ + C_QC, INWP, SM_WQ, 2, QKV, 1024);
            SMALL_GEMM(PROJ + C_KVC, INWP, SM_WKV, 2, QKV + 512, 1024);
            SMALL_GEMM(AP, 512, SM_WLORA, 3, LO, 1024);
            if (l > 0) SMALL_GEMM(AP + 256, 512, SM_WVV, 1, LO + 768, 1024);
            { pg8::Gemm g{(const bf16_t*)(a.ws + R_UP), (const bf16_t*)(a.ws + R_WE), 768, 512, 512, nullptr}; pg8::Order S; S.init(128, 1, G, (int)blockIdx.x, (const int*)(a.ws + WS_S5TAB), (size_t)256 * 512);
              pg8::EpiS5E E{(float*)(a.ws + R_EB)}; pg8::gemm_phase<pg8::EpiS5E, false>(lds, g, S, E, tid);
              if (fuse34 && (int)blockIdx.x < 128) { const int pm = ((int)blockIdx.x & 7) * 16 + ((int)blockIdx.x >> 3);
                  s5_chunk_scan(a, l, tid, G, (pm & 7) * 16 + (pm >> 3)); } }
            }
#undef SMALL_GEMM
            if (fuse34) { __syncthreads(); ret_pass_a(a, lds, tid, wave, lane, G); }
            SEAM(pb + 3);
        }
        if (PHM(5) && IN(pb + 4) && !fuse34) { FRESH();
            REP(4) mla_finish(a, lds, tid, G);
            REP(6) s5_chunk_scan(a, l, tid, G);
            __syncthreads();
            REP(7) ret_pass_a(a, lds, tid, wave, lane, G);
            SEAM(pb + 4);
        }
        if (PHM(6) && IN(pb + 5) && fuse34) { FRESH(); mla_finish(a, lds, tid, G); __syncthreads(); }
        if (PHM(6) && IN(pb + 5)) { FRESH();
            { pg8::Gemm g{(const bf16_t*)(a.ws + R_UP), (const bf16_t*)(a.ws + R_WY), 768, 768, 768, nullptr}; pg8::Order S; S.init(128, 2, G, (int)blockIdx.x, (const int*)(a.ws + WS_S5TAB), (size_t)512 * 768);
              pg8::EpiS5Y E{(bf16_t*)(a.ws + R_YG), PROJ, FIN(I_S5D) + l * 256}; pg8::gemm_phase<pg8::EpiS5Y, false>(lds, g, S, E, tid); }
            REP(9) { rwkv_pre(a, l, lds, wave, lane, G);
            __syncthreads(); }
            __syncthreads();
            REP(10) ret_pass_c(a, lds, tid, wave, lane, G);
            SEAM(pb + 5);
        }
        if (PHM(7) && IN(pb + 6)) { FRESH();
            pg8::Gemm g{(const bf16_t*)(a.ws + R_YG), SM + SM_WGLU / 2, 256, 256, 256, nullptr}; pg8::Order S; S.init(T / 256, 1, G > 64 ? G - 32 : G, G > 64 ? (int)blockIdx.x - 32 : (int)blockIdx.x);
            pg8::EpiGlu E{MIX, (const bf16_t*)(a.ws + R_YG), FIN(I_S5GB) + l * 256};
            if (G > 64) { if ((int)blockIdx.x < 32) rwkv_main(a, l, lds, (int)blockIdx.x, tid, wave, lane); else pg8::gemm_phase<pg8::EpiGlu, false>(lds, g, S, E, tid); }
            else { for (int bh = blockIdx.x; bh < 32; bh += G) rwkv_main(a, l, lds, bh, tid, wave, lane); pg8::gemm_phase<pg8::EpiGlu, false>(lds, g, S, E, tid); }
            __syncthreads();
            attn_queue(a, l, lds, (volatile LAS unsigned*)(lds + MISC_OFF + 64), ctl + CW_ATTQ + 64 * l, tid, wave, lane);
            SEAM(pb + 6);
        }
        if (PHM(8) && IN(pb + 7)) { FRESH();
        }
        if (PHM(9) && IN(pb + 8)) { FRESH();
            pg8::Gemm g{MIX, (const bf16_t*)(a.ws + WS_WOUT), 1024, 1024, 1024, nullptr}; pg8::Order S; S.init(T / 256, 4, G, (int)blockIdx.x);
            pg8::EpiResid E{l == 0 ? FIN(I_X) : a.out, a.out, (const float*)(a.ws + WS_MOD) + (size_t)(l * 8) * 6144 + 2048};
            const bool own = (G == T / 256) && IN(pb + 9);
            S.own = own ? 1 : 0;
            pg8::gemm_phase<pg8::EpiResid, false>(lds, g, S, E, tid);
            if (!own) SEAM(pb + 8);
        }
        if (PHM(10) && IN(pb + 9)) { FRESH(); REP(14) phase_norm2(a, l, lds, tid, wave, lane, G); SEAM(pb + 9); }
        if (PHM(11) && IN(pb + 10)) { FRESH(); REP(15) phase_plan(a, lds, tid, G);
            if (l + 1 < DEPTH && (G == T / 256) && IN(pb + PH_PER_LAYER) && IN(pb + PH_PER_LAYER + 1)) { __syncthreads(); phase_conv<0>(a, l + 1, lds, tid, wave, lane, G); }
            SEAM(pb + 10); }
        if (PHM(12) && IN(pb + 11)) { FRESH();
            const int ntiles = __builtin_amdgcn_readfirstlane((int)__hip_atomic_load(ctl + CW_NTILES, __ATOMIC_RELAXED, __HIP_MEMORY_SCOPE_AGENT));
            pg8::Gemm g{(const bf16_t*)(a.ws + WS_HN8), (const bf16_t*)(a.ws + WS_WGU), 512, 512, 512, (const int*)(a.ws + MO_ROWTOK)}; pg8::Order S; S.init(ntiles, 8, G, (int)blockIdx.x, (const int*)(a.ws + MO_TILEE), (size_t)2048 * 512);
            pg8::EpiSwiglu E{a.ws + R_H, FIN(I_EBG) + (size_t)l * 32 * 1024, FIN(I_EBU) + (size_t)l * 32 * 1024};
            REP(16) pg8::gemm_phase<pg8::EpiSwiglu, true, true>(lds, g, S, E, tid);
            SEAM(pb + 11);
        }
        if (PHM(13) && IN(pb + 12)) { FRESH();
            const int ntiles = __builtin_amdgcn_readfirstlane((int)__hip_atomic_load(ctl + CW_NTILES, __ATOMIC_RELAXED, __HIP_MEMORY_SCOPE_AGENT));
            pg8::Gemm g{(const bf16_t*)(a.ws + R_H), (const bf16_t*)(a.ws + WS_WDN), 512, 512, 512, nullptr}; pg8::Order S; S.init(ntiles, 4, G, (int)blockIdx.x, (const int*)(a.ws + MO_TILEE), (size_t)1024 * 512);
            pg8::EpiBf16 E{(bf16_t*)(a.ws + R_Y), 1024, FIN(I_EBD) + (size_t)l * 32 * 1024, 1024, 1};
            REP(17) pg8::gemm_phase<pg8::EpiBf16, false, true>(lds, g, S, E, tid);
            SEAM(pb + 12);
        }
    }
    if (PHM(14) && IN(NPH - 1)) { FRESH(); phase_norm1<1>(a, DEPTH, wave, lane, G); }
#undef IN
#undef SEAM
}

extern "C" void kernel_launch(void* const* d_in, const int* in_sizes, int n_in, void* d_out, int out_size, void* d_ws, size_t ws_size, hipStream_t stream) {
    static int grid = 0;
    if (grid == 0) {
        if (n_in != 46 || in_sizes[0] != T * D || out_size != T * D || ws_size < WS_END) {
            fprintf(stderr, "kernel_launch: unexpected problem: n_in %d in0 %d out %d ws %zu (need %zu)\n", n_in, n_in > 0 ? in_sizes[0] : -1, out_size, ws_size, (size_t)WS_END); grid = -1; return; }
        int dev = 0, cus = 0;
        if (hipGetDevice(&dev) != hipSuccess || hipDeviceGetAttribute(&cus, hipDeviceAttributeMultiprocessorCount, dev) != hipSuccess) { fprintf(stderr, "kernel_launch: device query failed\n"); grid = -1; return; }
        if (hipFuncSetAttribute((const void*)fwd, hipFuncAttributeMaxDynamicSharedMemorySize, LDS_BYTES) != hipSuccess) { fprintf(stderr, "kernel_launch: hipFuncSetAttribute failed\n"); grid = -1; return; }
        int per_cu = 0;
        if (hipOccupancyMaxActiveBlocksPerMultiprocessor(&per_cu, (const void*)fwd, NTHR, LDS_BYTES) != hipSuccess || per_cu < 1) fprintf(stderr, "kernel_launch: occupancy query reports %d\n", per_cu);
        (void)hipGetLastError();
        grid = cus;
    }
    if (grid < 0) return;
    if (hipMemsetAsync((char*)d_ws + WS_CTL, 0, CTL_ZERO_BYTES, stream) != hipSuccess) { fprintf(stderr, "kernel_launch: memset failed\n"); return; }
    KArgs ka{};
    for (int i = 0; i < 46; ++i) ka.a.in[i] = d_in[i];
    ka.a.out = (float*)d_out; ka.a.ws = (unsigned char*)d_ws;
#if MK_SPLIT
    for (int p = 0; p < NPH; ++p) { ka.a.ph_lo = p; ka.a.ph_hi = p + 1; ka.li = p; ka.pad = 0;
        hipLaunchKernelGGL(fwd, dim3(grid), dim3(NTHR), LDS_BYTES, stream, ka);
        const hipError_t le = hipPeekAtLastError(); if (le != hipSuccess) { fprintf(stderr, "kernel_launch: launch %d failed: %s\n", p, hipGetErrorName(le)); break; } }
#else
    ka.a.ph_lo = 0; ka.a.ph_hi = NPH; ka.li = 0; ka.pad = 0;
    hipLaunchKernelGGL(fwd, dim3(grid), dim3(NTHR), LDS_BYTES, stream, ka);
    const hipError_t le = hipPeekAtLastError(); if (le != hipSuccess) fprintf(stderr, "kernel_launch: launch failed: %s\n", hipGetErrorName(le));
#endif
}
```
